# Optimizing an MI355X kernel written in HIP

```python
import jax, jax.numpy as jnp
from jax import lax
import numpy as np

D_MODEL = 1024
BATCH = 16
SEQ = 256
DEPTH = 4
DEC_BATCH = 2
DEC_SEQ = 2048
PAST_LEN = 512

GRID_W = 64
N_MIXERS = 3
ATTN_HEADS = 16
ATTN_KV_HEADS = 4
ATTN_HEAD_DIM = D_MODEL // ATTN_HEADS
ATTN_GROUP = ATTN_HEADS // ATTN_KV_HEADS
ATTN_WIDTH = ATTN_HEADS * ATTN_HEAD_DIM
ATTN_KV_WIDTH = ATTN_KV_HEADS * ATTN_HEAD_DIM
WINDOW = 128
ATTN_BLOCK = 128
BAND_SIDE = WINDOW // ATTN_BLOCK
ROPE_BASE = 10000.0
ROPE_AXIS_DIM = ATTN_HEAD_DIM // 2
POOL_WIDTH = D_MODEL
POOL_WINDOWS = (2, 4, 8, 16)
POOL_GROUPS = len(POOL_WINDOWS)
POOL_GROUP_DIM = POOL_WIDTH // POOL_GROUPS
RET_HEADS = 4
RET_KEY_DIM = D_MODEL // RET_HEADS
RET_VAL_DIM = 2 * RET_KEY_DIM
RET_QK_WIDTH = RET_HEADS * RET_KEY_DIM
RET_V_WIDTH = RET_HEADS * RET_VAL_DIM
RET_CHUNK = 128
N_ATTN = (DEPTH + N_MIXERS - 1) // N_MIXERS
N_POOL = (DEPTH + N_MIXERS - 2) // N_MIXERS
N_RET = DEPTH // N_MIXERS
EPS = 1e-6
NEG_INF = -1e30

kernel_name = "hybrid_flow_ctx_prefix_step"


def rms_norm(x, g):
    xf = x.astype(jnp.float32)
    y = xf * lax.rsqrt(jnp.mean(xf * xf, axis=-1, keepdims=True) + EPS) * g.astype(jnp.float32)
    return y.astype(x.dtype)


def ada_params(cond, w, b):
    m = jax.nn.silu(cond) @ w + b
    return jnp.split(m, 3, axis=-1)


def axial_rope_tables(n_tok):
    n_rows = n_tok // GRID_W
    rows = jnp.repeat(jnp.arange(n_rows), GRID_W).astype(jnp.float32)
    cols = jnp.tile(jnp.arange(GRID_W), n_rows).astype(jnp.float32)
    half = ROPE_AXIS_DIM // 2
    inv = ROPE_BASE ** (-jnp.arange(half, dtype=jnp.float32) / half)
    ang_r = rows[:, None] * inv[None, :]
    ang_c = cols[:, None] * inv[None, :]
    cos = jnp.concatenate([jnp.cos(ang_r), jnp.cos(ang_r), jnp.cos(ang_c), jnp.cos(ang_c)], axis=-1)
    sin = jnp.concatenate([jnp.sin(ang_r), jnp.sin(ang_r), jnp.sin(ang_c), jnp.sin(ang_c)], axis=-1)
    return cos, sin


def apply_rope(x, cos, sin):
    shape = (x.shape[1],) + (1,) * (x.ndim - 3) + (x.shape[-1],)
    c = cos.reshape(shape)
    s = sin.reshape(shape)
    xf = x.astype(jnp.float32)
    x1r, x2r, x1c, x2c = jnp.split(xf, 4, axis=-1)
    rot = jnp.concatenate([-x2r, x1r, -x2c, x1c], axis=-1)
    return (xf * c + rot * s).astype(x.dtype)


def softmax_with_sink(s, sink):
    sk = sink.astype(jnp.float32)[None, :, :, None, None]
    m = jnp.maximum(jnp.max(s, axis=-1, keepdims=True), sk)
    e = jnp.exp(s - m)
    return e / (jnp.sum(e, axis=-1, keepdims=True) + jnp.exp(sk - m))


def attn_project(h, w_in):
    B, L, _ = h.shape
    q, k, v, z = jnp.split(h @ w_in, [ATTN_WIDTH, ATTN_WIDTH + ATTN_KV_WIDTH,
                                     ATTN_WIDTH + 2 * ATTN_KV_WIDTH], axis=-1)
    q = q.reshape(B, L, ATTN_KV_HEADS, ATTN_GROUP, ATTN_HEAD_DIM)
    k = k.reshape(B, L, ATTN_KV_HEADS, ATTN_HEAD_DIM)
    v = v.reshape(B, L, ATTN_KV_HEADS, ATTN_HEAD_DIM)
    return q, k, v, z


def context_attention(q, k, v, sink):
    B, L = q.shape[:2]
    nb = L // ATTN_BLOCK
    scale = ATTN_HEAD_DIM ** -0.5
    qb = q.reshape(B, nb, ATTN_BLOCK, ATTN_KV_HEADS, ATTN_GROUP, ATTN_HEAD_DIM).swapaxes(0, 1)

    def block(qi):
        s = jnp.einsum('bqhgd,bkhd->bhgqk', qi, k).astype(jnp.float32) * scale
        p = softmax_with_sink(s, sink).astype(v.dtype)
        return jnp.einsum('bhgqk,bkhd->bqhgd', p, v)

    o = lax.map(block, qb)
    return o.swapaxes(0, 1).reshape(B, L, ATTN_WIDTH)


def latent_attention(q, k, v, k_ctx, v_ctx, sink):
    B, S = q.shape[:2]
    nb = S // ATTN_BLOCK
    n_ctx = k_ctx.shape[1]
    pad = BAND_SIDE * ATTN_BLOCK
    band = (2 * BAND_SIDE + 1) * ATTN_BLOCK
    scale = ATTN_HEAD_DIM ** -0.5
    kp = jnp.pad(k, ((0, 0), (pad, pad), (0, 0), (0, 0)))
    vp = jnp.pad(v, ((0, 0), (pad, pad), (0, 0), (0, 0)))

    def block(n):
        start = n * ATTN_BLOCK
        qi = lax.dynamic_slice_in_dim(q, start, ATTN_BLOCK, axis=1)
        kb = lax.dynamic_slice_in_dim(kp, start, band, axis=1)
        vb = lax.dynamic_slice_in_dim(vp, start, band, axis=1)
        qpos = start + jnp.arange(ATTN_BLOCK)
        kpos = start - pad + jnp.arange(band)
        mask = ((jnp.abs(qpos[:, None] - kpos[None, :]) <= WINDOW)
                & (kpos >= 0)[None, :] & (kpos < S)[None, :])
        s_ctx = jnp.einsum('bqhgd,bkhd->bhgqk', qi, k_ctx).astype(jnp.float32) * scale
        s_lat = jnp.einsum('bqhgd,bkhd->bhgqk', qi, kb).astype(jnp.float32) * scale
        s_lat = jnp.where(mask, s_lat, NEG_INF)
        p = softmax_with_sink(jnp.concatenate([s_ctx, s_lat], axis=-1), sink).astype(v.dtype)
        return (jnp.einsum('bhgqk,bkhd->bqhgd', p[..., :n_ctx], v_ctx)
                + jnp.einsum('bhgqk,bkhd->bqhgd', p[..., n_ctx:], vb))

    o = lax.map(block, jnp.arange(nb))
    return o.swapaxes(0, 1).reshape(B, S, ATTN_WIDTH)


def attn_mixer_context(h, w_in, w_out, sink):
    q, k, v, z = attn_project(h, w_in)
    o = context_attention(q, k, v, sink.reshape(ATTN_KV_HEADS, ATTN_GROUP))
    return (o * jax.nn.silu(z)) @ w_out, k, v


def attn_mixer_latent(h, k_ctx, v_ctx, w_in, w_out, sink, cos, sin):
    q, k, v, z = attn_project(h, w_in)
    q = apply_rope(q, cos, sin)
    k = apply_rope(k, cos, sin)
    o = latent_attention(q, k, v, k_ctx.astype(k.dtype), v_ctx.astype(v.dtype),
                         sink.reshape(ATTN_KV_HEADS, ATTN_GROUP))
    return (o * jax.nn.silu(z)) @ w_out


def pool_mixer(h, w_in, w_grp, scale, w_out):
    B, L, _ = h.shape
    u, z = jnp.split(h @ w_in, 2, axis=-1)
    uf = u.astype(jnp.float32)
    cs = jnp.concatenate([jnp.zeros_like(uf[:, :1]), jnp.cumsum(uf, axis=1)], axis=1)
    t = jnp.arange(L)
    parts = []
    for g, w in enumerate(POOL_WINDOWS):
        left = w // 2
        right = w - 1 - left
        lo = jnp.clip(t - left, 0, L)
        hi = jnp.clip(t + right + 1, 0, L)
        sl = slice(g * POOL_GROUP_DIM, (g + 1) * POOL_GROUP_DIM)
        csg = cs[..., sl]
        mean = (csg[:, hi] - csg[:, lo]) / (hi - lo).astype(jnp.float32)[None, :, None]
        parts.append(mean - uf[..., sl])
    d = jnp.stack(parts, axis=2).astype(h.dtype)
    y = jnp.einsum('blgc,gcd->blgd', d, w_grp).reshape(B, L, POOL_WIDTH) * scale
    return (y * jax.nn.silu(z)) @ w_out


def retention_scan(q, k, v, log_gamma, s0):
    B, L = q.shape[:2]
    C = RET_CHUNK
    n = L // C
    idx = jnp.arange(C, dtype=jnp.float32)
    diff = idx[:, None] - idx[None, :]
    decay_in = jnp.where(diff[None] >= 0,
                         jnp.exp(jnp.maximum(diff, 0.0)[None] * log_gamma[:, None, None]), 0.0)
    q_dec = jnp.exp((idx + 1.0)[:, None] * log_gamma[None, :])
    k_dec = jnp.exp((C - 1.0 - idx)[:, None] * log_gamma[None, :])
    c_dec = jnp.exp(C * log_gamma)

    def to_chunks(a):
        return a.reshape((B, n, C) + a.shape[2:]).swapaxes(0, 1)

    def step(S, inp):
        qc, kc, vc = inp
        att = jnp.einsum('bihd,bjhd->bhij', qc, kc) * decay_in[None]
        o = (jnp.einsum('bhij,bjhe->bihe', att, vc)
             + jnp.einsum('bihd,bhde->bihe', qc * q_dec[None, :, :, None], S))
        S = S * c_dec[None, :, None, None] + jnp.einsum('bjhd,bjhe->bhde', kc * k_dec[None, :, :, None], vc)
        return S, o

    s_fin, o = lax.scan(step, s0, (to_chunks(q), to_chunks(k), to_chunks(v)))
    return o.swapaxes(0, 1).reshape(B, L, RET_HEADS, RET_VAL_DIM), s_fin


def retention_project(h, w_in):
    B, L, _ = h.shape
    q, k, v, z = jnp.split(h @ w_in, [RET_QK_WIDTH, 2 * RET_QK_WIDTH,
                                     2 * RET_QK_WIDTH + RET_V_WIDTH], axis=-1)
    q = q.reshape(B, L, RET_HEADS, RET_KEY_DIM).astype(jnp.float32)
    k = k.reshape(B, L, RET_HEADS, RET_KEY_DIM).astype(jnp.float32) * (RET_KEY_DIM ** -0.5)
    v = v.reshape(B, L, RET_HEADS, RET_VAL_DIM).astype(jnp.float32)
    return q, k, v, z


def bidir_retention(q, k, v, lg_f, lg_b, s_f, s_b):
    o_f, sf = retention_scan(q, k, v, lg_f, s_f)
    o_b, sb = retention_scan(q[:, ::-1], k[:, ::-1], v[:, ::-1], lg_b, s_b)
    return o_f + o_b[:, ::-1], sf, sb


def retention_output(o, z, gn_g, w_out):
    B, L = o.shape[:2]
    mu = jnp.mean(o, axis=-1, keepdims=True)
    var = jnp.mean(jnp.square(o - mu), axis=-1, keepdims=True)
    on = (o - mu) * lax.rsqrt(var + EPS)
    y = (on.reshape(B, L, RET_V_WIDTH) * gn_g.astype(jnp.float32)).astype(z.dtype)
    return (y * jax.nn.silu(z)) @ w_out


def setup_inputs(seed: int = 0) -> dict:
    key = jax.random.key(seed)
    ks = jax.random.split(key, 24)

    def nrm(k, shape, s):
        return jax.random.normal(k, shape, jnp.float32) * s

    D = D_MODEL
    base_decay = jnp.log(2.0 ** (5.0 + jnp.arange(RET_HEADS, dtype=jnp.float32)) - 1.0)
    return {
        "x_prompt": nrm(ks[0], (BATCH, SEQ, D), 1.0),
        "x_sample": nrm(ks[1], (DEC_BATCH, DEC_SEQ, D), 1.0),
        "cache_k": nrm(ks[2], (DEC_BATCH, N_ATTN, PAST_LEN, ATTN_KV_HEADS, ATTN_HEAD_DIM), 1.0),
        "cache_v": nrm(ks[3], (DEC_BATCH, N_ATTN, PAST_LEN, ATTN_KV_HEADS, ATTN_HEAD_DIM), 1.0),
        "state_fwd": nrm(ks[4], (DEC_BATCH, N_RET, RET_HEADS, RET_KEY_DIM, RET_VAL_DIM), 0.5),
        "state_bwd": nrm(ks[5], (DEC_BATCH, N_RET, RET_HEADS, RET_KEY_DIM, RET_VAL_DIM), 0.5),
        "c": nrm(ks[6], (DEC_BATCH, D), 1.0),
        "c_ctx": nrm(ks[7], (D,), 1.0),
        "norm_g": 1.0 + nrm(ks[8], (DEPTH, D), 0.05),
        "ada_w": nrm(ks[9], (DEPTH, D, 3 * D), D ** -0.5),
        "ada_b": nrm(ks[10], (DEPTH, 3 * D), 0.02),
        "attn_w_in": nrm(ks[11], (N_ATTN, D, 2 * ATTN_WIDTH + 2 * ATTN_KV_WIDTH), D ** -0.5),
        "attn_w_out": nrm(ks[12], (N_ATTN, ATTN_WIDTH, D), ATTN_WIDTH ** -0.5),
        "attn_sink": nrm(ks[13], (N_ATTN, ATTN_HEADS), 0.5),
        "pool_w_in": nrm(ks[14], (N_POOL, D, 2 * POOL_WIDTH), D ** -0.5),
        "pool_w_grp": nrm(ks[15], (N_POOL, POOL_GROUPS, POOL_GROUP_DIM, POOL_GROUP_DIM), POOL_GROUP_DIM ** -0.5),
        "pool_scale": 1.0 + nrm(ks[16], (N_POOL, POOL_WIDTH), 0.1),
        "pool_w_out": nrm(ks[17], (N_POOL, POOL_WIDTH, D), POOL_WIDTH ** -0.5),
        "ret_w_in": nrm(ks[18], (N_RET, D, 2 * RET_QK_WIDTH + 2 * RET_V_WIDTH), D ** -0.5),
        "ret_decay_fwd": base_decay + nrm(ks[19], (N_RET, RET_HEADS), 0.1),
        "ret_decay_bwd": base_decay + nrm(ks[20], (N_RET, RET_HEADS), 0.1),
        "ret_gn_g": 1.0 + nrm(ks[21], (N_RET, RET_V_WIDTH), 0.05),
        "ret_w_out": nrm(ks[22], (N_RET, RET_V_WIDTH, D), RET_V_WIDTH ** -0.5),
        "final_g": 1.0 + nrm(ks[23], (D,), 0.05),
    }


def reference(x_prompt, x_sample, cache_k, cache_v, state_fwd, state_bwd, c, c_ctx,
              norm_g, ada_w, ada_b, attn_w_in, attn_w_out, attn_sink,
              pool_w_in, pool_w_grp, pool_scale, pool_w_out,
              ret_w_in, ret_decay_fwd, ret_decay_bwd, ret_gn_g, ret_w_out, final_g):
    cos, sin = axial_rope_tables(x_sample.shape[1])
    xp, xs = x_prompt, x_sample
    new_k, new_v, new_sf, new_sb = [], [], [], []
    for i in range(DEPTH):
        kind, j = i % N_MIXERS, i // N_MIXERS
        sh_p, sc_p, g_p = ada_params(c_ctx, ada_w[i], ada_b[i])
        sh_s, sc_s, g_s = ada_params(c[:, None, :], ada_w[i], ada_b[i])
        hp = rms_norm(xp, norm_g[i]) * (1.0 + sc_p) + sh_p
        hs = rms_norm(xs, norm_g[i]) * (1.0 + sc_s) + sh_s
        if kind == 0:
            op, kc, vc = attn_mixer_context(hp, attn_w_in[j], attn_w_out[j], attn_sink[j])
            os_ = attn_mixer_latent(hs, cache_k[:, j], cache_v[:, j], attn_w_in[j], attn_w_out[j],
                                    attn_sink[j], cos, sin)
            new_k.append(kc)
            new_v.append(vc)
        elif kind == 1:
            op = pool_mixer(hp, pool_w_in[j], pool_w_grp[j], pool_scale[j], pool_w_out[j])
            os_ = pool_mixer(hs, pool_w_in[j], pool_w_grp[j], pool_scale[j], pool_w_out[j])
        else:
            lg_f = jax.nn.log_sigmoid(ret_decay_fwd[j].astype(jnp.float32))
            lg_b = jax.nn.log_sigmoid(ret_decay_bwd[j].astype(jnp.float32))
            q, k, v, z = retention_project(hp, ret_w_in[j])
            zeros = jnp.zeros((hp.shape[0], RET_HEADS, RET_KEY_DIM, RET_VAL_DIM), jnp.float32)
            o, sf, sb = bidir_retention(q, k, v, lg_f, lg_b, zeros, zeros)
            op = retention_output(o, z, ret_gn_g[j], ret_w_out[j])
            new_sf.append(sf.astype(xp.dtype))
            new_sb.append(sb.astype(xp.dtype))
            q, k, v, z = retention_project(hs, ret_w_in[j])
            o, _, _ = bidir_retention(q, k, v, lg_f, lg_b,
                                      state_fwd[:, j].astype(jnp.float32),
                                      state_bwd[:, j].astype(jnp.float32))
            os_ = retention_output(o, z, ret_gn_g[j], ret_w_out[j])
        xp = xp + g_p * op
        xs = xs + g_s * os_
    y_prompt = rms_norm(xp, final_g)
    y_sample = rms_norm(xs, final_g)
    new_cache_k = jnp.stack(new_k, axis=1)
    new_cache_v = jnp.stack(new_v, axis=1)
    new_state_fwd = jnp.stack(new_sf, axis=1)
    new_state_bwd = jnp.stack(new_sb, axis=1)
    return (y_prompt, y_sample, new_cache_k, new_cache_v, new_state_fwd, new_state_bwd)
```

```cpp
#include <hip/hip_runtime.h>
#include <hip/hip_cooperative_groups.h>
#include <cstdio>
#include <cstdint>
namespace cg = cooperative_groups;

typedef unsigned short u16;
typedef short bf16x8 __attribute__((ext_vector_type(8)));
typedef float f32x4 __attribute__((ext_vector_type(4)));
typedef unsigned u32x4 __attribute__((ext_vector_type(4)));

#define NTHREADS 256
#define SMEM_BYTES 73728
constexpr float LOG2E = 1.4426950408889634f;

constexpr size_t MiB = 1048576;
constexpr size_t WS_MOD  = 0;
constexpr size_t WS_ROPE = 147456;
constexpr size_t WS_BAR  = 155648;
constexpr size_t WS_WAI  = 262144;
constexpr size_t WS_WAO  = WS_WAI + 2 * 2560 * 1024 * 2;
constexpr size_t WS_WPI  = WS_WAO + 2 * 1024 * 1024 * 2;
constexpr size_t WS_WPG  = WS_WPI + 2048 * 1024 * 2;
constexpr size_t WS_WPO  = WS_WPG + 4 * 256 * 256 * 2;
constexpr size_t WS_WRI  = WS_WPO + 1024 * 1024 * 2;
constexpr size_t WS_WRO  = WS_WRI + 6144 * 1024 * 2;
constexpr size_t WS_CK   = WS_WRO + 1024 * 2048 * 2;
constexpr size_t WS_CVT  = WS_CK + 2 * 2 * 512 * 256 * 2;
constexpr size_t WS_RA   = WS_CVT + 2 * 2 * 512 * 256 * 2;
constexpr size_t WS_RB   = WS_RA + 16 * MiB;
constexpr size_t WS_RC   = WS_RB + 16 * MiB;
constexpr size_t WS_RD   = WS_RC + 16 * MiB;
constexpr size_t WS_RE   = WS_RD + 32 * MiB;
constexpr size_t WS_RF   = WS_RE + 32 * MiB;
constexpr size_t WS_END  = WS_RF + 96 * MiB;

constexpr size_t O_NK = 8388608, O_NV = 10485760, O_SF = 12582912, O_SB = 20971520;

struct Params {
  const float* in[24];
  float* out;
  unsigned char* ws;
};

typedef __bf16 bf16x2_t __attribute__((ext_vector_type(2)));
__device__ __forceinline__ unsigned pk_bf16(float lo, float hi) { bf16x2_t v; v.x = (__bf16)lo; v.y = (__bf16)hi; return __builtin_bit_cast(unsigned, v); }
__device__ __forceinline__ u16 f2bf(float f) { return __builtin_bit_cast(u16, (__bf16)f); }
__device__ __forceinline__ float bf2f(u16 h) { return __uint_as_float(((unsigned)h) << 16); }
__device__ __forceinline__ float bflo(unsigned u) { return __uint_as_float(u << 16); }
__device__ __forceinline__ float bfhi(unsigned u) { return __uint_as_float(u & 0xffff0000u); }
__device__ __forceinline__ float fexp2(float x) { return __builtin_amdgcn_exp2f(x); }
__shared__ int g_wave_tab[64];
__device__ __forceinline__ int hw_slot() { return (int)(__builtin_amdgcn_s_getreg(((6 - 1) << 11) | 4) & 63u); }
__device__ __forceinline__ int lane_now() { return (int)__builtin_amdgcn_mbcnt_hi(~0u, __builtin_amdgcn_mbcnt_lo(~0u, 0u)); }
__device__ __forceinline__ int tid_now() { return __builtin_amdgcn_readfirstlane(g_wave_tab[hw_slot()]) * 64 + lane_now(); }
__device__ __forceinline__ float silu(float x) { return x / (1.f + __expf(-x)); }
__device__ __forceinline__ float logsig2(float x) { return -log1pf(expf(-x)) * LOG2E; }
__device__ __forceinline__ f32x4 mfma16(bf16x8 a, bf16x8 b, f32x4 c) { return __builtin_amdgcn_mfma_f32_16x16x32_bf16(a, b, c, 0, 0, 0); }

template <typename T> __device__ __forceinline__ T* opaque(T* p) { asm volatile("" : "+v"(p)); return p; }

__device__ __forceinline__ int lds_off(int r, int c) {
  int st = (r >> 4) * 2 + (c >> 5), ob = (r & 15) * 64 + (c & 31) * 2;
  return st * 1024 + (ob ^ (((ob >> 9) & 1) << 5));
}

__device__ __forceinline__ bf16x8 scale_frag(bf16x8 v, float s) {
  union { bf16x8 v; unsigned u[4]; } x; x.v = v;
#pragma unroll
  for (int i = 0; i < 4; ++i) x.u[i] = pk_bf16(bflo(x.u[i]) * s, bfhi(x.u[i]) * s);
  return x.v;
}

template <bool SCALE>
__device__ __forceinline__ void gemm_core(const u16* __restrict__ A, size_t lda, const u16* __restrict__ B, size_t ldb, int K,
                                          f32x4 (&acc)[4][4], char* sm, float lg2 = 0.f, int dir = 0) {
  const int t = tid_now(), lane = t & 63, w = t >> 6, wm = w >> 1, wn = w & 1, fr = lane & 15, fq = lane >> 4;
  const int lr = t >> 3, lc = (t & 7) * 8;
  uint4 ra[4], rb[4];
  const int nk = K >> 6;
  const u16* Ap = A + (size_t)lr * lda + lc;
  const u16* Bp = B + (size_t)lr * ldb + lc;
#define GLOAD(kt) do { _Pragma("unroll") for (int i = 0; i < 4; ++i) { ra[i] = *(const uint4*)(Ap + (size_t)(32 * i) * lda + (kt) * 64); rb[i] = *(const uint4*)(Bp + (size_t)(32 * i) * ldb + (kt) * 64); } } while (0)
#define LSTORE(buf, kt) do { \
    if (SCALE) { float fs[8]; _Pragma("unroll") for (int e = 0; e < 8; ++e) { int j = (kt) * 64 + lc + e; fs[e] = fexp2((float)(dir ? j : 127 - j) * lg2); } \
      _Pragma("unroll") for (int i = 0; i < 4; ++i) { unsigned* u = (unsigned*)&ra[i]; _Pragma("unroll") for (int e = 0; e < 4; ++e) u[e] = pk_bf16(bflo(u[e]) * fs[2 * e], bfhi(u[e]) * fs[2 * e + 1]); } } \
    _Pragma("unroll") for (int i = 0; i < 4; ++i) { *(uint4*)(sm + (buf) * 32768 + lds_off(lr + 32 * i, lc)) = ra[i]; *(uint4*)(sm + (buf) * 32768 + 16384 + lds_off(lr + 32 * i, lc)) = rb[i]; } } while (0)
  GLOAD(0);
  LSTORE(0, 0);
  __syncthreads();
  for (int kt = 0; kt < nk; ++kt) {
    const int cur = kt & 1;
    if (kt + 1 < nk) GLOAD(kt + 1);
    const char* sa = sm + cur * 32768;
    const char* sb = sa + 16384;
#pragma unroll
    for (int ks = 0; ks < 2; ++ks) {
      bf16x8 a[4], b[4];
#pragma unroll
      for (int m = 0; m < 4; ++m) a[m] = *(const bf16x8*)(sa + lds_off(wm * 64 + m * 16 + fr, ks * 32 + fq * 8));
#pragma unroll
      for (int n = 0; n < 4; ++n) b[n] = *(const bf16x8*)(sb + lds_off(wn * 64 + n * 16 + fr, ks * 32 + fq * 8));
#pragma unroll
      for (int m = 0; m < 4; ++m)
#pragma unroll
        for (int n = 0; n < 4; ++n) acc[m][n] = mfma16(a[m], b[n], acc[m][n]);
    }
    if (kt + 1 < nk) LSTORE(cur ^ 1, kt + 1);
    __syncthreads();
  }
#undef GLOAD
#undef LSTORE
}

__device__ __forceinline__ int lds_off32(int r, int c) {
  int ob = (r & 15) * 64 + c * 2;
  return (r >> 4) * 1024 + (ob ^ (((ob >> 9) & 1) << 5));
}
#define LAS3 __attribute__((address_space(3)))
template <int J>
__device__ __forceinline__ void glds_step(int kt, int nk, const u16* Ap, size_t lda, const u16* Bp, size_t ldb, char* sm, unsigned aA, unsigned aB,
                                          f32x4 (&acc)[4][4]) {
  const int t = tid_now();
  if (kt + 2 < nk) asm volatile("s_waitcnt vmcnt(8)" ::: "memory");
  else if (kt + 1 < nk) asm volatile("s_waitcnt vmcnt(4)" ::: "memory");
  else asm volatile("s_waitcnt vmcnt(0)" ::: "memory");
  __builtin_amdgcn_s_barrier();
  if (kt + 3 < nk) {
    char* d = sm + ((J + 3) & 3) * 16384 + t * 16;
    const size_t ko = (size_t)(kt + 3) * 32;
#pragma unroll
    for (int i = 0; i < 2; ++i) {
      __builtin_amdgcn_global_load_lds((const unsigned*)(Ap + (size_t)(64 * i) * 32 + (size_t)(kt + 3) * lda), (unsigned*)(d + i * 4096), 16, 0, 0);
      __builtin_amdgcn_global_load_lds((const unsigned*)(Bp + (size_t)(64 * i) * 32 + (size_t)(kt + 3) * ldb), (unsigned*)(d + 8192 + i * 4096), 16, 0, 0);
    }
  }
  bf16x8 a0, a1, a2, a3, b0, b1, b2, b3;
  asm volatile(
      "ds_read_b128 %0, %8 offset:%10\n\t"
      "ds_read_b128 %4, %9 offset:%10\n\t"
      "ds_read_b128 %5, %9 offset:%11\n\t"
      "ds_read_b128 %1, %8 offset:%11\n\t"
      "ds_read_b128 %6, %9 offset:%12\n\t"
      "ds_read_b128 %7, %9 offset:%13\n\t"
      "ds_read_b128 %2, %8 offset:%12\n\t"
      "ds_read_b128 %3, %8 offset:%13\n\t"
      "s_waitcnt lgkmcnt(0)"
      : "=&v"(a0), "=&v"(a1), "=&v"(a2), "=&v"(a3), "=&v"(b0), "=&v"(b1), "=&v"(b2), "=&v"(b3)
      : "v"(aA), "v"(aB), "n"(J * 16384), "n"(J * 16384 + 1024), "n"(J * 16384 + 2048), "n"(J * 16384 + 3072)
      : "memory");
  acc[0][0] = mfma16(a0, b0, acc[0][0]); acc[0][1] = mfma16(a0, b1, acc[0][1]); acc[0][2] = mfma16(a0, b2, acc[0][2]); acc[0][3] = mfma16(a0, b3, acc[0][3]);
  acc[1][0] = mfma16(a1, b0, acc[1][0]); acc[1][1] = mfma16(a1, b1, acc[1][1]); acc[1][2] = mfma16(a1, b2, acc[1][2]); acc[1][3] = mfma16(a1, b3, acc[1][3]);
  acc[2][0] = mfma16(a2, b0, acc[2][0]); acc[2][1] = mfma16(a2, b1, acc[2][1]); acc[2][2] = mfma16(a2, b2, acc[2][2]); acc[2][3] = mfma16(a2, b3, acc[2][3]);
  acc[3][0] = mfma16(a3, b0, acc[3][0]); acc[3][1] = mfma16(a3, b1, acc[3][1]); acc[3][2] = mfma16(a3, b2, acc[3][2]); acc[3][3] = mfma16(a3, b3, acc[3][3]);
}
__device__ __forceinline__ void gemm_core_glds(const u16* __restrict__ A, size_t lda, const u16* __restrict__ B, size_t ldb, int K,
                                               f32x4 (&acc)[4][4], char* sm) {
  const int t = tid_now(), lane = t & 63, w = t >> 6, wm = w >> 1, wn = w & 1, fr = lane & 15, fq = lane >> 4;
  const int sb = lane * 16, swz = sb ^ (((sb >> 9) & 1) << 5);
  const int r0 = w * 16 + (swz >> 6), c0 = (swz & 63) >> 1;
  const u16* Ap = A + (size_t)r0 * 32 + c0;
  const u16* Bp = B + (size_t)r0 * 32 + c0;
  const int nk = K >> 5;
  const unsigned smb = (unsigned)(uintptr_t)(LAS3 char*)sm;
  const unsigned aA = smb + lds_off32(wm * 64 + fr, fq * 8);
  const unsigned aB = smb + 8192 + lds_off32(wn * 64 + fr, fq * 8);
#pragma unroll
  for (int j = 0; j < 3; ++j) {
    char* d = sm + j * 16384 + t * 16;
#pragma unroll
    for (int i = 0; i < 2; ++i) {
      __builtin_amdgcn_global_load_lds((const unsigned*)(Ap + (size_t)(64 * i) * 32 + (size_t)j * lda), (unsigned*)(d + i * 4096), 16, 0, 0);
      __builtin_amdgcn_global_load_lds((const unsigned*)(Bp + (size_t)(64 * i) * 32 + (size_t)j * ldb), (unsigned*)(d + 8192 + i * 4096), 16, 0, 0);
    }
  }
  for (int kt0 = 0; kt0 < nk; kt0 += 4) {
    glds_step<0>(kt0, nk, Ap, lda, Bp, ldb, sm, aA, aB, acc);
    glds_step<1>(kt0 + 1, nk, Ap, lda, Bp, ldb, sm, aA, aB, acc);
    glds_step<2>(kt0 + 2, nk, Ap, lda, Bp, ldb, sm, aA, aB, acc);
    glds_step<3>(kt0 + 3, nk, Ap, lda, Bp, ldb, sm, aA, aB, acc);
  }
  __syncthreads();
}

template <int J>
__device__ __forceinline__ void glds2_step(int kt, int nk, const u16* Ap, size_t lda, const u16* Bp, size_t ldb, char* sm, unsigned aA, unsigned aB, int t,
                                           f32x4 (&accL)[4][4], f32x4 (&accR)[4][4]) {
  if (kt + 1 < nk) asm volatile("s_waitcnt vmcnt(6)" ::: "memory");
  else asm volatile("s_waitcnt vmcnt(0)" ::: "memory");
  __builtin_amdgcn_s_barrier();
  if (kt + 2 < nk) {
    char* d = sm + ((J + 2) % 3) * 24576 + t * 16;
    const size_t ko = (size_t)(kt + 2) * 32;
#pragma unroll
    for (int i = 0; i < 2; ++i) __builtin_amdgcn_global_load_lds((const unsigned*)(Ap + (size_t)(64 * i) * 32 + (size_t)(kt + 2) * lda), (unsigned*)(d + i * 4096), 16, 0, 0);
#pragma unroll
    for (int i = 0; i < 4; ++i) __builtin_amdgcn_global_load_lds((const unsigned*)(Bp + (size_t)(64 * i) * 32 + (size_t)(kt + 2) * ldb), (unsigned*)(d + 8192 + i * 4096), 16, 0, 0);
  }
  bf16x8 a0, a1, a2, a3, b0, b1, b2, b3, b4, b5, b6, b7;
  asm volatile(
      "ds_read_b128 %0, %12 offset:%14\n\t"
      "ds_read_b128 %4, %13 offset:%14\n\t"
      "ds_read_b128 %5, %13 offset:%15\n\t"
      "ds_read_b128 %1, %12 offset:%15\n\t"
      "ds_read_b128 %6, %13 offset:%16\n\t"
      "ds_read_b128 %7, %13 offset:%17\n\t"
      "ds_read_b128 %2, %12 offset:%16\n\t"
      "ds_read_b128 %8, %13 offset:%18\n\t"
      "ds_read_b128 %9, %13 offset:%19\n\t"
      "ds_read_b128 %3, %12 offset:%17\n\t"
      "ds_read_b128 %10, %13 offset:%20\n\t"
      "ds_read_b128 %11, %13 offset:%21\n\t"
      "s_waitcnt lgkmcnt(0)"
      : "=&v"(a0), "=&v"(a1), "=&v"(a2), "=&v"(a3), "=&v"(b0), "=&v"(b1), "=&v"(b2), "=&v"(b3), "=&v"(b4), "=&v"(b5), "=&v"(b6), "=&v"(b7)
      : "v"(aA), "v"(aB), "n"(J * 24576), "n"(J * 24576 + 1024), "n"(J * 24576 + 2048), "n"(J * 24576 + 3072),
        "n"(J * 24576 + 8192), "n"(J * 24576 + 9216), "n"(J * 24576 + 10240), "n"(J * 24576 + 11264)
      : "memory");
#define G2_ROW(m, am) accL[m][0] = mfma16(am, b0, accL[m][0]); accL[m][1] = mfma16(am, b1, accL[m][1]); accL[m][2] = mfma16(am, b2, accL[m][2]); accL[m][3] = mfma16(am, b3, accL[m][3]); \
                      accR[m][0] = mfma16(am, b4, accR[m][0]); accR[m][1] = mfma16(am, b5, accR[m][1]); accR[m][2] = mfma16(am, b6, accR[m][2]); accR[m][3] = mfma16(am, b7, accR[m][3]);
  G2_ROW(0, a0) G2_ROW(1, a1) G2_ROW(2, a2) G2_ROW(3, a3)
#undef G2_ROW
  __builtin_amdgcn_sched_barrier(0);
}
__device__ __forceinline__ void gemm_core_glds2(const u16* __restrict__ A, size_t lda, const u16* __restrict__ B, size_t ldb, int K,
                                                f32x4 (&accL)[4][4], f32x4 (&accR)[4][4], char* sm) {
  const int t = tid_now(), lane = t & 63, w = t >> 6, wm = w >> 1, wn = w & 1, fr = lane & 15, fq = lane >> 4;
  const int sb = lane * 16, swz = sb ^ (((sb >> 9) & 1) << 5);
  const int r0 = w * 16 + (swz >> 6), c0 = (swz & 63) >> 1;
  const u16* Ap = A + (size_t)r0 * 32 + c0;
  const u16* Bp = B + (size_t)r0 * 32 + c0;
  const int nk = K >> 5;
  const unsigned smb = (unsigned)(uintptr_t)(LAS3 char*)sm;
  const unsigned aA = smb + lds_off32(wm * 64 + fr, fq * 8);
  const unsigned aB = smb + 8192 + lds_off32(wn * 64 + fr, fq * 8);
#pragma unroll
  for (int j = 0; j < 2; ++j) {
    char* d = sm + j * 24576 + t * 16;
#pragma unroll
    for (int i = 0; i < 2; ++i) __builtin_amdgcn_global_load_lds((const unsigned*)(Ap + (size_t)(64 * i) * 32 + (size_t)j * lda), (unsigned*)(d + i * 4096), 16, 0, 0);
#pragma unroll
    for (int i = 0; i < 4; ++i) __builtin_amdgcn_global_load_lds((const unsigned*)(Bp + (size_t)(64 * i) * 32 + (size_t)j * ldb), (unsigned*)(d + 8192 + i * 4096), 16, 0, 0);
  }
  for (int kt0 = 0; kt0 < nk; kt0 += 3) {
    glds2_step<0>(kt0, nk, Ap, lda, Bp, ldb, sm, aA, aB, t, accL, accR);
    if (kt0 + 1 < nk) glds2_step<1>(kt0 + 1, nk, Ap, lda, Bp, ldb, sm, aA, aB, t, accL, accR);
    if (kt0 + 2 < nk) glds2_step<2>(kt0 + 2, nk, Ap, lda, Bp, ldb, sm, aA, aB, t, accL, accR);
  }
  __syncthreads();
}

#define WAVE_IDS const int t = tid_now(), lane = t & 63, w = t >> 6, wm = w >> 1, wn = w & 1, fr = lane & 15, fq = lane >> 4; (void)wm; (void)wn; (void)fr; (void)fq; (void)lane; (void)w; (void)t
#define AROW(m, r) (wm * 64 + (m) * 16 + fq * 4 + (r))
#define ACOL(n) (wn * 64 + (n) * 16 + fr)

template <class F>
__device__ __forceinline__ void epi_store_bf16(const f32x4 (&acc)[4][4], char* sm, u16* dst, size_t ldd, F f, const u16* mulp = nullptr, size_t ldm = 0) {
  WAVE_IDS;
  u16* cs = (u16*)sm;
#pragma unroll
  for (int m = 0; m < 4; ++m) {
#pragma unroll
    for (int n = 0; n < 4; ++n)
#pragma unroll
      for (int r = 0; r < 4; ++r) cs[AROW(m, r) * 136 + ACOL(n)] = f2bf(f(AROW(m, r), ACOL(n), acc[m][n][r]));
    __builtin_amdgcn_sched_barrier(0);
  }
  __syncthreads();
#pragma unroll
  for (int i = 0; i < 8; ++i) {
    int row = (t >> 4) + 16 * i, ch = t & 15;
    uint4 v = *(const uint4*)(cs + row * 136 + ch * 8);
    if (mulp) {
      uint4 z = *(const uint4*)(mulp + (size_t)row * ldm + ch * 8);
      v.x = pk_bf16(bflo(v.x) * bflo(z.x), bfhi(v.x) * bfhi(z.x));
      v.y = pk_bf16(bflo(v.y) * bflo(z.y), bfhi(v.y) * bfhi(z.y));
      v.z = pk_bf16(bflo(v.z) * bflo(z.z), bfhi(v.z) * bfhi(z.z));
      v.w = pk_bf16(bflo(v.w) * bflo(z.w), bfhi(v.w) * bfhi(z.w));
    }
    *(uint4*)(dst + (size_t)row * ldd + ch * 8) = v;
  }
  __syncthreads();
}

template <class F>
__device__ __forceinline__ void epi_store_bf16_T(const f32x4 (&acc)[4][4], u16* dstT, size_t ldt, F f) {
  WAVE_IDS;
#pragma unroll
  for (int m = 0; m < 4; ++m)
#pragma unroll
    for (int n = 0; n < 4; ++n) {
      float v0 = f(AROW(m, 0), ACOL(n), acc[m][n][0]), v1 = f(AROW(m, 1), ACOL(n), acc[m][n][1]);
      float v2 = f(AROW(m, 2), ACOL(n), acc[m][n][2]), v3 = f(AROW(m, 3), ACOL(n), acc[m][n][3]);
      uint2 pk; pk.x = pk_bf16(v0, v1); pk.y = pk_bf16(v2, v3);
      *(uint2*)(dstT + (size_t)ACOL(n) * ldt + AROW(m, 0)) = pk;
    }
}

template <class F>
__device__ __forceinline__ void epi_store_bf16_img(const f32x4 (&acc)[4][4], char* sm, u16* img, int row0, int col0, F f, const u16* mulp = nullptr, size_t ldm = 0) {
  WAVE_IDS;
  u16* cs = (u16*)sm;
#pragma unroll
  for (int m = 0; m < 4; ++m) {
#pragma unroll
    for (int n = 0; n < 4; ++n)
#pragma unroll
      for (int r = 0; r < 4; ++r) cs[AROW(m, r) * 136 + ACOL(n)] = f2bf(f(AROW(m, r), ACOL(n), acc[m][n][r]));
    __builtin_amdgcn_sched_barrier(0);
  }
  __syncthreads();
#pragma unroll
  for (int i = 0; i < 8; ++i) {
    int ch = (t & 3) + 4 * ((t >> 6) & 3), row = ((t >> 2) & 15) + 16 * i;
    uint4 v = *(const uint4*)(cs + row * 136 + ch * 8);
    if (mulp) {
      uint4 z = *(const uint4*)(mulp + (size_t)row * ldm + ch * 8);
      v.x = pk_bf16(bflo(v.x) * bflo(z.x), bfhi(v.x) * bfhi(z.x));
      v.y = pk_bf16(bflo(v.y) * bflo(z.y), bfhi(v.y) * bfhi(z.y));
      v.z = pk_bf16(bflo(v.z) * bflo(z.z), bfhi(v.z) * bfhi(z.z));
      v.w = pk_bf16(bflo(v.w) * bflo(z.w), bfhi(v.w) * bfhi(z.w));
    }
    const int col = col0 + ch * 8;
    *(uint4*)(img + (size_t)(col >> 5) * 262144 + (size_t)(row0 + row) * 32 + (col & 31)) = v;
  }
  __syncthreads();
}

struct IdF { __device__ __forceinline__ float operator()(int, int, float v) const { return v; } };
struct SiluF { __device__ __forceinline__ float operator()(int, int, float v) const { return silu(v); } };
struct ScaleF { float s; __device__ __forceinline__ float operator()(int, int, float v) const { return v * s; } };

__device__ __forceinline__ void transpose_tile(const float* __restrict__ src, size_t ldn, u16* __restrict__ dst, size_t ldk, int k0, int n0, char* smc, size_t bstep) {
  float* sm = (float*)smc;
  const int t = tid_now(), l = t & 63, w = t >> 6;
  float4 v[16];
#pragma unroll
  for (int i = 0; i < 16; ++i) v[i] = *(const float4*)(src + (size_t)(k0 + w + 4 * i) * ldn + n0 + l * 4);
#pragma unroll
  for (int i = 0; i < 16; ++i) {
    float* d = sm + (w + 4 * i) * 257 + l * 4;
    d[0] = v[i].x; d[1] = v[i].y; d[2] = v[i].z; d[3] = v[i].w;
  }
  __syncthreads();
  const int kq = t & 7;
#pragma unroll
  for (int j = 0; j < 8; ++j) {
    int n = (t >> 3) + 32 * j;
    const float* r = sm + (kq * 8) * 257 + n;
    uint4 o;
    o.x = pk_bf16(r[0], r[257]); o.y = pk_bf16(r[2 * 257], r[3 * 257]); o.z = pk_bf16(r[4 * 257], r[5 * 257]); o.w = pk_bf16(r[6 * 257], r[7 * 257]);
    const int kk = k0 + kq * 8;
    if (bstep) *(uint4*)(dst + (size_t)(kk >> 5) * bstep + (size_t)(n0 + n) * 32 + (kk & 31)) = o;
    else *(uint4*)(dst + (size_t)(n0 + n) * ldk + kk) = o;
  }
  __syncthreads();
}

__device__ __forceinline__ void phase_prep(const Params& p, char* sm) {
  const int t = tid_now();
  unsigned char* ws = p.ws;
  float* mod = (float*)(ws + WS_MOD);
  const int N_ADA = 384, N_TR = 1200, N_CK = 256;
  for (int idx = blockIdx.x; idx < N_ADA + N_TR + N_CK + 1; idx += gridDim.x) {
    if (idx < N_ADA) {
      int i = idx / 96, nb = idx % 96, n0 = nb * 32;
      float* sv = (float*)sm;
      float* red = (float*)(sm + 12288);
      for (int e = t; e < 3072; e += NTHREADS) {
        int k = e / 3, cd = e % 3;
        float cv = (cd == 0) ? p.in[7][k] : p.in[6][(cd - 1) * 1024 + k];
        sv[e] = silu(cv);
      }
      __syncthreads();
      const int kg = t >> 3, c4 = (t & 7) * 4;
      float a0[4] = {0, 0, 0, 0}, a1[4] = {0, 0, 0, 0}, a2[4] = {0, 0, 0, 0};
      const float* wp = p.in[9] + ((size_t)i * 1024 + kg * 32) * 3072 + n0 + c4;
#pragma unroll 16
      for (int kk = 0; kk < 32; ++kk) {
        float4 wv = *(const float4*)(wp + (size_t)kk * 3072);
        const float* svp = sv + (kg * 32 + kk) * 3;
        float s0 = svp[0], s1 = svp[1], s2 = svp[2];
        a0[0] += s0 * wv.x; a0[1] += s0 * wv.y; a0[2] += s0 * wv.z; a0[3] += s0 * wv.w;
        a1[0] += s1 * wv.x; a1[1] += s1 * wv.y; a1[2] += s1 * wv.z; a1[3] += s1 * wv.w;
        a2[0] += s2 * wv.x; a2[1] += s2 * wv.y; a2[2] += s2 * wv.z; a2[3] += s2 * wv.w;
      }
#pragma unroll
      for (int e = 0; e < 4; ++e) { red[(kg * 3 + 0) * 32 + c4 + e] = a0[e]; red[(kg * 3 + 1) * 32 + c4 + e] = a1[e]; red[(kg * 3 + 2) * 32 + c4 + e] = a2[e]; }
      __syncthreads();
      if (t < 96) {
        int cd = t >> 5, col = t & 31;
        float sacc = p.in[10][(size_t)i * 3072 + n0 + col];
        for (int g = 0; g < 32; ++g) sacc += red[(g * 3 + cd) * 32 + col];
        mod[((size_t)i * 3 + cd) * 3072 + n0 + col] = sacc;
      }
      __syncthreads();
    } else if (idx < N_ADA + N_TR) {
      int q = idx - N_ADA;
      const float* src; u16* dst; size_t ldn, ldk; int tk, tn;
      bool q_is_cache = false;
      if (q < 320) { int j = q / 160, r = q % 160; src = p.in[11] + (size_t)j * 1024 * 2560; dst = (u16*)(ws + WS_WAI) + (size_t)j * 2560 * 1024; ldn = 2560; ldk = 1024; tk = r / 10; tn = r % 10; }
      else if (q < 448) { q -= 320; int j = q / 64, r = q % 64; src = p.in[12] + (size_t)j * 1024 * 1024; dst = (u16*)(ws + WS_WAO) + (size_t)j * 1024 * 1024; ldn = 1024; ldk = 1024; tk = r / 4; tn = r % 4; }
      else if (q < 576) { q -= 448; src = p.in[14]; dst = (u16*)(ws + WS_WPI); ldn = 2048; ldk = 1024; tk = q / 8; tn = q % 8; }
      else if (q < 592) { q -= 576; int g = q / 4, r = q % 4; src = p.in[15] + (size_t)g * 65536; dst = (u16*)(ws + WS_WPG) + (size_t)g * 65536; ldn = 256; ldk = 256; tk = r; tn = 0; }
      else if (q < 656) { q -= 592; src = p.in[17]; dst = (u16*)(ws + WS_WPO); ldn = 1024; ldk = 1024; tk = q / 4; tn = q % 4; }
      else if (q < 1040) { q -= 656; src = p.in[18]; dst = (u16*)(ws + WS_WRI); ldn = 6144; ldk = 1024; tk = q / 24; tn = q % 24; }
      else if (q < 1168) { q -= 1040; src = p.in[22]; dst = (u16*)(ws + WS_WRO); ldn = 1024; ldk = 2048; tk = q / 4; tn = q % 4; }
      else { q_is_cache = true; q -= 1168; int bj = q / 8, r = q % 8; src = p.in[3] + (size_t)bj * 512 * 256; dst = (u16*)(ws + WS_CVT) + (size_t)bj * 256 * 512; ldn = 256; ldk = 512; tk = r; tn = 0; }
      transpose_tile(src, ldn, dst, ldk, tk * 64, tn * 256, sm, q_is_cache ? 0 : ldn * 32);
    } else if (idx < N_ADA + N_TR + N_CK) {
      int q = idx - N_ADA - N_TR;
      size_t off = (size_t)q * 2048 + t * 8;
      float4 v0 = *(const float4*)(p.in[2] + off), v1 = *(const float4*)(p.in[2] + off + 4);
      *(uint4*)((u16*)(ws + WS_CK) + off) = make_uint4(pk_bf16(v0.x, v0.y), pk_bf16(v0.z, v0.w), pk_bf16(v1.x, v1.y), pk_bf16(v1.z, v1.w));
    } else {
      if (t < 16) {
        double r = 0.5623413251903491, th = 1.0;
        for (int i = 0; i < t; ++i) th *= r;
        double x2 = th * th, cs = 1.0, sn = th, tc = 1.0, ts = th;
        for (int i = 1; i < 14; ++i) { tc *= -x2 / ((2.0 * i - 1.0) * (2.0 * i)); ts *= -x2 / ((2.0 * i) * (2.0 * i + 1.0)); cs += tc; sn += ts; }
        double c = 1.0, s = 0.0;
        float* tab = (float*)(ws + WS_ROPE);
        for (int pos = 0; pos < 64; ++pos) {
          tab[(pos * 16 + t) * 2] = (float)c; tab[(pos * 16 + t) * 2 + 1] = (float)s;
          double c2 = c * cs - s * sn, s2 = s * cs + c * sn; c = c2; s = s2;
        }
      }
    }
  }
}

__device__ __forceinline__ void phase_norm(const Params& p, int layer, const float* xp, const float* xs) {
  const int t = tid_now(), lane = t & 63, w = t >> 6;
  u16* H = (u16*)(p.ws + WS_RF);
  const float* g = p.in[8] + (size_t)layer * 1024;
  for (int base = (blockIdx.x * 4 + w) * 4; base < 8192; base += gridDim.x * 16) {
    const float* x = base < 4096 ? xp + (size_t)base * 1024 : xs + (size_t)(base - 4096) * 1024;
    int cnd = base < 4096 ? 0 : 1 + ((base - 4096) >> 11);
    const float* md = (const float*)(p.ws + WS_MOD) + ((size_t)layer * 3 + cnd) * 3072;
    float4 v[4][4];
#pragma unroll
    for (int j = 0; j < 4; ++j)
#pragma unroll
      for (int i = 0; i < 4; ++i) v[j][i] = *(const float4*)(x + (size_t)j * 1024 + (i * 64 + lane) * 4);
    float rstd[4];
#pragma unroll
    for (int j = 0; j < 4; ++j) {
      float ss = 0.f;
#pragma unroll
      for (int i = 0; i < 4; ++i) ss += v[j][i].x * v[j][i].x + v[j][i].y * v[j][i].y + v[j][i].z * v[j][i].z + v[j][i].w * v[j][i].w;
#pragma unroll
      for (int o = 32; o > 0; o >>= 1) ss += __shfl_xor(ss, o);
      rstd[j] = rsqrtf(ss * (1.f / 1024.f) + 1e-6f);
    }
#pragma unroll
    for (int i = 0; i < 4; ++i) {
      int c = (i * 64 + lane) * 4;
      float4 gv = *(const float4*)(g + c), sh = *(const float4*)(md + c), sc = *(const float4*)(md + 1024 + c);
      float m0 = gv.x * (1.f + sc.x), m1 = gv.y * (1.f + sc.y), m2 = gv.z * (1.f + sc.z), m3 = gv.w * (1.f + sc.w);
#pragma unroll
      for (int j = 0; j < 4; ++j) {
        float h0 = v[j][i].x * rstd[j] * m0 + sh.x, h1 = v[j][i].y * rstd[j] * m1 + sh.y;
        float h2 = v[j][i].z * rstd[j] * m2 + sh.z, h3 = v[j][i].w * rstd[j] * m3 + sh.w;
        uint2 pk; pk.x = pk_bf16(h0, h1); pk.y = pk_bf16(h2, h3);
        *(uint2*)(H + (size_t)(c >> 5) * 262144 + (size_t)(base + j) * 32 + (c & 31)) = pk;
      }
    }
  }
}

__device__ __forceinline__ void phase_final_norm(const Params& p) {
  const int t = tid_now(), lane = t & 63, w = t >> 6;
  const float* g = p.in[23];
  for (int base = (blockIdx.x * 4 + w) * 4; base < 8192; base += gridDim.x * 16) {
    float* x = p.out + (size_t)base * 1024;
    float4 v[4][4];
#pragma unroll
    for (int j = 0; j < 4; ++j)
#pragma unroll
      for (int i = 0; i < 4; ++i) v[j][i] = *(const float4*)(x + (size_t)j * 1024 + (i * 64 + lane) * 4);
    float rstd[4];
#pragma unroll
    for (int j = 0; j < 4; ++j) {
      float ss = 0.f;
#pragma unroll
      for (int i = 0; i < 4; ++i) ss += v[j][i].x * v[j][i].x + v[j][i].y * v[j][i].y + v[j][i].z * v[j][i].z + v[j][i].w * v[j][i].w;
#pragma unroll
      for (int o = 32; o > 0; o >>= 1) ss += __shfl_xor(ss, o);
      rstd[j] = rsqrtf(ss * (1.f / 1024.f) + 1e-6f);
    }
#pragma unroll
    for (int i = 0; i < 4; ++i) {
      int c = (i * 64 + lane) * 4;
      float4 gv = *(const float4*)(g + c);
#pragma unroll
      for (int j = 0; j < 4; ++j) {
        float4 o; o.x = v[j][i].x * rstd[j] * gv.x; o.y = v[j][i].y * rstd[j] * gv.y; o.z = v[j][i].z * rstd[j] * gv.z; o.w = v[j][i].w * rstd[j] * gv.w;
        *(float4*)(x + (size_t)j * 1024 + c) = o;
      }
    }
  }
}

__device__ __forceinline__ void phase_outproj(const Params& p, int layer, const u16* Y, int K, const u16* Wt, const float* xp, const float* xs, char* sm) {
  WAVE_IDS;
  float* X = p.out;
  for (int idx = blockIdx.x; idx < 512; idx += gridDim.x) {
    int mt = idx & 63, nt = idx >> 6;
    f32x4 acc[4][4];
#pragma unroll
    for (int m = 0; m < 4; ++m)
#pragma unroll
      for (int n = 0; n < 4; ++n) acc[m][n] = (f32x4){0.f, 0.f, 0.f, 0.f};
    gemm_core_glds(Y + (size_t)mt * 128 * 32, 262144, Wt + (size_t)nt * 128 * 32, 1024 * 32, K, acc, sm);
    int row0 = mt * 128, col0 = nt * 128;
    int cnd = row0 < 4096 ? 0 : 1 + ((row0 - 4096) >> 11);
    const float* gate = (const float*)(p.ws + WS_MOD) + ((size_t)layer * 3 + cnd) * 3072 + 2048;
    const float* xres = row0 < 4096 ? xp + (size_t)row0 * 1024 : xs + (size_t)(row0 - 4096) * 1024;
    const int c4 = (t & 31) * 4, rb = t >> 5;
    const float4 g4 = *(const float4*)(gate + col0 + c4);
    float4 xv[16];
#pragma unroll
    for (int i = 0; i < 16; ++i) xv[i] = *(const float4*)(xres + (size_t)(rb + 8 * i) * 1024 + col0 + c4);
    float* cs = (float*)sm;
#pragma unroll
    for (int m = 0; m < 4; ++m) {
#pragma unroll
      for (int n = 0; n < 4; ++n)
#pragma unroll
        for (int r = 0; r < 4; ++r) cs[AROW(m, r) * 132 + ACOL(n)] = acc[m][n][r];
      __builtin_amdgcn_sched_barrier(0);
    }
    __syncthreads();
#pragma unroll
    for (int i = 0; i < 16; ++i) {
      const float4 a = *(const float4*)(cs + (rb + 8 * i) * 132 + c4);
      float4 o; o.x = xv[i].x + g4.x * a.x; o.y = xv[i].y + g4.y * a.y; o.z = xv[i].z + g4.z * a.z; o.w = xv[i].w + g4.w * a.w;
      *(float4*)(X + (size_t)(row0 + rb + 8 * i) * 1024 + col0 + c4) = o;
    }
    __syncthreads();
  }
}

__device__ __forceinline__ void attn_inproj_epi(const Params& p, int j, int mt, int nt, f32x4 (&acc)[4][4], char* sm) {
  WAVE_IDS;
  u16* Q = (u16*)(p.ws + WS_RA);
  u16* Kb = (u16*)(p.ws + WS_RB);
  u16* VTp = (u16*)(p.ws + WS_RD);
  u16* VTs = VTp + (size_t)16 * 256 * 256;
  u16* SZ = (u16*)(p.ws + WS_RE);
  const float* rope = (const float*)(p.ws + WS_ROPE);
  const int row0 = mt * 128;
  const bool sample = row0 >= 4096;
  if (nt < 10 && sample) {
#pragma unroll
    for (int m = 0; m < 4; ++m) {
      __builtin_amdgcn_sched_barrier(0);
#pragma unroll
      for (int r = 0; r < 4; ++r) {
        int tk = (row0 + AROW(m, r) - 4096) & 2047;
        int rp = tk >> 6, cp = tk & 63;
        float2 a = *(const float2*)(rope + (rp * 16 + fr) * 2), b = *(const float2*)(rope + (cp * 16 + fr) * 2);
        float x1r = acc[m][0][r], x2r = acc[m][1][r], x1c = acc[m][2][r], x2c = acc[m][3][r];
        acc[m][0][r] = x1r * a.x - x2r * a.y; acc[m][1][r] = x2r * a.x + x1r * a.y;
        acc[m][2][r] = x1c * b.x - x2c * b.y; acc[m][3][r] = x2c * b.x + x1c * b.y;
      }
    }
  }
  if (nt < 8) {
    epi_store_bf16(acc, sm, Q + (size_t)row0 * 1024 + nt * 128, 1024, IdF());
  } else if (nt < 10) {
    int c0 = (nt - 8) * 128;
    if (!sample) {
      int b = row0 >> 8, t0 = row0 & 255;
      float* dk = p.out + O_NK + ((size_t)(b * 2 + j) * 256 + t0) * 256 + c0;
#pragma unroll
      for (int m = 0; m < 4; ++m) {
        float* pm = opaque(dk + (size_t)AROW(m, 0) * 256 + ACOL(0));
#pragma unroll
        for (int n = 0; n < 4; ++n)
#pragma unroll
          for (int r = 0; r < 4; ++r) pm[r * 256 + n * 16] = acc[m][n][r];
        __builtin_amdgcn_sched_barrier(0);
      }
    }
    epi_store_bf16(acc, sm, Kb + (size_t)row0 * 256 + c0, 256, IdF());
  } else if (nt < 12) {
    int c0 = (nt - 10) * 128;
    if (!sample) {
      int b = row0 >> 8, t0 = row0 & 255;
      float* dv = p.out + O_NV + ((size_t)(b * 2 + j) * 256 + t0) * 256 + c0;
#pragma unroll
      for (int m = 0; m < 4; ++m) {
        float* pm = opaque(dv + (size_t)AROW(m, 0) * 256 + ACOL(0));
#pragma unroll
        for (int n = 0; n < 4; ++n)
#pragma unroll
          for (int r = 0; r < 4; ++r) pm[r * 256 + n * 16] = acc[m][n][r];
        __builtin_amdgcn_sched_barrier(0);
      }
      epi_store_bf16_T(acc, VTp + ((size_t)b * 256 + c0) * 256 + t0, 256, IdF());
    } else {
      int s = (row0 - 4096) >> 11, t0 = (row0 - 4096) & 2047;
      epi_store_bf16_T(acc, VTs + ((size_t)s * 256 + c0) * 2048 + t0, 2048, IdF());
    }
  } else {
    epi_store_bf16(acc, sm, SZ + (size_t)row0 * 1024 + (nt - 12) * 128, 1024, SiluF());
  }
}

__device__ __forceinline__ void phase_attn_inproj(const Params& p, int j, char* sm) {
  const u16* H = (const u16*)(p.ws + WS_RF);
  const u16* W = (const u16*)(p.ws + WS_WAI) + (size_t)j * 2560 * 1024;
  for (int idx = blockIdx.x; idx < 768; idx += gridDim.x) {
    if (idx < 512) {
      const int mt = idx & 63, nt2 = idx >> 6;
      f32x4 accL[4][4], accR[4][4];
#pragma unroll
      for (int m = 0; m < 4; ++m)
#pragma unroll
        for (int n = 0; n < 4; ++n) { accL[m][n] = (f32x4){0.f, 0.f, 0.f, 0.f}; accR[m][n] = (f32x4){0.f, 0.f, 0.f, 0.f}; }
      gemm_core_glds2(H + (size_t)mt * 128 * 32, 262144, W + (size_t)nt2 * 256 * 32, 2560 * 32, 1024, accL, accR, sm);
      attn_inproj_epi(p, j, mt, nt2 * 2, accL, sm);
      attn_inproj_epi(p, j, mt, nt2 * 2 + 1, accR, sm);
    } else {
      const int j2 = idx - 512, mt = j2 & 63, nt = 16 + (j2 >> 6);
      f32x4 acc[4][4];
#pragma unroll
      for (int m = 0; m < 4; ++m)
#pragma unroll
        for (int n = 0; n < 4; ++n) acc[m][n] = (f32x4){0.f, 0.f, 0.f, 0.f};
      gemm_core_glds(H + (size_t)mt * 128 * 32, 262144, W + (size_t)nt * 128 * 32, 2560 * 32, 1024, acc, sm);
      attn_inproj_epi(p, j, mt, nt, acc, sm);
    }
  }
}

__device__ __forceinline__ void attn_comp64_lds(const char* sk, const char* sv, const bf16x8 (&qf)[2][2], f32x4 (&oacc)[4][2],
                                                float (&mrun)[2], float (&lrun)[2], bool masked, int key0, int qbase, float sc2, int fr, int fq) {
  f32x4 s[4][2];
#pragma unroll
  for (int m = 0; m < 4; ++m) {
    const int krow = 32 * (m >> 1) + 8 * (fr >> 2) + 4 * (m & 1) + (fr & 3);
    bf16x8 k0 = *(const bf16x8*)(sk + lds_off(krow, fq * 8));
    bf16x8 k1 = *(const bf16x8*)(sk + lds_off(krow, 32 + fq * 8));
#pragma unroll
    for (int n = 0; n < 2; ++n) {
      s[m][n] = mfma16(k0, qf[n][0], (f32x4){0.f, 0.f, 0.f, 0.f});
      s[m][n] = mfma16(k1, qf[n][1], s[m][n]);
    }
  }
  if (masked) {
#pragma unroll
    for (int n = 0; n < 2; ++n)
#pragma unroll
      for (int m = 0; m < 4; ++m)
#pragma unroll
        for (int r = 0; r < 4; ++r) {
          int kpos = key0 + 32 * (m >> 1) + 8 * fq + 4 * (m & 1) + r, qpos = qbase + 16 * n + fr;
          int dd = qpos - kpos; dd = dd < 0 ? -dd : dd;
          s[m][n][r] = dd <= 128 ? s[m][n][r] : -1.0e30f;
        }
  }
#pragma unroll
  for (int n = 0; n < 2; ++n) {
    float mx = -3.0e38f;
#pragma unroll
    for (int m = 0; m < 4; ++m)
#pragma unroll
      for (int r = 0; r < 4; ++r) { float v = s[m][n][r] * sc2; s[m][n][r] = v; mx = fmaxf(mx, v); }
    mx = fmaxf(mx, __shfl_xor(mx, 16));
    mx = fmaxf(mx, __shfl_xor(mx, 32));
    float mnew = fmaxf(mrun[n], mx);
    float alpha = fexp2(mrun[n] - mnew);
    mrun[n] = mnew;
    float ls = 0.f;
#pragma unroll
    for (int m = 0; m < 4; ++m)
#pragma unroll
      for (int r = 0; r < 4; ++r) { float pv = fexp2(s[m][n][r] - mnew); s[m][n][r] = pv; ls += pv; }
    lrun[n] = lrun[n] * alpha + ls;
#pragma unroll
    for (int dt = 0; dt < 4; ++dt) oacc[dt][n] *= alpha;
  }
#pragma unroll
  for (int s2 = 0; s2 < 2; ++s2) {
    bf16x8 vf[4];
#pragma unroll
    for (int dt = 0; dt < 4; ++dt) vf[dt] = *(const bf16x8*)(sv + lds_off(dt * 16 + fr, s2 * 32 + fq * 8));
#pragma unroll
    for (int n = 0; n < 2; ++n) {
      union { bf16x8 v; unsigned u[4]; } pf;
      pf.u[0] = pk_bf16(s[2 * s2][n][0], s[2 * s2][n][1]); pf.u[1] = pk_bf16(s[2 * s2][n][2], s[2 * s2][n][3]);
      pf.u[2] = pk_bf16(s[2 * s2 + 1][n][0], s[2 * s2 + 1][n][1]); pf.u[3] = pk_bf16(s[2 * s2 + 1][n][2], s[2 * s2 + 1][n][3]);
#pragma unroll
      for (int dt = 0; dt < 4; ++dt) oacc[dt][n] = mfma16(vf[dt], pf.v, oacc[dt][n]);
    }
  }
}

__device__ __forceinline__ void phase_attn(const Params& p, int j, char* sm) {
  const int t = tid_now(), lane = t & 63, w = t >> 6, fr = lane & 15, fq = lane >> 4;
  const u16* Q = (const u16*)(p.ws + WS_RA);
  const u16* Kb = (const u16*)(p.ws + WS_RB);
  const u16* VTp = (const u16*)(p.ws + WS_RD);
  const u16* VTs = VTp + (size_t)16 * 256 * 256;
  const u16* SZ = (const u16*)(p.ws + WS_RE);
  const u16* cK = (const u16*)(p.ws + WS_CK);
  const u16* cVT = (const u16*)(p.ws + WS_CVT);
  u16* Y = (u16*)(p.ws + WS_RC);
  const float sc2 = 0.125f * LOG2E;
  const int lrow = t >> 3, lcol = (t & 7) * 8;
  for (int idx = blockIdx.x; idx < 1024; idx += gridDim.x) {
    const bool sample = idx < 512;
    int hq, qb, rowbase, sb;
    if (sample) { sb = idx >> 8; hq = (idx >> 4) & 15; qb = idx & 15; rowbase = 4096 + sb * 2048; }
    else { int ii = idx - 512; sb = ii >> 5; hq = (ii >> 1) & 15; qb = ii & 1; rowbase = sb * 256; }
    const int kvh = hq >> 2;
    const int Q0 = qb * 128, q0 = Q0 + w * 32;
    bf16x8 qf[2][2];
#pragma unroll
    for (int n = 0; n < 2; ++n)
#pragma unroll
      for (int ks = 0; ks < 2; ++ks) qf[n][ks] = *(const bf16x8*)(Q + (size_t)(rowbase + q0 + 16 * n + fr) * 1024 + hq * 64 + ks * 32 + fq * 8);
    f32x4 oacc[4][2];
#pragma unroll
    for (int dt = 0; dt < 4; ++dt)
#pragma unroll
      for (int n = 0; n < 2; ++n) oacc[dt][n] = (f32x4){0.f, 0.f, 0.f, 0.f};
    const float sink2 = p.in[13][j * 16 + hq] * LOG2E;
    float mrun[2] = {sink2, sink2}, lrun[2] = {0.f, 0.f};
    const u16 *K1, *V1, *K2, *V2;
    size_t ldv1, ldv2 = 2048;
    int n1, n2 = 0, lo = 0;
    if (sample) {
      K1 = cK + ((size_t)(sb * 2 + j) * 512) * 256 + kvh * 64;
      V1 = cVT + ((size_t)(sb * 2 + j) * 256 + kvh * 64) * 512; ldv1 = 512; n1 = 8;
      K2 = Kb + (size_t)rowbase * 256 + kvh * 64;
      V2 = VTs + ((size_t)sb * 256 + kvh * 64) * 2048;
      lo = Q0 - 128; lo = lo < 0 ? 0 : lo;
      int hi = Q0 + 256; hi = hi > 2048 ? 2048 : hi;
      n2 = (hi - lo) >> 6;
    } else {
      K1 = Kb + (size_t)rowbase * 256 + kvh * 64;
      V1 = VTp + ((size_t)sb * 256 + kvh * 64) * 256; ldv1 = 256; n1 = 4;
      K2 = K1; V2 = V1;
    }
    const int total = n1 + n2;
    u32x4 rk[2], rv[2];
#define AT_GLOAD(i) do { const u16* _kp; const u16* _vp; size_t _ldv; \
      if ((i) < n1) { _kp = K1 + (size_t)(i) * 64 * 256; _vp = V1 + (i) * 64; _ldv = ldv1; } \
      else { int _k0 = lo + ((i) - n1) * 64; _kp = K2 + (size_t)_k0 * 256; _vp = V2 + _k0; _ldv = ldv2; } \
      _Pragma("unroll") for (int _i = 0; _i < 2; ++_i) { \
        rk[_i] = *(const u32x4*)(_kp + (size_t)(lrow + 32 * _i) * 256 + lcol); \
        rv[_i] = *(const u32x4*)(_vp + (size_t)(lrow + 32 * _i) * _ldv + lcol); } } while (0)
#define AT_LSTORE(buf) do { _Pragma("unroll") for (int _i = 0; _i < 2; ++_i) { \
        *(u32x4*)(sm + (buf) * 16384 + lds_off(lrow + 32 * _i, lcol)) = rk[_i]; \
        *(u32x4*)(sm + (buf) * 16384 + 8192 + lds_off(lrow + 32 * _i, lcol)) = rv[_i]; } } while (0)
    AT_GLOAD(0);
    AT_LSTORE(0);
    __syncthreads();
    for (int i = 0; i < total; ++i) {
      const int cur = i & 1;
      if (i + 1 < total) AT_GLOAD(i + 1);
      const bool masked = i >= n1;
      const int key0 = lo + (i - n1) * 64;
      const bool skip = masked && (key0 + 63 < q0 - 128 || key0 > q0 + 31 + 128);
      if (!skip) attn_comp64_lds(sm + cur * 16384, sm + cur * 16384 + 8192, qf, oacc, mrun, lrun, masked, key0, q0, sc2, fr, fq);
      if (i + 1 < total) AT_LSTORE(cur ^ 1);
      __syncthreads();
    }
#undef AT_GLOAD
#undef AT_LSTORE
#pragma unroll
    for (int n = 0; n < 2; ++n) {
      float lt = lrun[n];
      lt += __shfl_xor(lt, 16);
      lt += __shfl_xor(lt, 32);
      float inv = 1.f / (lt + fexp2(sink2 - mrun[n]));
      size_t row = (size_t)(rowbase + q0 + 16 * n + fr);
#pragma unroll
      for (int dt = 0; dt < 4; ++dt) {
        int d0 = hq * 64 + dt * 16 + 4 * fq;
        uint2 zz = *(const uint2*)(SZ + row * 1024 + d0);
        uint2 o;
        o.x = pk_bf16(oacc[dt][n][0] * inv * bflo(zz.x), oacc[dt][n][1] * inv * bfhi(zz.x));
        o.y = pk_bf16(oacc[dt][n][2] * inv * bflo(zz.y), oacc[dt][n][3] * inv * bfhi(zz.y));
        *(uint2*)(Y + (size_t)(d0 >> 5) * 262144 + row * 32 + (d0 & 31)) = o;
      }
    }
  }
}

__device__ __forceinline__ void phase_pool_inproj(const Params& p, char* sm) {
  const u16* H = (const u16*)(p.ws + WS_RF);
  const u16* W = (const u16*)(p.ws + WS_WPI);
  u16* U = (u16*)(p.ws + WS_RD);
  u16* SZ = (u16*)(p.ws + WS_RE);
  for (int idx = blockIdx.x; idx < 64 * 8; idx += gridDim.x) {
    int mt = idx & 63, nt2 = idx >> 6;
    f32x4 accL[4][4], accR[4][4];
#pragma unroll
    for (int m = 0; m < 4; ++m)
#pragma unroll
      for (int n = 0; n < 4; ++n) { accL[m][n] = (f32x4){0.f, 0.f, 0.f, 0.f}; accR[m][n] = (f32x4){0.f, 0.f, 0.f, 0.f}; }
    gemm_core_glds2(H + (size_t)mt * 128 * 32, 262144, W + (size_t)nt2 * 256 * 32, 2048 * 32, 1024, accL, accR, sm);
    if (nt2 < 4) {
      epi_store_bf16(accL, sm, U + (size_t)mt * 128 * 1024 + nt2 * 256, 1024, IdF());
      epi_store_bf16(accR, sm, U + (size_t)mt * 128 * 1024 + nt2 * 256 + 128, 1024, IdF());
    } else {
      epi_store_bf16(accL, sm, SZ + (size_t)mt * 128 * 1024 + (nt2 - 4) * 256, 1024, SiluF());
      epi_store_bf16(accR, sm, SZ + (size_t)mt * 128 * 1024 + (nt2 - 4) * 256 + 128, 1024, SiluF());
    }
  }
}

struct PoolEpiF {
  const float* scale;
  __device__ __forceinline__ float operator()(int r, int c, float v) const { return v * scale[c]; }
};
template <int W>
__device__ __forceinline__ void pool_d_strip(const u16* __restrict__ uc, u16* __restrict__ dc, int t0, int L) {
  constexpr int LEFT = W / 2, RIGHT = W - 1 - LEFT;
  float pre[49];
  pre[0] = 0.f;
  float ctr[32];
#pragma unroll
  for (int k = 0; k < 48; ++k) {
    int pos = t0 - 8 + k;
    float v = 0.f;
    if (k >= 8 - LEFT && k < 40 + RIGHT) {
      int pc = pos < 0 ? 0 : (pos >= L ? L - 1 : pos);
      float lv = bf2f(uc[(ptrdiff_t)(pc - t0) * 1024]);
      v = (pos >= 0 && pos < L) ? lv : 0.f;
    }
    pre[k + 1] = pre[k] + v;
    if (k >= 8 && k < 40) ctr[k - 8] = v;
  }
#pragma unroll
  for (int i = 0; i < 32; ++i) {
    int pos = t0 + i;
    int lo = pos - LEFT; lo = lo < 0 ? 0 : lo;
    int hi = pos + RIGHT + 1; hi = hi > L ? L : hi;
    float sum = pre[i + 8 + RIGHT + 1] - pre[i + 8 - LEFT];
    dc[(size_t)i * 32] = f2bf(sum / (float)(hi - lo) - ctr[i]);
  }
}
__device__ __forceinline__ void phase_pool_d(const Params& p) {
  const int t = tid_now();
  const u16* U = (const u16*)(p.ws + WS_RD);
  u16* Dm = (u16*)(p.ws + WS_RD + 16 * MiB);
  for (int idx = blockIdx.x; idx < 1024; idx += gridDim.x) {
    const int g = idx & 3, strip = idx >> 2;
    const int row0 = strip * 32;
    int L, t0;
    if (row0 < 4096) { L = 256; t0 = row0 & 255; } else { L = 2048; t0 = (row0 - 4096) & 2047; }
    const u16* uc = U + (size_t)row0 * 1024 + g * 256 + t;
    const int dcol = g * 256 + t;
    u16* dc = Dm + (size_t)(dcol >> 5) * 262144 + (size_t)row0 * 32 + (dcol & 31);
    if (g == 0) pool_d_strip<2>(uc, dc, t0, L);
    else if (g == 1) pool_d_strip<4>(uc, dc, t0, L);
    else if (g == 2) pool_d_strip<8>(uc, dc, t0, L);
    else pool_d_strip<16>(uc, dc, t0, L);
  }
}
__device__ __forceinline__ void phase_pool_gemm(const Params& p, char* sm) {
  const u16* Dm = (const u16*)(p.ws + WS_RD + 16 * MiB);
  const u16* SZ = (const u16*)(p.ws + WS_RE);
  u16* Y = (u16*)(p.ws + WS_RC);
  const u16* Wg = (const u16*)(p.ws + WS_WPG);
  for (int idx = blockIdx.x; idx < 512; idx += gridDim.x) {
    const int mt = idx & 63, gn = idx >> 6, g = gn >> 1, n2 = gn & 1;
    const int row0 = mt * 128;
    f32x4 acc[4][4];
#pragma unroll
    for (int m = 0; m < 4; ++m)
#pragma unroll
      for (int n = 0; n < 4; ++n) acc[m][n] = (f32x4){0.f, 0.f, 0.f, 0.f};
    gemm_core_glds(Dm + (size_t)(g * 8) * 262144 + (size_t)row0 * 32, 262144, Wg + (size_t)g * 65536 + (size_t)n2 * 128 * 32, 256 * 32, 256, acc, sm);
    int c0 = g * 256 + n2 * 128;
    PoolEpiF f{p.in[16] + c0};
    epi_store_bf16_img(acc, sm, Y, row0, c0, f, SZ + (size_t)row0 * 1024 + c0, 1024);
  }
}

__device__ __forceinline__ void phase_ret_inproj(const Params& p, char* sm) {
  const u16* H = (const u16*)(p.ws + WS_RF);
  const u16* W = (const u16*)(p.ws + WS_WRI);
  u16* Q = (u16*)(p.ws + WS_RA);
  u16* Kb = (u16*)(p.ws + WS_RB);
  u16* KTp = (u16*)(p.ws + WS_RC);
  u16* KTs = KTp + (size_t)16 * 1024 * 256;
  u16* VTp = (u16*)(p.ws + WS_RD);
  u16* VTs = VTp + (size_t)16 * 2048 * 256;
  u16* SZ = (u16*)(p.ws + WS_RE);
  for (int idx = blockIdx.x; idx < 64 * 24; idx += gridDim.x) {
    int mt = idx & 63, nt2 = idx >> 6;
    f32x4 accL[4][4], accR[4][4];
#pragma unroll
    for (int m = 0; m < 4; ++m)
#pragma unroll
      for (int n = 0; n < 4; ++n) { accL[m][n] = (f32x4){0.f, 0.f, 0.f, 0.f}; accR[m][n] = (f32x4){0.f, 0.f, 0.f, 0.f}; }
    gemm_core_glds2(H + (size_t)mt * 128 * 32, 262144, W + (size_t)nt2 * 256 * 32, 6144 * 32, 1024, accL, accR, sm);
    const int row0 = mt * 128;
    const bool sample = row0 >= 4096;
    int sb, t0;
    if (!sample) { sb = row0 >> 8; t0 = row0 & 255; } else { sb = (row0 - 4096) >> 11; t0 = (row0 - 4096) & 2047; }
#pragma unroll
    for (int half = 0; half < 2; ++half) {
    f32x4 (&acc)[4][4] = half ? accR : accL;
    const int nt = nt2 * 2 + half;
    if (nt < 8) {
      epi_store_bf16_img(acc, sm, Q, row0, nt * 128, IdF());
    } else if (nt < 16) {
      int c0 = (nt - 8) * 128;
      ScaleF f{0.0625f};
      if (!sample) epi_store_bf16_T(acc, KTp + ((size_t)sb * 1024 + c0) * 256 + t0, 256, f);
      else epi_store_bf16_T(acc, KTs + ((size_t)sb * 1024 + c0) * 2048 + t0, 2048, f);
      epi_store_bf16_img(acc, sm, Kb, row0, c0, f);
    } else if (nt < 32) {
      int c0 = (nt - 16) * 128;
      if (!sample) epi_store_bf16_T(acc, VTp + ((size_t)sb * 2048 + c0) * 256 + t0, 256, IdF());
      else epi_store_bf16_T(acc, VTs + ((size_t)sb * 2048 + c0) * 2048 + t0, 2048, IdF());
    } else {
      epi_store_bf16_img(acc, sm, SZ, row0, (nt - 32) * 128, SiluF());
    }
    }
  }
}

__device__ __forceinline__ void scan_sample64(const Params& p, int ii, char* sm) {
  const int t = tid_now(), lane = t & 63, w = t >> 6, wm = w >> 1, wn = w & 1, fr = lane & 15, fq = lane >> 4;
  const int et8 = ii & 7, dt4 = (ii >> 3) & 3, dir = (ii >> 5) & 1, h = (ii >> 6) & 3, sb = ii >> 8;
  const u16* KTs = (const u16*)(p.ws + WS_RC) + (size_t)16 * 1024 * 256;
  const u16* VTs = (const u16*)(p.ws + WS_RD) + (size_t)16 * 2048 * 256;
  u16* SNAP = (u16*)(p.ws + WS_RF);
  const float lg2 = logsig2((dir ? p.in[20] : p.in[19])[h]);
  const float cdec = fexp2(128.f * lg2);
  const int lrow = t >> 4, kc = t & 15;
  const u16* Ap = KTs + ((size_t)sb * 1024 + h * 256 + dt4 * 64 + lrow) * 2048 + kc * 8;
  const u16* Bp = VTs + ((size_t)sb * 2048 + h * 512 + et8 * 64 + lrow) * 2048 + kc * 8;
  const int ldst = (kc >> 3) * 8192 + lds_off(lrow, (kc & 7) * 8);
  float fs[8];
#pragma unroll
  for (int e = 0; e < 8; ++e) { int jj = kc * 8 + e; fs[e] = fexp2((float)(dir ? jj : 127 - jj) * lg2); }
  f32x4 acc[2][2];
  {
    const float* st = (dir ? p.in[5] : p.in[4]) + ((size_t)(sb * 4 + h) * 256 + dt4 * 64 + wm * 32) * 512 + et8 * 64 + wn * 32;
#pragma unroll
    for (int m = 0; m < 2; ++m)
#pragma unroll
      for (int n = 0; n < 2; ++n)
#pragma unroll
        for (int r = 0; r < 4; ++r) acc[m][n][r] = st[(size_t)(m * 16 + fq * 4 + r) * 512 + n * 16 + fr];
  }
  u32x4 ra[4], rb[4];
#define S6_GLOAD(cc) do { const size_t _o = (size_t)((dir ? 15 - (cc) : (cc)) * 128); _Pragma("unroll") for (int i = 0; i < 4; ++i) { \
    ra[i] = *(const u32x4*)(Ap + (size_t)(16 * i) * 2048 + _o); rb[i] = *(const u32x4*)(Bp + (size_t)(16 * i) * 2048 + _o); } } while (0)
#define S6_LSTORE(buf) do { _Pragma("unroll") for (int i = 0; i < 4; ++i) { u32x4 _v = ra[i], _o; \
    _o[0] = pk_bf16(bflo(_v[0]) * fs[0], bfhi(_v[0]) * fs[1]); _o[1] = pk_bf16(bflo(_v[1]) * fs[2], bfhi(_v[1]) * fs[3]); \
    _o[2] = pk_bf16(bflo(_v[2]) * fs[4], bfhi(_v[2]) * fs[5]); _o[3] = pk_bf16(bflo(_v[3]) * fs[6], bfhi(_v[3]) * fs[7]); \
    *(u32x4*)(sm + (buf) * 32768 + ldst + i * 2048) = _o; *(u32x4*)(sm + (buf) * 32768 + 16384 + ldst + i * 2048) = rb[i]; } } while (0)
  S6_GLOAD(0);
  S6_LSTORE(0);
  __syncthreads();
  for (int cc = 0; cc < 15; ++cc) {
    const int cur = cc & 1;
    if (cc + 1 < 15) S6_GLOAD(cc + 1);
    {
      const int c = dir ? 15 - cc : cc;
      u16* sp = SNAP + (size_t)(((sb * 16 + c) * 4 + h) * 2 + dir) * 131072 + (size_t)(dt4 * 2 + wm) * 16384 + (size_t)(et8 * 64 + wn * 32 + fr) * 32 + fq * 4;
#pragma unroll
      for (int m = 0; m < 2; ++m)
#pragma unroll
        for (int n = 0; n < 2; ++n) {
          uint2 pk; pk.x = pk_bf16(acc[m][n][0], acc[m][n][1]); pk.y = pk_bf16(acc[m][n][2], acc[m][n][3]);
          *(uint2*)(sp + (size_t)(n * 16) * 32 + m * 16) = pk;
          acc[m][n] *= cdec;
        }
    }
    const char* sa = sm + cur * 32768;
    const char* sb2 = sa + 16384;
#pragma unroll
    for (int kh = 0; kh < 2; ++kh)
#pragma unroll
      for (int ks = 0; ks < 2; ++ks) {
        bf16x8 a[2], b[2];
#pragma unroll
        for (int m = 0; m < 2; ++m) a[m] = *(const bf16x8*)(sa + kh * 8192 + lds_off(wm * 32 + m * 16 + fr, ks * 32 + fq * 8));
#pragma unroll
        for (int n = 0; n < 2; ++n) b[n] = *(const bf16x8*)(sb2 + kh * 8192 + lds_off(wn * 32 + n * 16 + fr, ks * 32 + fq * 8));
#pragma unroll
        for (int m = 0; m < 2; ++m)
#pragma unroll
          for (int n = 0; n < 2; ++n) acc[m][n] = mfma16(a[m], b[n], acc[m][n]);
      }
    if (cc + 1 < 15) S6_LSTORE(cur ^ 1);
    __syncthreads();
  }
#undef S6_GLOAD
#undef S6_LSTORE
  {
    const int c = dir ? 0 : 15;
    u16* sp = SNAP + (size_t)(((sb * 16 + c) * 4 + h) * 2 + dir) * 131072 + (size_t)(dt4 * 2 + wm) * 16384 + (size_t)(et8 * 64 + wn * 32 + fr) * 32 + fq * 4;
#pragma unroll
    for (int m = 0; m < 2; ++m)
#pragma unroll
      for (int n = 0; n < 2; ++n) {
        uint2 pk; pk.x = pk_bf16(acc[m][n][0], acc[m][n][1]); pk.y = pk_bf16(acc[m][n][2], acc[m][n][3]);
        *(uint2*)(sp + (size_t)(n * 16) * 32 + m * 16) = pk;
      }
  }
}

__device__ __forceinline__ void phase_ret_scan(const Params& p, char* sm) {
  WAVE_IDS;
  const u16* KTp = (const u16*)(p.ws + WS_RC);
  const u16* KTs = KTp + (size_t)16 * 1024 * 256;
  const u16* VTp = (const u16*)(p.ws + WS_RD);
  const u16* VTs = VTp + (size_t)16 * 2048 * 256;
  u16* SNAP = (u16*)(p.ws + WS_RF);
  const int lr = t >> 3, lc = (t & 7) * 8;
  for (int idx = blockIdx.x; idx < 512; idx += gridDim.x) scan_sample64(p, idx, sm);
  for (int idx = 512 + (blockIdx.x + gridDim.x - (512 % gridDim.x)) % gridDim.x; idx < 512 + 1024; idx += gridDim.x) {
    const bool sample = false;
    int ii = idx - 512;
    const int et = ii & 3, dt = (ii >> 2) & 1, dir = (ii >> 3) & 1, h = (ii >> 4) & 3, sb = ii >> 6;
    const float lg2 = logsig2((dir ? p.in[20] : p.in[19])[h]);
    const float cdec = fexp2(128.f * lg2);
    const int nch = sample ? 16 : 2;
    const int nacc = sample ? 15 : 2;
    const size_t ld = sample ? 2048 : 256;
    const u16* Ab = sample ? KTs + ((size_t)sb * 1024 + h * 256 + dt * 128) * 2048 : KTp + ((size_t)sb * 1024 + h * 256 + dt * 128) * 256;
    const u16* Bb = sample ? VTs + ((size_t)sb * 2048 + h * 512 + et * 128) * 2048 : VTp + ((size_t)sb * 2048 + h * 512 + et * 128) * 256;
    const u16* Ap = Ab + (size_t)lr * ld + lc;
    const u16* Bp = Bb + (size_t)lr * ld + lc;
    f32x4 acc[4][4];
#pragma unroll
    for (int m = 0; m < 4; ++m)
#pragma unroll
      for (int n = 0; n < 4; ++n) acc[m][n] = (f32x4){0.f, 0.f, 0.f, 0.f};
    if (sample) {
      const float* st = (dir ? p.in[5] : p.in[4]) + ((size_t)(sb * 4 + h) * 256 + dt * 128) * 512 + et * 128;
#pragma unroll
      for (int m = 0; m < 4; ++m) {
#pragma unroll
        for (int hh = 0; hh < 2; ++hh) {
          const float* pm = opaque(st + (size_t)AROW(m, 2 * hh) * 512 + ACOL(0));
#pragma unroll
          for (int n = 0; n < 4; ++n)
#pragma unroll
            for (int r = 0; r < 2; ++r) acc[m][n][2 * hh + r] = pm[r * 512 + n * 16];
        }
        __builtin_amdgcn_sched_barrier(0);
      }
    }
    float fs0[8];
#pragma unroll
    for (int e = 0; e < 8; ++e) {
      int j0 = lc + e;
      fs0[e] = fexp2((float)(dir ? j0 : 127 - j0) * lg2);
    }
    const float c64 = fexp2((dir ? 64.f : -64.f) * lg2);
    u32x4 ra[4], rb[4];
    const int nq = nacc * 2;
#define SC_TOK(q) ((size_t)((dir ? nch - 1 - ((q) >> 1) : ((q) >> 1)) * 128 + ((q) & 1) * 64))
#define SC_GLOAD(q) do { const size_t _o = SC_TOK(q); _Pragma("unroll") for (int i = 0; i < 4; ++i) { ra[i] = *(const u32x4*)(Ap + (size_t)(32 * i) * ld + _o); rb[i] = *(const u32x4*)(Bp + (size_t)(32 * i) * ld + _o); } } while (0)
#define SC_LSTORE(buf, q) do { \
    const float _cm = ((q) & 1) ? c64 : 1.f; \
    const float g0 = fs0[0] * _cm, g1 = fs0[1] * _cm, g2 = fs0[2] * _cm, g3 = fs0[3] * _cm; \
    const float g4 = fs0[4] * _cm, g5 = fs0[5] * _cm, g6 = fs0[6] * _cm, g7 = fs0[7] * _cm; \
    _Pragma("unroll") for (int i = 0; i < 4; ++i) { \
      u32x4 _v = ra[i]; u32x4 _o; \
      _o[0] = pk_bf16(bflo(_v[0]) * g0, bfhi(_v[0]) * g1); _o[1] = pk_bf16(bflo(_v[1]) * g2, bfhi(_v[1]) * g3); \
      _o[2] = pk_bf16(bflo(_v[2]) * g4, bfhi(_v[2]) * g5); _o[3] = pk_bf16(bflo(_v[3]) * g6, bfhi(_v[3]) * g7); ra[i] = _o; } \
    _Pragma("unroll") for (int i = 0; i < 4; ++i) { *(u32x4*)(sm + (buf) * 32768 + lds_off(lr + 32 * i, lc)) = ra[i]; *(u32x4*)(sm + (buf) * 32768 + 16384 + lds_off(lr + 32 * i, lc)) = rb[i]; } } while (0)
    SC_GLOAD(0);
    SC_LSTORE(0, 0);
    __syncthreads();
    for (int q = 0; q < nq; ++q) {
      const int cur = q & 1;
      if (q + 1 < nq) SC_GLOAD(q + 1);
      if ((q & 1) == 0) {
        const int cc = q >> 1, c = dir ? nch - 1 - cc : cc;
        if (sample || cc == 1) {
          int slot = sample ? ((sb * 16 + c) * 4 + h) * 2 + dir : 256 + (sb * 4 + h) * 2 + dir;
          u16* sp = SNAP + (size_t)slot * 131072;
#pragma unroll
          for (int m = 0; m < 4; ++m)
#pragma unroll
            for (int n = 0; n < 4; ++n) {
              const int dd = dt * 128 + AROW(m, 0), ee = et * 128 + ACOL(n);
              uint2 pk; pk.x = pk_bf16(acc[m][n][0], acc[m][n][1]); pk.y = pk_bf16(acc[m][n][2], acc[m][n][3]);
              *(uint2*)(sp + (size_t)(dd >> 5) * 16384 + (size_t)ee * 32 + (dd & 31)) = pk;
            }
        }
#pragma unroll
        for (int m = 0; m < 4; ++m)
#pragma unroll
          for (int n = 0; n < 4; ++n) acc[m][n] *= cdec;
      }
      const char* sa = sm + cur * 32768;
      const char* sb2 = sa + 16384;
#pragma unroll
      for (int ks = 0; ks < 2; ++ks) {
        bf16x8 a[4], b[4];
#pragma unroll
        for (int m = 0; m < 4; ++m) a[m] = *(const bf16x8*)(sa + lds_off(wm * 64 + m * 16 + fr, ks * 32 + fq * 8));
#pragma unroll
        for (int n = 0; n < 4; ++n) b[n] = *(const bf16x8*)(sb2 + lds_off(wn * 64 + n * 16 + fr, ks * 32 + fq * 8));
#pragma unroll
        for (int m = 0; m < 4; ++m)
#pragma unroll
          for (int n = 0; n < 4; ++n) acc[m][n] = mfma16(a[m], b[n], acc[m][n]);
      }
      if (q + 1 < nq) SC_LSTORE(cur ^ 1, q + 1);
      __syncthreads();
    }
#undef SC_TOK
#undef SC_GLOAD
#undef SC_LSTORE
    if (sample) {
      const int c = dir ? 0 : 15;
      u16* sp = SNAP + (size_t)(((sb * 16 + c) * 4 + h) * 2 + dir) * 131072 + (size_t)(et * 128) * 256 + dt * 128;
      epi_store_bf16_T(acc, sp, 256, IdF());
    } else {
      float* so = p.out + (dir ? O_SB : O_SF) + ((size_t)(sb * 4 + h) * 256 + dt * 128) * 512 + et * 128;
#pragma unroll
      for (int m = 0; m < 4; ++m) {
#pragma unroll
        for (int hh = 0; hh < 2; ++hh) {
          float* pm = opaque(so + (size_t)AROW(m, 2 * hh) * 512 + ACOL(0));
#pragma unroll
          for (int n = 0; n < 4; ++n)
#pragma unroll
            for (int r = 0; r < 2; ++r) pm[r * 512 + n * 16] = acc[m][n][2 * hh + r];
        }
        __builtin_amdgcn_sched_barrier(0);
      }
    }
  }
}

template <int J>
__device__ __forceinline__ void ret_ring_step(int ks, const u16* Ap, const u16* Bp, char* sm, unsigned aA, unsigned aB, int t, f32x4 (&a2)[4][8]) {
  asm volatile("s_waitcnt vmcnt(0)" ::: "memory");
  __builtin_amdgcn_s_barrier();
  if (ks + 1 < 8) {
    char* d = sm + (J ^ 1) * 36864 + t * 16;
    const int ko = (ks + 1) * 32;
    __builtin_amdgcn_global_load_lds((const unsigned*)(Ap + (size_t)(ks + 1) * 262144), (unsigned*)d, 16, 0, 0);
    const u16* bp = opaque(Bp + (size_t)(ks + 1) * 16384);
#pragma unroll
    for (int i = 0; i < 8; ++i) {
      __builtin_amdgcn_global_load_lds((const unsigned*)bp, (unsigned*)(d + 4096 + i * 4096), 16, 0, 0);
      bp = opaque(bp + 64 * 32);
    }
  }
  bf16x8 a0, a1, a2f, a3, b0, b1, b2, b3, b4, b5, b6, b7;
  asm volatile(
      "ds_read_b128 %0, %12 offset:%14\n\t"
      "ds_read_b128 %4, %13 offset:%18\n\t"
      "ds_read_b128 %5, %13 offset:%19\n\t"
      "ds_read_b128 %1, %12 offset:%15\n\t"
      "ds_read_b128 %6, %13 offset:%20\n\t"
      "ds_read_b128 %7, %13 offset:%21\n\t"
      "ds_read_b128 %2, %12 offset:%16\n\t"
      "ds_read_b128 %8, %13 offset:%22\n\t"
      "ds_read_b128 %9, %13 offset:%23\n\t"
      "ds_read_b128 %3, %12 offset:%17\n\t"
      "ds_read_b128 %10, %13 offset:%24\n\t"
      "ds_read_b128 %11, %13 offset:%25\n\t"
      "s_waitcnt lgkmcnt(0)"
      : "=&v"(a0), "=&v"(a1), "=&v"(a2f), "=&v"(a3), "=&v"(b0), "=&v"(b1), "=&v"(b2), "=&v"(b3), "=&v"(b4), "=&v"(b5), "=&v"(b6), "=&v"(b7)
      : "v"(aA), "v"(aB), "n"(J * 36864), "n"(J * 36864 + 1024), "n"(J * 36864 + 2048), "n"(J * 36864 + 3072),
        "n"(J * 36864), "n"(J * 36864 + 1024), "n"(J * 36864 + 2048), "n"(J * 36864 + 3072),
        "n"(J * 36864 + 4096), "n"(J * 36864 + 5120), "n"(J * 36864 + 6144), "n"(J * 36864 + 7168)
      : "memory");
#define RR_ROW(m, am) a2[m][0] = mfma16(am, b0, a2[m][0]); a2[m][1] = mfma16(am, b1, a2[m][1]); a2[m][2] = mfma16(am, b2, a2[m][2]); a2[m][3] = mfma16(am, b3, a2[m][3]); \
                      a2[m][4] = mfma16(am, b4, a2[m][4]); a2[m][5] = mfma16(am, b5, a2[m][5]); a2[m][6] = mfma16(am, b6, a2[m][6]); a2[m][7] = mfma16(am, b7, a2[m][7]);
  RR_ROW(0, a0) RR_ROW(1, a1) RR_ROW(2, a2f) RR_ROW(3, a3)
#undef RR_ROW
  __builtin_amdgcn_sched_barrier(0);
}
__device__ __forceinline__ void ret_ring_gemm(const u16* __restrict__ qbase, const u16* __restrict__ sbase, f32x4 (&a2)[4][8], char* sm) {
  const int t = tid_now(), lane = t & 63, w = t >> 6, fr = lane & 15, fq = lane >> 4;
  const int sb = lane * 16, swz = sb ^ (((sb >> 9) & 1) << 5);
  const int r0 = w * 16 + (swz >> 6), c0 = (swz & 63) >> 1;
  const u16* Ap = qbase + (size_t)r0 * 32 + c0;
  const u16* Bp = sbase + (size_t)r0 * 32 + c0;
  const unsigned smb = (unsigned)(uintptr_t)(LAS3 char*)sm;
  const unsigned aA = smb + lds_off32(fr, fq * 8);
  const unsigned aB = smb + 4096 + w * 8192 + lds_off32(fr, fq * 8);
  {
    char* d = sm + t * 16;
    __builtin_amdgcn_global_load_lds((const unsigned*)Ap, (unsigned*)d, 16, 0, 0);
#pragma unroll
    for (int i = 0; i < 8; ++i)
      __builtin_amdgcn_global_load_lds((const unsigned*)(Bp + (size_t)(64 * i) * 32), (unsigned*)(d + 4096 + i * 4096), 16, 0, 0);
  }
#pragma unroll 1
  for (int ks = 0; ks < 8; ks += 2) {
    ret_ring_step<0>(ks, Ap, Bp, sm, aA, aB, t, a2);
    ret_ring_step<1>(ks + 1, Ap, Bp, sm, aA, aB, t, a2);
  }
  __builtin_amdgcn_s_barrier();
}

__device__ __forceinline__ void phase_ret_out(const Params& p, char* sm) {
  for (int idx = blockIdx.x; idx < 512; idx += gridDim.x) {
    int t = tid_now();
    asm volatile("" : "+v"(t));
    const int lane = t & 63, w = t >> 6, fr = lane & 15, fq = lane >> 4;
    unsigned char* wsb = p.ws;
    asm volatile("" : "+s"(wsb));
    const u16* Q = (const u16*)(wsb + WS_RA);
    const u16* Kb = (const u16*)(wsb + WS_RB);
    const u16* VTp = (const u16*)(wsb + WS_RD);
    const u16* VTs = VTp + (size_t)16 * 2048 * 256;
    u16* SZ = (u16*)(wsb + WS_RE);
    const u16* SNAP = (const u16*)(wsb + WS_RF);
    const float* gn = p.in[21];
    int ii = idx, gc;
    if (ii < 256) gc = 32 + (ii >> 3); else { ii -= 256; gc = ii >> 3; }
    const int h = (ii >> 1) & 3, rh = ii & 1;
    const bool sample = gc >= 32;
    int sb, c;
    if (sample) { sb = (gc - 32) >> 4; c = (gc - 32) & 15; } else { sb = gc >> 1; c = gc & 1; }
    const size_t R0 = (size_t)gc * 128 + rh * 64;
    const float lgf2 = logsig2(p.in[19][h]), lgb2 = logsig2(p.in[20][h]);
    {
      f32x4 a1[4][2];
#pragma unroll
      for (int m = 0; m < 4; ++m)
#pragma unroll
        for (int n = 0; n < 2; ++n) a1[m][n] = (f32x4){0.f, 0.f, 0.f, 0.f};
      const u16* qp = Q + (size_t)(h * 8) * 262144 + (R0 + fr) * 32 + fq * 8;
      const u16* kp = Kb + (size_t)(h * 8) * 262144 + ((size_t)gc * 128 + w * 32 + fr) * 32 + fq * 8;
#pragma unroll 1
      for (int kb = 0; kb < 8; kb += 4) {
        bf16x8 af[4][4], bfr[4][2];
#pragma unroll
        for (int k2 = 0; k2 < 4; ++k2) {
#pragma unroll
          for (int m = 0; m < 4; ++m) af[k2][m] = *(const bf16x8*)(qp + (size_t)(kb + k2) * 262144 + (16 * m) * 32);
#pragma unroll
          for (int n = 0; n < 2; ++n) bfr[k2][n] = *(const bf16x8*)(kp + (size_t)(kb + k2) * 262144 + (16 * n) * 32);
        }
#pragma unroll
        for (int k2 = 0; k2 < 4; ++k2)
#pragma unroll
          for (int m = 0; m < 4; ++m)
#pragma unroll
            for (int n = 0; n < 2; ++n) a1[m][n] = mfma16(af[k2][m], bfr[k2][n], a1[m][n]);
      }
#pragma unroll
      for (int m = 0; m < 4; ++m)
#pragma unroll
        for (int n = 0; n < 2; ++n)
#pragma unroll
          for (int r = 0; r < 4; ++r) {
            int il = 16 * m + 4 * fq + r, i = rh * 64 + il, jj = w * 32 + 16 * n + fr;
            int dd = i - jj;
            float f = dd > 0 ? fexp2((float)dd * lgf2) : (dd < 0 ? fexp2((float)(-dd) * lgb2) : 2.0f);
            *(u16*)(sm + (jj >> 6) * 8192 + lds_off(il, jj & 63)) = f2bf(a1[m][n][r] * f);
          }
    }
    __syncthreads();
    f32x4 a2[4][8];
#pragma unroll
    for (int m = 0; m < 4; ++m)
#pragma unroll
      for (int n = 0; n < 8; ++n) a2[m][n] = (f32x4){0.f, 0.f, 0.f, 0.f};
    {
      const u16* vt; size_t ldv;
      if (sample) { ldv = 2048; vt = VTs + ((size_t)sb * 2048 + h * 512 + w * 128 + fr) * 2048 + c * 128 + fq * 8; }
      else { ldv = 256; vt = VTp + ((size_t)sb * 2048 + h * 512 + w * 128 + fr) * 256 + c * 128 + fq * 8; }
#pragma unroll 1
      for (int kb = 0; kb < 4; kb += 2) {
        bf16x8 bv[2][8];
#pragma unroll
        for (int k2 = 0; k2 < 2; ++k2)
#pragma unroll
          for (int n = 0; n < 8; ++n) bv[k2][n] = *(const bf16x8*)(vt + (size_t)(16 * n) * ldv + (kb + k2) * 32);
#pragma unroll
        for (int k2 = 0; k2 < 2; ++k2) {
          const int ks = kb + k2;
          bf16x8 af[4];
#pragma unroll
          for (int m = 0; m < 4; ++m) af[m] = *(const bf16x8*)(sm + (ks >> 1) * 8192 + lds_off(16 * m + fr, (ks & 1) * 32 + fq * 8));
#pragma unroll
          for (int n = 0; n < 8; ++n)
#pragma unroll
            for (int m = 0; m < 4; ++m) a2[m][n] = mfma16(af[m], bv[k2][n], a2[m][n]);
        }
        __builtin_amdgcn_sched_barrier(0);
      }
    }
    __syncthreads();
    {
      int tb = tid_now();
      asm volatile("" : "+v"(tb));
      const int fq = (tb & 63) >> 4;
      bool hasF = sample || c == 1, hasB = sample || c == 0;
      int mode = 0;
#pragma unroll 1
      for (int dir = 0; dir < 2; ++dir) {
        bool has = dir == 0 ? hasF : hasB;
        if (!has) continue;
#pragma unroll
        for (int m = 0; m < 4; ++m)
#pragma unroll
          for (int r = 0; r < 4; ++r) {
            float fi = (float)(rh * 64 + 16 * m + 4 * fq + r);
            float ecur = mode == 0 ? 0.f : (fi + 1.f) * lgf2;
            float enew = dir == 0 ? (fi + 1.f) * lgf2 : (128.f - fi) * lgb2;
            float f = fexp2(ecur - enew);
#pragma unroll
            for (int n = 0; n < 8; ++n) a2[m][n][r] *= f;
          }
        mode = dir + 1;
        int slot = sample ? ((sb * 16 + c) * 4 + h) * 2 + dir : 256 + (sb * 4 + h) * 2 + dir;
        ret_ring_gemm(Q + (size_t)(h * 8) * 262144 + R0 * 32, SNAP + (size_t)slot * 131072, a2, sm);
      }
      if (mode != 0) {
#pragma unroll
        for (int m = 0; m < 4; ++m)
#pragma unroll
          for (int r = 0; r < 4; ++r) {
            float fi = (float)(rh * 64 + 16 * m + 4 * fq + r);
            float f = fexp2(mode == 1 ? (fi + 1.f) * lgf2 : (128.f - fi) * lgb2);
#pragma unroll
            for (int n = 0; n < 8; ++n) a2[m][n][r] *= f;
          }
      }
    }
    int t3 = tid_now();
    asm volatile("" : "+v"(t3));
    {
    const int lane = t3 & 63, w = t3 >> 6, fr = lane & 15, fq = lane >> 4;
    float* red = (float*)(sm + 69632);
#pragma unroll
    for (int m = 0; m < 4; ++m)
#pragma unroll
      for (int r = 0; r < 4; ++r) {
        float s1 = 0.f, s2 = 0.f;
#pragma unroll
        for (int n = 0; n < 8; ++n) { float v = a2[m][n][r]; s1 += v; s2 += v * v; }
#pragma unroll
        for (int o = 1; o < 16; o <<= 1) { s1 += __shfl_xor(s1, o); s2 += __shfl_xor(s2, o); }
        if (fr == 0) { int row = 16 * m + 4 * fq + r; red[(w * 64 + row) * 2] = s1; red[(w * 64 + row) * 2 + 1] = s2; }
      }
    __syncthreads();
    u16* stg = (u16*)(sm + w * 17408);
    float gv[8];
#pragma unroll
    for (int n = 0; n < 8; ++n) gv[n] = gn[h * 512 + w * 128 + 16 * n + fr];
#pragma unroll
    for (int m = 0; m < 4; ++m)
#pragma unroll
      for (int r = 0; r < 4; ++r) {
        int row = 16 * m + 4 * fq + r;
        float s1 = 0.f, s2 = 0.f;
#pragma unroll
        for (int ww = 0; ww < 4; ++ww) { s1 += red[(ww * 64 + row) * 2]; s2 += red[(ww * 64 + row) * 2 + 1]; }
        float mean = s1 * (1.f / 512.f);
        float var = s2 * (1.f / 512.f) - mean * mean;
        var = var < 0.f ? 0.f : var;
        float rstd = rsqrtf(var + 1e-6f);
#pragma unroll
        for (int n = 0; n < 8; ++n) stg[row * 136 + 16 * n + fr] = f2bf((a2[m][n][r] - mean) * rstd * gv[n]);
      }
#pragma unroll 8
    for (int i = 0; i < 16; ++i) {
      int row = (lane >> 4) + 4 * i, ch = lane & 15;
      uint4 yv = *(const uint4*)(stg + row * 136 + ch * 8);
      const int zc = h * 512 + w * 128 + ch * 8;
      u16* zp = SZ + (size_t)(zc >> 5) * 262144 + (R0 + row) * 32 + (zc & 31);
      uint4 zv = *(const uint4*)zp;
      uint4 o;
      o.x = pk_bf16(bflo(yv.x) * bflo(zv.x), bfhi(yv.x) * bfhi(zv.x));
      o.y = pk_bf16(bflo(yv.y) * bflo(zv.y), bfhi(yv.y) * bfhi(zv.y));
      o.z = pk_bf16(bflo(yv.z) * bflo(zv.z), bfhi(yv.z) * bfhi(zv.z));
      o.w = pk_bf16(bflo(yv.w) * bflo(zv.w), bfhi(yv.w) * bfhi(zv.w));
      *(uint4*)zp = o;
    }
    }
    __syncthreads();
  }
}

#define XB_TMO      128
#define XB_XCNT(j)  (256  + 64 * (j))
#define XB_XSUB(j)  (1280 + 64 * (j))
#define XB_XGEN(j)  (2304 + 64 * (j))
#define XB_TOP      3328
#define XB_TOPGEN   3392
#define XCD_BAR_WORDS 3456
#define XB_SPIN_CAP (1u << 18)
#define LAS __attribute__((address_space(3)))
__device__ __forceinline__ unsigned xb_ld(unsigned* p)              { return __hip_atomic_load(p, __ATOMIC_RELAXED, __HIP_MEMORY_SCOPE_AGENT); }
__device__ __forceinline__ unsigned xb_add(unsigned* p, unsigned v) { return __hip_atomic_fetch_add(p, v, __ATOMIC_RELAXED, __HIP_MEMORY_SCOPE_AGENT); }
__device__ __forceinline__ unsigned xb_xcc_id() { return (unsigned)__builtin_amdgcn_s_getreg((3 << 11) | 20) & 0xFu; }
#define XB_SPIN(cond, bar) do { unsigned _sp = 0; while (cond) { __builtin_amdgcn_s_sleep(1); \
    if ((++_sp & 255u) == 0u) { if (xb_ld(&(bar)[XB_TMO])) break; if (_sp > XB_SPIN_CAP) { atomicAdd(&(bar)[XB_TMO], 1u); break; } } } } while (0)
struct XcdBarrier { unsigned* bar; unsigned x; volatile LAS unsigned* st; };
__device__ __forceinline__ XcdBarrier xcd_barrier_post(unsigned* bar, volatile LAS unsigned* st) {
    XcdBarrier b; b.bar = bar; b.x = xb_xcc_id(); b.st = st;
    if (tid_now() == 0) (void)xb_add(&bar[XB_XCNT(b.x)], 1u);
    return b;
}
__device__ __forceinline__ void xcd_barrier_complete(unsigned* bar, unsigned x, unsigned& nloc, unsigned& nx) {
    const unsigned G = gridDim.x * gridDim.y * gridDim.z;
    unsigned sum, cnt, mine, sp = 0u;
    for (;;) {
        sum = 0u; cnt = 0u; mine = 0u;
#pragma unroll
        for (unsigned j = 0; j < 16; ++j) { const unsigned c = xb_ld(&bar[XB_XCNT(j)]); sum += c; cnt += (c > 0u) ? 1u : 0u; mine = (j == x) ? c : mine; }
        if (sum == G) break;
        __builtin_amdgcn_s_sleep(1);
        if ((++sp & 255u) == 0u) { if (xb_ld(&bar[XB_TMO])) break; if (sp > XB_SPIN_CAP) { atomicAdd(&bar[XB_TMO], 1u); break; } }
    }
    nloc = mine > 0u ? mine : 1u; nx = cnt > 0u ? cnt : 1u;
}
__device__ __forceinline__ void xcd_barrier(const XcdBarrier& b) {
    asm volatile("s_waitcnt vmcnt(0)" ::: "memory");
    __syncthreads();
    if (tid_now() == 0) {
        unsigned* bar = b.bar;
        __builtin_amdgcn_s_waitcnt(0);
        unsigned nloc = b.st[0], nx = b.st[1];
        if (nloc == 0u) { xcd_barrier_complete(bar, b.x, nloc, nx); b.st[0] = nloc; b.st[1] = nx; }
        const unsigned old = xb_add(&bar[XB_XSUB(b.x)], 1u);
        const unsigned gen = old / nloc;
        if (old + 1u == (gen + 1u) * nloc) {
            __builtin_amdgcn_fence(__ATOMIC_RELEASE, "agent");
            asm volatile("s_waitcnt vmcnt(0)" ::: "memory");
            const unsigned og = xb_add(&bar[XB_TOP], 1u);
            const unsigned tg = og / nx;
            if (og + 1u == (tg + 1u) * nx) xb_add(&bar[XB_TOPGEN], 1u);
            else XB_SPIN(xb_ld(&bar[XB_TOPGEN]) == tg, bar);
            __builtin_amdgcn_fence(__ATOMIC_ACQUIRE, "agent");
            xb_add(&bar[XB_XGEN(b.x)], 1u);
            asm volatile("s_waitcnt vmcnt(0)" ::: "memory");
        } else {
            XB_SPIN(xb_ld(&bar[XB_XGEN(b.x)]) == gen, bar);
            __builtin_amdgcn_fence(__ATOMIC_ACQUIRE, "agent");
            asm volatile("s_waitcnt vmcnt(0)" ::: "memory");
        }
    }
    __syncthreads();
}

__global__ void __launch_bounds__(NTHREADS, 2) mega(Params p, int ph_lo, int ph_hi) {
  __shared__ __attribute__((aligned(16))) char sm[SMEM_BYTES];
  cg::grid_group grid = cg::this_grid();
  __shared__ uint4 xb_words;
  if ((threadIdx.x & 63) == 0) g_wave_tab[hw_slot()] = (int)(threadIdx.x >> 6);
  if (threadIdx.x == 0) xb_words = make_uint4(0u, 0u, 0u, 0u);
  __syncthreads();
  (void)xcd_barrier_post((unsigned*)(p.ws + WS_BAR), (volatile LAS unsigned*)&xb_words);
  if (ph_lo < 0) grid.sync();
  const float* xp0 = p.in[0];
  const float* xs0 = p.in[1];
  const float* xp1 = p.out;
  const float* xs1 = p.out + (size_t)4096 * 1024;
#ifndef PH_ONLY
#define PH_ONLY -1
#endif
#define PHON(x) (PH_ONLY < 0 || PH_ONLY == (x))
#define RUN(k, call) do { if (ph_lo <= (k) && (k) < ph_hi) { if (PHON(k)) { call; } if ((k) + 1 < ph_hi) { XcdBarrier xb; xb.bar = (unsigned*)(p.ws + WS_BAR); xb.x = xb_xcc_id(); xb.st = (volatile LAS unsigned*)&xb_words; xcd_barrier(xb); } } } while (0)
  RUN(0, phase_prep(p, sm));
  RUN(1, phase_norm(p, 0, xp0, xs0));
  RUN(2, phase_attn_inproj(p, 0, sm));
  RUN(3, phase_attn(p, 0, sm));
  RUN(4, phase_outproj(p, 0, (const u16*)(p.ws + WS_RC), 1024, (const u16*)(p.ws + WS_WAO), xp0, xs0, sm));
  RUN(5, phase_norm(p, 1, xp1, xs1));
  RUN(6, phase_pool_inproj(p, sm));
  RUN(7, phase_pool_d(p));
  RUN(8, phase_pool_gemm(p, sm));
  RUN(9, phase_outproj(p, 1, (const u16*)(p.ws + WS_RC), 1024, (const u16*)(p.ws + WS_WPO), xp1, xs1, sm));
  RUN(10, phase_norm(p, 2, xp1, xs1));
  RUN(11, phase_ret_inproj(p, sm));
  RUN(12, phase_ret_scan(p, sm));
  RUN(13, phase_ret_out(p, sm));
  RUN(14, phase_outproj(p, 2, (const u16*)(p.ws + WS_RE), 2048, (const u16*)(p.ws + WS_WRO), xp1, xs1, sm));
  RUN(15, phase_norm(p, 3, xp1, xs1));
  RUN(16, phase_attn_inproj(p, 1, sm));
  RUN(17, phase_attn(p, 1, sm));
  RUN(18, phase_outproj(p, 3, (const u16*)(p.ws + WS_RC), 1024, (const u16*)(p.ws + WS_WAO) + (size_t)1024 * 1024, xp1, xs1, sm));
  RUN(19, phase_final_norm(p));
}

extern "C" void kernel_launch(void* const* d_in, const int* in_sizes, int n_in, void* d_out, int out_size, void* d_ws, size_t ws_size,
                              hipStream_t stream) {
  static int grid_blocks = 0;
  if (!grid_blocks) {
    int dev = 0, cus = 0, per_cu = 0;
    hipGetDevice(&dev);
    hipDeviceGetAttribute(&cus, hipDeviceAttributeMultiprocessorCount, dev);
    hipOccupancyMaxActiveBlocksPerMultiprocessor(&per_cu, mega, NTHREADS, 0);
    if (per_cu < 1) per_cu = 1;
    if (per_cu > 2) per_cu = 2;
    grid_blocks = cus * per_cu;
    if (ws_size < WS_END) fprintf(stderr, "kernel_launch: workspace too small: %zu < %zu\n", ws_size, (size_t)WS_END);
  }
  Params p{};
  for (int i = 0; i < 24; ++i) p.in[i] = (const float*)d_in[i];
  p.out = (float*)d_out;
  p.ws = (unsigned char*)d_ws;
#ifndef N_SPLIT
#define N_SPLIT 1
#endif
#ifndef PH_END
#define PH_END 20
#endif
  if (PH_END < 20) (void)hipMemsetAsync(d_out, 0, (size_t)out_size * 4, stream);
  (void)hipMemsetAsync((char*)d_ws + WS_BAR, 0, XCD_BAR_WORDS * 4, stream);
#ifndef PROBE_DUP
#define PROBE_DUP -1
#endif
  {
    int seg[4][2]; int nseg = 0;
    if (PROBE_DUP < 0) { seg[0][0] = 0; seg[0][1] = PH_END; nseg = 1; }
#ifndef PROBE_LO
#define PROBE_LO PROBE_DUP
#endif
    else { seg[0][0] = 0; seg[0][1] = PROBE_DUP + 1; seg[1][0] = PROBE_LO; seg[1][1] = PROBE_DUP + 1; nseg = 2; if (PROBE_DUP + 1 < 20) { seg[2][0] = PROBE_DUP + 1; seg[2][1] = 20; nseg = 3; } }
    for (int li = 0; li < nseg; ++li) {
      int lo = seg[li][0], hi = seg[li][1];
      if (li > 0) (void)hipMemsetAsync((char*)d_ws + WS_BAR, 0, XCD_BAR_WORDS * 4, stream);
      void* args[] = {&p, &lo, &hi};
      hipError_t e = hipLaunchCooperativeKernel((void*)mega, dim3(grid_blocks), dim3(NTHREADS), args, 0, stream);
      if (e != hipSuccess) fprintf(stderr, "cooperative launch failed: %s (grid %d)\n", hipGetErrorString(e), grid_blocks);
    }
  }
}
```

```cpp
#include <hip/hip_runtime.h>
#include <hip/hip_cooperative_groups.h>
#include <cstdio>
#include <cstdint>
namespace cg = cooperative_groups;

typedef unsigned short u16;
typedef short bf16x8 __attribute__((ext_vector_type(8)));
typedef float f32x4 __attribute__((ext_vector_type(4)));
typedef unsigned u32x4 __attribute__((ext_vector_type(4)));

#define NTHREADS 256
#define SMEM_BYTES 73728
constexpr float LOG2E = 1.4426950408889634f;

constexpr size_t MiB = 1048576;
constexpr size_t WS_MOD  = 0;
constexpr size_t WS_ROPE = 147456;
constexpr size_t WS_BAR  = 155648;
constexpr size_t WS_WAI  = 262144;
constexpr size_t WS_WAO  = WS_WAI + 2 * 2560 * 1024 * 2;
constexpr size_t WS_WPI  = WS_WAO + 2 * 1024 * 1024 * 2;
constexpr size_t WS_WPG  = WS_WPI + 2048 * 1024 * 2;
constexpr size_t WS_WPO  = WS_WPG + 4 * 256 * 256 * 2;
constexpr size_t WS_WRI  = WS_WPO + 1024 * 1024 * 2;
constexpr size_t WS_WRO  = WS_WRI + 6144 * 1024 * 2;
constexpr size_t WS_CK   = WS_WRO + 1024 * 2048 * 2;
constexpr size_t WS_CVT  = WS_CK + 2 * 2 * 512 * 256 * 2;
constexpr size_t WS_RA   = WS_CVT + 2 * 2 * 512 * 256 * 2;
constexpr size_t WS_RB   = WS_RA + 16 * MiB;
constexpr size_t WS_RC   = WS_RB + 16 * MiB;
constexpr size_t WS_RD   = WS_RC + 16 * MiB;
constexpr size_t WS_RE   = WS_RD + 32 * MiB;
constexpr size_t WS_RF   = WS_RE + 32 * MiB;
constexpr size_t WS_END  = WS_RF + 96 * MiB;

constexpr size_t O_NK = 8388608, O_NV = 10485760, O_SF = 12582912, O_SB = 20971520;

struct Params {
  const float* in[24];
  float* out;
  unsigned char* ws;
};

typedef __bf16 bf16x2_t __attribute__((ext_vector_type(2)));
__device__ __forceinline__ unsigned pk_bf16(float lo, float hi) { bf16x2_t v; v.x = (__bf16)lo; v.y = (__bf16)hi; return __builtin_bit_cast(unsigned, v); }
__device__ __forceinline__ u16 f2bf(float f) { return __builtin_bit_cast(u16, (__bf16)f); }
__device__ __forceinline__ float bf2f(u16 h) { return __uint_as_float(((unsigned)h) << 16); }
__device__ __forceinline__ float bflo(unsigned u) { return __uint_as_float(u << 16); }
__device__ __forceinline__ float bfhi(unsigned u) { return __uint_as_float(u & 0xffff0000u); }
__device__ __forceinline__ float fexp2(float x) { return __builtin_amdgcn_exp2f(x); }
__shared__ int g_wave_tab[64];
__device__ __forceinline__ int hw_slot() { return (int)(__builtin_amdgcn_s_getreg(((6 - 1) << 11) | 4) & 63u); }
__device__ __forceinline__ int lane_now() { return (int)__builtin_amdgcn_mbcnt_hi(~0u, __builtin_amdgcn_mbcnt_lo(~0u, 0u)); }
__device__ __forceinline__ int tid_now() { return __builtin_amdgcn_readfirstlane(g_wave_tab[hw_slot()]) * 64 + lane_now(); }
__device__ __forceinline__ float silu(float x) { return x / (1.f + __expf(-x)); }
__device__ __forceinline__ float logsig2(float x) { return -log1pf(expf(-x)) * LOG2E; }
__device__ __forceinline__ f32x4 mfma16(bf16x8 a, bf16x8 b, f32x4 c) { return __builtin_amdgcn_mfma_f32_16x16x32_bf16(a, b, c, 0, 0, 0); }

template <typename T> __device__ __forceinline__ T* opaque(T* p) { asm volatile("" : "+v"(p)); return p; }

__device__ __forceinline__ int lds_off(int r, int c) {
  int st = (r >> 4) * 2 + (c >> 5), ob = (r & 15) * 64 + (c & 31) * 2;
  return st * 1024 + (ob ^ (((ob >> 9) & 1) << 5));
}

__device__ __forceinline__ bf16x8 scale_frag(bf16x8 v, float s) {
  union { bf16x8 v; unsigned u[4]; } x; x.v = v;
#pragma unroll
  for (int i = 0; i < 4; ++i) x.u[i] = pk_bf16(bflo(x.u[i]) * s, bfhi(x.u[i]) * s);
  return x.v;
}

template <bool SCALE>
__device__ __forceinline__ void gemm_core(const u16* __restrict__ A, size_t lda, const u16* __restrict__ B, size_t ldb, int K,
                                          f32x4 (&acc)[4][4], char* sm, float lg2 = 0.f, int dir = 0) {
  const int t = tid_now(), lane = t & 63, w = t >> 6, wm = w >> 1, wn = w & 1, fr = lane & 15, fq = lane >> 4;
  const int lr = t >> 3, lc = (t & 7) * 8;
  uint4 ra[4], rb[4];
  const int nk = K >> 6;
  const u16* Ap = A + (size_t)lr * lda + lc;
  const u16* Bp = B + (size_t)lr * ldb + lc;
#define GLOAD(kt) do { _Pragma("unroll") for (int i = 0; i < 4; ++i) { ra[i] = *(const uint4*)(Ap + (size_t)(32 * i) * lda + (kt) * 64); rb[i] = *(const uint4*)(Bp + (size_t)(32 * i) * ldb + (kt) * 64); } } while (0)
#define LSTORE(buf, kt) do { \
    if (SCALE) { float fs[8]; _Pragma("unroll") for (int e = 0; e < 8; ++e) { int j = (kt) * 64 + lc + e; fs[e] = fexp2((float)(dir ? j : 127 - j) * lg2); } \
      _Pragma("unroll") for (int i = 0; i < 4; ++i) { unsigned* u = (unsigned*)&ra[i]; _Pragma("unroll") for (int e = 0; e < 4; ++e) u[e] = pk_bf16(bflo(u[e]) * fs[2 * e], bfhi(u[e]) * fs[2 * e + 1]); } } \
    _Pragma("unroll") for (int i = 0; i < 4; ++i) { *(uint4*)(sm + (buf) * 32768 + lds_off(lr + 32 * i, lc)) = ra[i]; *(uint4*)(sm + (buf) * 32768 + 16384 + lds_off(lr + 32 * i, lc)) = rb[i]; } } while (0)
  GLOAD(0);
  LSTORE(0, 0);
  __syncthreads();
  for (int kt = 0; kt < nk; ++kt) {
    const int cur = kt & 1;
    if (kt + 1 < nk) GLOAD(kt + 1);
    const char* sa = sm + cur * 32768;
    const char* sb = sa + 16384;
#pragma unroll
    for (int ks = 0; ks < 2; ++ks) {
      bf16x8 a[4], b[4];
#pragma unroll
      for (int m = 0; m < 4; ++m) a[m] = *(const bf16x8*)(sa + lds_off(wm * 64 + m * 16 + fr, ks * 32 + fq * 8));
#pragma unroll
      for (int n = 0; n < 4; ++n) b[n] = *(const bf16x8*)(sb + lds_off(wn * 64 + n * 16 + fr, ks * 32 + fq * 8));
#pragma unroll
      for (int m = 0; m < 4; ++m)
#pragma unroll
        for (int n = 0; n < 4; ++n) acc[m][n] = mfma16(a[m], b[n], acc[m][n]);
    }
    if (kt + 1 < nk) LSTORE(cur ^ 1, kt + 1);
    __syncthreads();
  }
#undef GLOAD
#undef LSTORE
}

__device__ __forceinline__ int lds_off32(int r, int c) {
  int ob = (r & 15) * 64 + c * 2;
  return (r >> 4) * 1024 + (ob ^ (((ob >> 9) & 1) << 5));
}
#define LAS3 __attribute__((address_space(3)))
template <int J>
__device__ __forceinline__ void glds_step(int kt, int nk, const u16* Ap, size_t lda, const u16* Bp, size_t ldb, char* sm, unsigned aA, unsigned aB,
                                          f32x4 (&acc)[4][4]) {
  const int t = tid_now();
  if (kt + 2 < nk) asm volatile("s_waitcnt vmcnt(8)" ::: "memory");
  else if (kt + 1 < nk) asm volatile("s_waitcnt vmcnt(4)" ::: "memory");
  else asm volatile("s_waitcnt vmcnt(0)" ::: "memory");
  __builtin_amdgcn_s_barrier();
  bf16x8 a0, a1, a2, a3, b0, b1, b2, b3;
  asm volatile(
      "ds_read_b128 %0, %8 offset:%10\n\t"
      "ds_read_b128 %4, %9 offset:%10\n\t"
      "ds_read_b128 %5, %9 offset:%11\n\t"
      "ds_read_b128 %1, %8 offset:%11\n\t"
      "ds_read_b128 %6, %9 offset:%12\n\t"
      "ds_read_b128 %7, %9 offset:%13\n\t"
      "ds_read_b128 %2, %8 offset:%12\n\t"
      "ds_read_b128 %3, %8 offset:%13\n\t"
      "s_waitcnt lgkmcnt(0)"
      : "=&v"(a0), "=&v"(a1), "=&v"(a2), "=&v"(a3), "=&v"(b0), "=&v"(b1), "=&v"(b2), "=&v"(b3)
      : "v"(aA), "v"(aB), "n"(J * 16384), "n"(J * 16384 + 1024), "n"(J * 16384 + 2048), "n"(J * 16384 + 3072)
      : "memory");
  if (kt + 3 < nk) {
    char* d = sm + ((J + 3) & 3) * 16384 + t * 16;
    const size_t ko = (size_t)(kt + 3) * 32;
#pragma unroll
    for (int i = 0; i < 2; ++i) {
      __builtin_amdgcn_global_load_lds((const unsigned*)(Ap + (size_t)(64 * i) * 32 + (size_t)(kt + 3) * lda), (unsigned*)(d + i * 4096), 16, 0, 0);
      __builtin_amdgcn_global_load_lds((const unsigned*)(Bp + (size_t)(64 * i) * 32 + (size_t)(kt + 3) * ldb), (unsigned*)(d + 8192 + i * 4096), 16, 0, 0);
    }
  }
  acc[0][0] = mfma16(a0, b0, acc[0][0]); acc[0][1] = mfma16(a0, b1, acc[0][1]); acc[0][2] = mfma16(a0, b2, acc[0][2]); acc[0][3] = mfma16(a0, b3, acc[0][3]);
  acc[1][0] = mfma16(a1, b0, acc[1][0]); acc[1][1] = mfma16(a1, b1, acc[1][1]); acc[1][2] = mfma16(a1, b2, acc[1][2]); acc[1][3] = mfma16(a1, b3, acc[1][3]);
  acc[2][0] = mfma16(a2, b0, acc[2][0]); acc[2][1] = mfma16(a2, b1, acc[2][1]); acc[2][2] = mfma16(a2, b2, acc[2][2]); acc[2][3] = mfma16(a2, b3, acc[2][3]);
  acc[3][0] = mfma16(a3, b0, acc[3][0]); acc[3][1] = mfma16(a3, b1, acc[3][1]); acc[3][2] = mfma16(a3, b2, acc[3][2]); acc[3][3] = mfma16(a3, b3, acc[3][3]);
}
__device__ __forceinline__ void gemm_core_glds(const u16* __restrict__ A, size_t lda, const u16* __restrict__ B, size_t ldb, int K,
                                               f32x4 (&acc)[4][4], char* sm) {
  const int t = tid_now(), lane = t & 63, w = t >> 6, wm = w >> 1, wn = w & 1, fr = lane & 15, fq = lane >> 4;
  const int sb = lane * 16, swz = sb ^ (((sb >> 9) & 1) << 5);
  const int r0 = w * 16 + (swz >> 6), c0 = (swz & 63) >> 1;
  const u16* Ap = A + (size_t)r0 * 32 + c0;
  const u16* Bp = B + (size_t)r0 * 32 + c0;
  const int nk = K >> 5;
  const unsigned smb = (unsigned)(uintptr_t)(LAS3 char*)sm;
  const unsigned aA = smb + lds_off32(wm * 64 + fr, fq * 8);
  const unsigned aB = smb + 8192 + lds_off32(wn * 64 + fr, fq * 8);
#pragma unroll
  for (int j = 0; j < 3; ++j) {
    char* d = sm + j * 16384 + t * 16;
#pragma unroll
    for (int i = 0; i < 2; ++i) {
      __builtin_amdgcn_global_load_lds((const unsigned*)(Ap + (size_t)(64 * i) * 32 + (size_t)j * lda), (unsigned*)(d + i * 4096), 16, 0, 0);
      __builtin_amdgcn_global_load_lds((const unsigned*)(Bp + (size_t)(64 * i) * 32 + (size_t)j * ldb), (unsigned*)(d + 8192 + i * 4096), 16, 0, 0);
    }
  }
  for (int kt0 = 0; kt0 < nk; kt0 += 4) {
    glds_step<0>(kt0, nk, Ap, lda, Bp, ldb, sm, aA, aB, acc);
    glds_step<1>(kt0 + 1, nk, Ap, lda, Bp, ldb, sm, aA, aB, acc);
    glds_step<2>(kt0 + 2, nk, Ap, lda, Bp, ldb, sm, aA, aB, acc);
    glds_step<3>(kt0 + 3, nk, Ap, lda, Bp, ldb, sm, aA, aB, acc);
  }
  __syncthreads();
}

template <int J>
__device__ __forceinline__ void glds2_step(int kt, int nk, const u16* Ap, size_t lda, const u16* Bp, size_t ldb, char* sm, unsigned aA, unsigned aB, int t,
                                           f32x4 (&accL)[4][4], f32x4 (&accR)[4][4]) {
  if (kt + 1 < nk) asm volatile("s_waitcnt vmcnt(6)" ::: "memory");
  else asm volatile("s_waitcnt vmcnt(0)" ::: "memory");
  __builtin_amdgcn_s_barrier();
  bf16x8 a0, a1, a2, a3, b0, b1, b2, b3, b4, b5, b6, b7;
  asm volatile(
      "ds_read_b128 %0, %12 offset:%14\n\t"
      "ds_read_b128 %4, %13 offset:%14\n\t"
      "ds_read_b128 %5, %13 offset:%15\n\t"
      "ds_read_b128 %1, %12 offset:%15\n\t"
      "ds_read_b128 %6, %13 offset:%16\n\t"
      "ds_read_b128 %7, %13 offset:%17\n\t"
      "ds_read_b128 %2, %12 offset:%16\n\t"
      "ds_read_b128 %8, %13 offset:%18\n\t"
      "ds_read_b128 %9, %13 offset:%19\n\t"
      "ds_read_b128 %3, %12 offset:%17\n\t"
      "ds_read_b128 %10, %13 offset:%20\n\t"
      "ds_read_b128 %11, %13 offset:%21\n\t"
      "s_waitcnt lgkmcnt(0)"
      : "=&v"(a0), "=&v"(a1), "=&v"(a2), "=&v"(a3), "=&v"(b0), "=&v"(b1), "=&v"(b2), "=&v"(b3), "=&v"(b4), "=&v"(b5), "=&v"(b6), "=&v"(b7)
      : "v"(aA), "v"(aB), "n"(J * 24576), "n"(J * 24576 + 1024), "n"(J * 24576 + 2048), "n"(J * 24576 + 3072),
        "n"(J * 24576 + 8192), "n"(J * 24576 + 9216), "n"(J * 24576 + 10240), "n"(J * 24576 + 11264)
      : "memory");
  if (kt + 2 < nk) {
    char* d = sm + ((J + 2) % 3) * 24576 + t * 16;
    const size_t ko = (size_t)(kt + 2) * 32;
#pragma unroll
    for (int i = 0; i < 2; ++i) __builtin_amdgcn_global_load_lds((const unsigned*)(Ap + (size_t)(64 * i) * 32 + (size_t)(kt + 2) * lda), (unsigned*)(d + i * 4096), 16, 0, 0);
#pragma unroll
    for (int i = 0; i < 4; ++i) __builtin_amdgcn_global_load_lds((const unsigned*)(Bp + (size_t)(64 * i) * 32 + (size_t)(kt + 2) * ldb), (unsigned*)(d + 8192 + i * 4096), 16, 0, 0);
  }
#define G2_ROW(m, am) accL[m][0] = mfma16(am, b0, accL[m][0]); accL[m][1] = mfma16(am, b1, accL[m][1]); accL[m][2] = mfma16(am, b2, accL[m][2]); accL[m][3] = mfma16(am, b3, accL[m][3]); \
                      accR[m][0] = mfma16(am, b4, accR[m][0]); accR[m][1] = mfma16(am, b5, accR[m][1]); accR[m][2] = mfma16(am, b6, accR[m][2]); accR[m][3] = mfma16(am, b7, accR[m][3]);
  G2_ROW(0, a0) G2_ROW(1, a1) G2_ROW(2, a2) G2_ROW(3, a3)
#undef G2_ROW
  __builtin_amdgcn_sched_barrier(0);
}
__device__ __forceinline__ void gemm_core_glds2(const u16* __restrict__ A, size_t lda, const u16* __restrict__ B, size_t ldb, int K,
                                                f32x4 (&accL)[4][4], f32x4 (&accR)[4][4], char* sm) {
  const int t = tid_now(), lane = t & 63, w = t >> 6, wm = w >> 1, wn = w & 1, fr = lane & 15, fq = lane >> 4;
  const int sb = lane * 16, swz = sb ^ (((sb >> 9) & 1) << 5);
  const int r0 = w * 16 + (swz >> 6), c0 = (swz & 63) >> 1;
  const u16* Ap = A + (size_t)r0 * 32 + c0;
  const u16* Bp = B + (size_t)r0 * 32 + c0;
  const int nk = K >> 5;
  const unsigned smb = (unsigned)(uintptr_t)(LAS3 char*)sm;
  const unsigned aA = smb + lds_off32(wm * 64 + fr, fq * 8);
  const unsigned aB = smb + 8192 + lds_off32(wn * 64 + fr, fq * 8);
#pragma unroll
  for (int j = 0; j < 2; ++j) {
    char* d = sm + j * 24576 + t * 16;
#pragma unroll
    for (int i = 0; i < 2; ++i) __builtin_amdgcn_global_load_lds((const unsigned*)(Ap + (size_t)(64 * i) * 32 + (size_t)j * lda), (unsigned*)(d + i * 4096), 16, 0, 0);
#pragma unroll
    for (int i = 0; i < 4; ++i) __builtin_amdgcn_global_load_lds((const unsigned*)(Bp + (size_t)(64 * i) * 32 + (size_t)j * ldb), (unsigned*)(d + 8192 + i * 4096), 16, 0, 0);
  }
  for (int kt0 = 0; kt0 < nk; kt0 += 3) {
    glds2_step<0>(kt0, nk, Ap, lda, Bp, ldb, sm, aA, aB, t, accL, accR);
    if (kt0 + 1 < nk) glds2_step<1>(kt0 + 1, nk, Ap, lda, Bp, ldb, sm, aA, aB, t, accL, accR);
    if (kt0 + 2 < nk) glds2_step<2>(kt0 + 2, nk, Ap, lda, Bp, ldb, sm, aA, aB, t, accL, accR);
  }
  __syncthreads();
}

#define WAVE_IDS const int t = tid_now(), lane = t & 63, w = t >> 6, wm = w >> 1, wn = w & 1, fr = lane & 15, fq = lane >> 4; (void)wm; (void)wn; (void)fr; (void)fq; (void)lane; (void)w; (void)t
#define AROW(m, r) (wm * 64 + (m) * 16 + fq * 4 + (r))
#define ACOL(n) (wn * 64 + (n) * 16 + fr)

template <class F>
__device__ __forceinline__ void epi_store_bf16(const f32x4 (&acc)[4][4], char* sm, u16* dst, size_t ldd, F f, const u16* mulp = nullptr, size_t ldm = 0) {
  WAVE_IDS;
  u16* cs = (u16*)sm;
#pragma unroll
  for (int m = 0; m < 4; ++m) {
#pragma unroll
    for (int n = 0; n < 4; ++n)
#pragma unroll
      for (int r = 0; r < 4; ++r) cs[AROW(m, r) * 136 + ACOL(n)] = f2bf(f(AROW(m, r), ACOL(n), acc[m][n][r]));
    __builtin_amdgcn_sched_barrier(0);
  }
  __syncthreads();
#pragma unroll
  for (int i = 0; i < 8; ++i) {
    int row = (t >> 4) + 16 * i, ch = t & 15;
    uint4 v = *(const uint4*)(cs + row * 136 + ch * 8);
    if (mulp) {
      uint4 z = *(const uint4*)(mulp + (size_t)row * ldm + ch * 8);
      v.x = pk_bf16(bflo(v.x) * bflo(z.x), bfhi(v.x) * bfhi(z.x));
      v.y = pk_bf16(bflo(v.y) * bflo(z.y), bfhi(v.y) * bfhi(z.y));
      v.z = pk_bf16(bflo(v.z) * bflo(z.z), bfhi(v.z) * bfhi(z.z));
      v.w = pk_bf16(bflo(v.w) * bflo(z.w), bfhi(v.w) * bfhi(z.w));
    }
    *(uint4*)(dst + (size_t)row * ldd + ch * 8) = v;
  }
  __syncthreads();
}

template <class F>
__device__ __forceinline__ void epi_store_bf16_T(const f32x4 (&acc)[4][4], u16* dstT, size_t ldt, F f) {
  WAVE_IDS;
#pragma unroll
  for (int m = 0; m < 4; ++m)
#pragma unroll
    for (int n = 0; n < 4; ++n) {
      float v0 = f(AROW(m, 0), ACOL(n), acc[m][n][0]), v1 = f(AROW(m, 1), ACOL(n), acc[m][n][1]);
      float v2 = f(AROW(m, 2), ACOL(n), acc[m][n][2]), v3 = f(AROW(m, 3), ACOL(n), acc[m][n][3]);
      uint2 pk; pk.x = pk_bf16(v0, v1); pk.y = pk_bf16(v2, v3);
      *(uint2*)(dstT + (size_t)ACOL(n) * ldt + AROW(m, 0)) = pk;
    }
}

template <class F>
__device__ __forceinline__ void epi_store_bf16_img(const f32x4 (&acc)[4][4], char* sm, u16* img, int row0, int col0, F f, const u16* mulp = nullptr, size_t ldm = 0) {
  WAVE_IDS;
  u16* cs = (u16*)sm;
#pragma unroll
  for (int m = 0; m < 4; ++m) {
#pragma unroll
    for (int n = 0; n < 4; ++n)
#pragma unroll
      for (int r = 0; r < 4; ++r) cs[AROW(m, r) * 136 + ACOL(n)] = f2bf(f(AROW(m, r), ACOL(n), acc[m][n][r]));
    __builtin_amdgcn_sched_barrier(0);
  }
  __syncthreads();
#pragma unroll
  for (int i = 0; i < 8; ++i) {
    int ch = (t & 3) + 4 * ((t >> 6) & 3), row = ((t >> 2) & 15) + 16 * i;
    uint4 v = *(const uint4*)(cs + row * 136 + ch * 8);
    if (mulp) {
      uint4 z = *(const uint4*)(mulp + (size_t)row * ldm + ch * 8);
      v.x = pk_bf16(bflo(v.x) * bflo(z.x), bfhi(v.x) * bfhi(z.x));
      v.y = pk_bf16(bflo(v.y) * bflo(z.y), bfhi(v.y) * bfhi(z.y));
      v.z = pk_bf16(bflo(v.z) * bflo(z.z), bfhi(v.z) * bfhi(z.z));
      v.w = pk_bf16(bflo(v.w) * bflo(z.w), bfhi(v.w) * bfhi(z.w));
    }
    const int col = col0 + ch * 8;
    *(uint4*)(img + (size_t)(col >> 5) * 262144 + (size_t)(row0 + row) * 32 + (col & 31)) = v;
  }
  __syncthreads();
}

struct IdF { __device__ __forceinline__ float operator()(int, int, float v) const { return v; } };
struct SiluF { __device__ __forceinline__ float operator()(int, int, float v) const { return silu(v); } };
struct ScaleF { float s; __device__ __forceinline__ float operator()(int, int, float v) const { return v * s; } };

__device__ __forceinline__ void transpose_tile(const float* __restrict__ src, size_t ldn, u16* __restrict__ dst, size_t ldk, int k0, int n0, char* smc, size_t bstep) {
  float* sm = (float*)smc;
  const int t = tid_now(), l = t & 63, w = t >> 6;
  float4 v[16];
#pragma unroll
  for (int i = 0; i < 16; ++i) v[i] = *(const float4*)(src + (size_t)(k0 + w + 4 * i) * ldn + n0 + l * 4);
#pragma unroll
  for (int i = 0; i < 16; ++i) {
    float* d = sm + (w + 4 * i) * 257 + l * 4;
    d[0] = v[i].x; d[1] = v[i].y; d[2] = v[i].z; d[3] = v[i].w;
  }
  __syncthreads();
  const int kq = t & 7;
#pragma unroll
  for (int j = 0; j < 8; ++j) {
    int n = (t >> 3) + 32 * j;
    const float* r = sm + (kq * 8) * 257 + n;
    uint4 o;
    o.x = pk_bf16(r[0], r[257]); o.y = pk_bf16(r[2 * 257], r[3 * 257]); o.z = pk_bf16(r[4 * 257], r[5 * 257]); o.w = pk_bf16(r[6 * 257], r[7 * 257]);
    const int kk = k0 + kq * 8;
    if (bstep) *(uint4*)(dst + (size_t)(kk >> 5) * bstep + (size_t)(n0 + n) * 32 + (kk & 31)) = o;
    else *(uint4*)(dst + (size_t)(n0 + n) * ldk + kk) = o;
  }
  __syncthreads();
}

__device__ __forceinline__ void phase_prep(const Params& p, char* sm) {
  const int t = tid_now();
  unsigned char* ws = p.ws;
  float* mod = (float*)(ws + WS_MOD);
  const int N_ADA = 384, N_TR = 1200, N_CK = 256;
  for (int idx = blockIdx.x; idx < N_ADA + N_TR + N_CK + 1; idx += gridDim.x) {
    if (idx < N_ADA) {
      int i = idx / 96, nb = idx % 96, n0 = nb * 32;
      float* sv = (float*)sm;
      float* red = (float*)(sm + 12288);
      for (int e = t; e < 3072; e += NTHREADS) {
        int k = e / 3, cd = e % 3;
        float cv = (cd == 0) ? p.in[7][k] : p.in[6][(cd - 1) * 1024 + k];
        sv[e] = silu(cv);
      }
      __syncthreads();
      const int kg = t >> 3, c4 = (t & 7) * 4;
      float a0[4] = {0, 0, 0, 0}, a1[4] = {0, 0, 0, 0}, a2[4] = {0, 0, 0, 0};
      const float* wp = p.in[9] + ((size_t)i * 1024 + kg * 32) * 3072 + n0 + c4;
#pragma unroll 16
      for (int kk = 0; kk < 32; ++kk) {
        float4 wv = *(const float4*)(wp + (size_t)kk * 3072);
        const float* svp = sv + (kg * 32 + kk) * 3;
        float s0 = svp[0], s1 = svp[1], s2 = svp[2];
        a0[0] += s0 * wv.x; a0[1] += s0 * wv.y; a0[2] += s0 * wv.z; a0[3] += s0 * wv.w;
        a1[0] += s1 * wv.x; a1[1] += s1 * wv.y; a1[2] += s1 * wv.z; a1[3] += s1 * wv.w;
        a2[0] += s2 * wv.x; a2[1] += s2 * wv.y; a2[2] += s2 * wv.z; a2[3] += s2 * wv.w;
      }
#pragma unroll
      for (int e = 0; e < 4; ++e) { red[(kg * 3 + 0) * 32 + c4 + e] = a0[e]; red[(kg * 3 + 1) * 32 + c4 + e] = a1[e]; red[(kg * 3 + 2) * 32 + c4 + e] = a2[e]; }
      __syncthreads();
      if (t < 96) {
        int cd = t >> 5, col = t & 31;
        float sacc = p.in[10][(size_t)i * 3072 + n0 + col];
        for (int g = 0; g < 32; ++g) sacc += red[(g * 3 + cd) * 32 + col];
        mod[((size_t)i * 3 + cd) * 3072 + n0 + col] = sacc;
      }
      __syncthreads();
    } else if (idx < N_ADA + N_TR) {
      int q = idx - N_ADA;
      const float* src; u16* dst; size_t ldn, ldk; int tk, tn;
      bool q_is_cache = false;
      if (q < 320) { int j = q / 160, r = q % 160; src = p.in[11] + (size_t)j * 1024 * 2560; dst = (u16*)(ws + WS_WAI) + (size_t)j * 2560 * 1024; ldn = 2560; ldk = 1024; tk = r / 10; tn = r % 10; }
      else if (q < 448) { q -= 320; int j = q / 64, r = q % 64; src = p.in[12] + (size_t)j * 1024 * 1024; dst = (u16*)(ws + WS_WAO) + (size_t)j * 1024 * 1024; ldn = 1024; ldk = 1024; tk = r / 4; tn = r % 4; }
      else if (q < 576) { q -= 448; src = p.in[14]; dst = (u16*)(ws + WS_WPI); ldn = 2048; ldk = 1024; tk = q / 8; tn = q % 8; }
      else if (q < 592) { q -= 576; int g = q / 4, r = q % 4; src = p.in[15] + (size_t)g * 65536; dst = (u16*)(ws + WS_WPG) + (size_t)g * 65536; ldn = 256; ldk = 256; tk = r; tn = 0; }
      else if (q < 656) { q -= 592; src = p.in[17]; dst = (u16*)(ws + WS_WPO); ldn = 1024; ldk = 1024; tk = q / 4; tn = q % 4; }
      else if (q < 1040) { q -= 656; src = p.in[18]; dst = (u16*)(ws + WS_WRI); ldn = 6144; ldk = 1024; tk = q / 24; tn = q % 24; }
      else if (q < 1168) { q -= 1040; src = p.in[22]; dst = (u16*)(ws + WS_WRO); ldn = 1024; ldk = 2048; tk = q / 4; tn = q % 4; }
      else { q_is_cache = true; q -= 1168; int bj = q / 8, r = q % 8; src = p.in[3] + (size_t)bj * 512 * 256; dst = (u16*)(ws + WS_CVT) + (size_t)bj * 256 * 512; ldn = 256; ldk = 512; tk = r; tn = 0; }
      transpose_tile(src, ldn, dst, ldk, tk * 64, tn * 256, sm, q_is_cache ? 0 : ldn * 32);
    } else if (idx < N_ADA + N_TR + N_CK) {
      int q = idx - N_ADA - N_TR;
      size_t off = (size_t)q * 2048 + t * 8;
      float4 v0 = *(const float4*)(p.in[2] + off), v1 = *(const float4*)(p.in[2] + off + 4);
      *(uint4*)((u16*)(ws + WS_CK) + off) = make_uint4(pk_bf16(v0.x, v0.y), pk_bf16(v0.z, v0.w), pk_bf16(v1.x, v1.y), pk_bf16(v1.z, v1.w));
    } else {
      if (t < 16) {
        double r = 0.5623413251903491, th = 1.0;
        for (int i = 0; i < t; ++i) th *= r;
        double x2 = th * th, cs = 1.0, sn = th, tc = 1.0, ts = th;
        for (int i = 1; i < 14; ++i) { tc *= -x2 / ((2.0 * i - 1.0) * (2.0 * i)); ts *= -x2 / ((2.0 * i) * (2.0 * i + 1.0)); cs += tc; sn += ts; }
        double c = 1.0, s = 0.0;
        float* tab = (float*)(ws + WS_ROPE);
        for (int pos = 0; pos < 64; ++pos) {
          tab[(pos * 16 + t) * 2] = (float)c; tab[(pos * 16 + t) * 2 + 1] = (float)s;
          double c2 = c * cs - s * sn, s2 = s * cs + c * sn; c = c2; s = s2;
        }
      }
    }
  }
}

__device__ __forceinline__ void phase_norm(const Params& p, int layer, const float* xp, const float* xs) {
  const int t = tid_now(), lane = t & 63, w = t >> 6;
  u16* H = (u16*)(p.ws + WS_RF);
  const float* g = p.in[8] + (size_t)layer * 1024;
  for (int base = (blockIdx.x * 4 + w) * 4; base < 8192; base += gridDim.x * 16) {
    const float* x = base < 4096 ? xp + (size_t)base * 1024 : xs + (size_t)(base - 4096) * 1024;
    int cnd = base < 4096 ? 0 : 1 + ((base - 4096) >> 11);
    const float* md = (const float*)(p.ws + WS_MOD) + ((size_t)layer * 3 + cnd) * 3072;
    float4 v[4][4];
#pragma unroll
    for (int j = 0; j < 4; ++j)
#pragma unroll
      for (int i = 0; i < 4; ++i) v[j][i] = *(const float4*)(x + (size_t)j * 1024 + (i * 64 + lane) * 4);
    float rstd[4];
#pragma unroll
    for (int j = 0; j < 4; ++j) {
      float ss = 0.f;
#pragma unroll
      for (int i = 0; i < 4; ++i) ss += v[j][i].x * v[j][i].x + v[j][i].y * v[j][i].y + v[j][i].z * v[j][i].z + v[j][i].w * v[j][i].w;
#pragma unroll
      for (int o = 32; o > 0; o >>= 1) ss += __shfl_xor(ss, o);
      rstd[j] = rsqrtf(ss * (1.f / 1024.f) + 1e-6f);
    }
#pragma unroll
    for (int i = 0; i < 4; ++i) {
      int c = (i * 64 + lane) * 4;
      float4 gv = *(const float4*)(g + c), sh = *(const float4*)(md + c), sc = *(const float4*)(md + 1024 + c);
      float m0 = gv.x * (1.f + sc.x), m1 = gv.y * (1.f + sc.y), m2 = gv.z * (1.f + sc.z), m3 = gv.w * (1.f + sc.w);
#pragma unroll
      for (int j = 0; j < 4; ++j) {
        float h0 = v[j][i].x * rstd[j] * m0 + sh.x, h1 = v[j][i].y * rstd[j] * m1 + sh.y;
        float h2 = v[j][i].z * rstd[j] * m2 + sh.z, h3 = v[j][i].w * rstd[j] * m3 + sh.w;
        uint2 pk; pk.x = pk_bf16(h0, h1); pk.y = pk_bf16(h2, h3);
        *(uint2*)(H + (size_t)(c >> 5) * 262144 + (size_t)(base + j) * 32 + (c & 31)) = pk;
      }
    }
  }
}

__device__ __forceinline__ void phase_final_norm(const Params& p) {
  const int t = tid_now(), lane = t & 63, w = t >> 6;
  const float* g = p.in[23];
  for (int base = (blockIdx.x * 4 + w) * 4; base < 8192; base += gridDim.x * 16) {
    float* x = p.out + (size_t)base * 1024;
    float4 v[4][4];
#pragma unroll
    for (int j = 0; j < 4; ++j)
#pragma unroll
      for (int i = 0; i < 4; ++i) v[j][i] = *(const float4*)(x + (size_t)j * 1024 + (i * 64 + lane) * 4);
    float rstd[4];
#pragma unroll
    for (int j = 0; j < 4; ++j) {
      float ss = 0.f;
#pragma unroll
      for (int i = 0; i < 4; ++i) ss += v[j][i].x * v[j][i].x + v[j][i].y * v[j][i].y + v[j][i].z * v[j][i].z + v[j][i].w * v[j][i].w;
#pragma unroll
      for (int o = 32; o > 0; o >>= 1) ss += __shfl_xor(ss, o);
      rstd[j] = rsqrtf(ss * (1.f / 1024.f) + 1e-6f);
    }
#pragma unroll
    for (int i = 0; i < 4; ++i) {
      int c = (i * 64 + lane) * 4;
      float4 gv = *(const float4*)(g + c);
#pragma unroll
      for (int j = 0; j < 4; ++j) {
        float4 o; o.x = v[j][i].x * rstd[j] * gv.x; o.y = v[j][i].y * rstd[j] * gv.y; o.z = v[j][i].z * rstd[j] * gv.z; o.w = v[j][i].w * rstd[j] * gv.w;
        *(float4*)(x + (size_t)j * 1024 + c) = o;
      }
    }
  }
}

__device__ __forceinline__ void phase_outproj(const Params& p, int layer, const u16* Y, int K, const u16* Wt, const float* xp, const float* xs, char* sm) {
  WAVE_IDS;
  float* X = p.out;
  for (int idx = blockIdx.x; idx < 512; idx += gridDim.x) {
    int mt = idx & 63, nt = idx >> 6;
    f32x4 acc[4][4];
#pragma unroll
    for (int m = 0; m < 4; ++m)
#pragma unroll
      for (int n = 0; n < 4; ++n) acc[m][n] = (f32x4){0.f, 0.f, 0.f, 0.f};
    gemm_core_glds(Y + (size_t)mt * 128 * 32, 262144, Wt + (size_t)nt * 128 * 32, 1024 * 32, K, acc, sm);
    int row0 = mt * 128, col0 = nt * 128;
    int cnd = row0 < 4096 ? 0 : 1 + ((row0 - 4096) >> 11);
    const float* gate = (const float*)(p.ws + WS_MOD) + ((size_t)layer * 3 + cnd) * 3072 + 2048;
    const float* xres = row0 < 4096 ? xp + (size_t)row0 * 1024 : xs + (size_t)(row0 - 4096) * 1024;
    const int c4 = (t & 31) * 4, rb = t >> 5;
    const float4 g4 = *(const float4*)(gate + col0 + c4);
    float4 xv[16];
#pragma unroll
    for (int i = 0; i < 16; ++i) xv[i] = *(const float4*)(xres + (size_t)(rb + 8 * i) * 1024 + col0 + c4);
    float* cs = (float*)sm;
#pragma unroll
    for (int m = 0; m < 4; ++m) {
#pragma unroll
      for (int n = 0; n < 4; ++n)
#pragma unroll
        for (int r = 0; r < 4; ++r) cs[AROW(m, r) * 132 + ACOL(n)] = acc[m][n][r];
      __builtin_amdgcn_sched_barrier(0);
    }
    __syncthreads();
#pragma unroll
    for (int i = 0; i < 16; ++i) {
      const float4 a = *(const float4*)(cs + (rb + 8 * i) * 132 + c4);
      float4 o; o.x = xv[i].x + g4.x * a.x; o.y = xv[i].y + g4.y * a.y; o.z = xv[i].z + g4.z * a.z; o.w = xv[i].w + g4.w * a.w;
      *(float4*)(X + (size_t)(row0 + rb + 8 * i) * 1024 + col0 + c4) = o;
    }
    __syncthreads();
  }
}

__device__ __forceinline__ void attn_inproj_epi(const Params& p, int j, int mt, int nt, f32x4 (&acc)[4][4], char* sm) {
  WAVE_IDS;
  u16* Q = (u16*)(p.ws + WS_RA);
  u16* Kb = (u16*)(p.ws + WS_RB);
  u16* VTp = (u16*)(p.ws + WS_RD);
  u16* VTs = VTp + (size_t)16 * 256 * 256;
  u16* SZ = (u16*)(p.ws + WS_RE);
  const float* rope = (const float*)(p.ws + WS_ROPE);
  const int row0 = mt * 128;
  const bool sample = row0 >= 4096;
  if (nt < 10 && sample) {
#pragma unroll
    for (int m = 0; m < 4; ++m) {
      __builtin_amdgcn_sched_barrier(0);
#pragma unroll
      for (int r = 0; r < 4; ++r) {
        int tk = (row0 + AROW(m, r) - 4096) & 2047;
        int rp = tk >> 6, cp = tk & 63;
        float2 a = *(const float2*)(rope + (rp * 16 + fr) * 2), b = *(const float2*)(rope + (cp * 16 + fr) * 2);
        float x1r = acc[m][0][r], x2r = acc[m][1][r], x1c = acc[m][2][r], x2c = acc[m][3][r];
        acc[m][0][r] = x1r * a.x - x2r * a.y; acc[m][1][r] = x2r * a.x + x1r * a.y;
        acc[m][2][r] = x1c * b.x - x2c * b.y; acc[m][3][r] = x2c * b.x + x1c * b.y;
      }
    }
  }
  if (nt < 8) {
    epi_store_bf16(acc, sm, Q + (size_t)row0 * 1024 + nt * 128, 1024, IdF());
  } else if (nt < 10) {
    int c0 = (nt - 8) * 128;
    if (!sample) {
      int b = row0 >> 8, t0 = row0 & 255;
      float* dk = p.out + O_NK + ((size_t)(b * 2 + j) * 256 + t0) * 256 + c0;
#pragma unroll
      for (int m = 0; m < 4; ++m) {
        float* pm = opaque(dk + (size_t)AROW(m, 0) * 256 + ACOL(0));
#pragma unroll
        for (int n = 0; n < 4; ++n)
#pragma unroll
          for (int r = 0; r < 4; ++r) pm[r * 256 + n * 16] = acc[m][n][r];
        __builtin_amdgcn_sched_barrier(0);
      }
    }
    epi_store_bf16(acc, sm, Kb + (size_t)row0 * 256 + c0, 256, IdF());
  } else if (nt < 12) {
    int c0 = (nt - 10) * 128;
    if (!sample) {
      int b = row0 >> 8, t0 = row0 & 255;
      float* dv = p.out + O_NV + ((size_t)(b * 2 + j) * 256 + t0) * 256 + c0;
#pragma unroll
      for (int m = 0; m < 4; ++m) {
        float* pm = opaque(dv + (size_t)AROW(m, 0) * 256 + ACOL(0));
#pragma unroll
        for (int n = 0; n < 4; ++n)
#pragma unroll
          for (int r = 0; r < 4; ++r) pm[r * 256 + n * 16] = acc[m][n][r];
        __builtin_amdgcn_sched_barrier(0);
      }
      epi_store_bf16_T(acc, VTp + ((size_t)b * 256 + c0) * 256 + t0, 256, IdF());
    } else {
      int s = (row0 - 4096) >> 11, t0 = (row0 - 4096) & 2047;
      epi_store_bf16_T(acc, VTs + ((size_t)s * 256 + c0) * 2048 + t0, 2048, IdF());
    }
  } else {
    epi_store_bf16(acc, sm, SZ + (size_t)row0 * 1024 + (nt - 12) * 128, 1024, SiluF());
  }
}

__device__ __forceinline__ void phase_attn_inproj(const Params& p, int j, char* sm) {
  const u16* H = (const u16*)(p.ws + WS_RF);
  const u16* W = (const u16*)(p.ws + WS_WAI) + (size_t)j * 2560 * 1024;
  for (int idx = blockIdx.x; idx < 768; idx += gridDim.x) {
    if (idx < 512) {
      const int mt = idx & 63, nt2 = idx >> 6;
      f32x4 accL[4][4], accR[4][4];
#pragma unroll
      for (int m = 0; m < 4; ++m)
#pragma unroll
        for (int n = 0; n < 4; ++n) { accL[m][n] = (f32x4){0.f, 0.f, 0.f, 0.f}; accR[m][n] = (f32x4){0.f, 0.f, 0.f, 0.f}; }
      gemm_core_glds2(H + (size_t)mt * 128 * 32, 262144, W + (size_t)nt2 * 256 * 32, 2560 * 32, 1024, accL, accR, sm);
      attn_inproj_epi(p, j, mt, nt2 * 2, accL, sm);
      attn_inproj_epi(p, j, mt, nt2 * 2 + 1, accR, sm);
    } else {
      const int j2 = idx - 512, mt = j2 & 63, nt = 16 + (j2 >> 6);
      f32x4 acc[4][4];
#pragma unroll
      for (int m = 0; m < 4; ++m)
#pragma unroll
        for (int n = 0; n < 4; ++n) acc[m][n] = (f32x4){0.f, 0.f, 0.f, 0.f};
      gemm_core_glds(H + (size_t)mt * 128 * 32, 262144, W + (size_t)nt * 128 * 32, 2560 * 32, 1024, acc, sm);
      attn_inproj_epi(p, j, mt, nt, acc, sm);
    }
  }
}

__device__ __forceinline__ void attn_comp64_lds(const char* sk, const char* sv, const bf16x8 (&qf)[2][2], f32x4 (&oacc)[4][2],
                                                float (&mrun)[2], float (&lrun)[2], bool masked, int key0, int qbase, float sc2, int fr, int fq) {
  f32x4 s[4][2];
#pragma unroll
  for (int m = 0; m < 4; ++m) {
    const int krow = 32 * (m >> 1) + 8 * (fr >> 2) + 4 * (m & 1) + (fr & 3);
    bf16x8 k0 = *(const bf16x8*)(sk + lds_off(krow, fq * 8));
    bf16x8 k1 = *(const bf16x8*)(sk + lds_off(krow, 32 + fq * 8));
#pragma unroll
    for (int n = 0; n < 2; ++n) {
      s[m][n] = mfma16(k0, qf[n][0], (f32x4){0.f, 0.f, 0.f, 0.f});
      s[m][n] = mfma16(k1, qf[n][1], s[m][n]);
    }
  }
  if (masked) {
#pragma unroll
    for (int n = 0; n < 2; ++n)
#pragma unroll
      for (int m = 0; m < 4; ++m)
#pragma unroll
        for (int r = 0; r < 4; ++r) {
          int kpos = key0 + 32 * (m >> 1) + 8 * fq + 4 * (m & 1) + r, qpos = qbase + 16 * n + fr;
          int dd = qpos - kpos; dd = dd < 0 ? -dd : dd;
          s[m][n][r] = dd <= 128 ? s[m][n][r] : -1.0e30f;
        }
  }
#pragma unroll
  for (int n = 0; n < 2; ++n) {
    float mx = -3.0e38f;
#pragma unroll
    for (int m = 0; m < 4; ++m)
#pragma unroll
      for (int r = 0; r < 4; ++r) { float v = s[m][n][r] * sc2; s[m][n][r] = v; mx = fmaxf(mx, v); }
    mx = fmaxf(mx, __shfl_xor(mx, 16));
    mx = fmaxf(mx, __shfl_xor(mx, 32));
    float mnew = fmaxf(mrun[n], mx);
    float alpha = fexp2(mrun[n] - mnew);
    mrun[n] = mnew;
    float ls = 0.f;
#pragma unroll
    for (int m = 0; m < 4; ++m)
#pragma unroll
      for (int r = 0; r < 4; ++r) { float pv = fexp2(s[m][n][r] - mnew); s[m][n][r] = pv; ls += pv; }
    lrun[n] = lrun[n] * alpha + ls;
#pragma unroll
    for (int dt = 0; dt < 4; ++dt) oacc[dt][n] *= alpha;
  }
#pragma unroll
  for (int s2 = 0; s2 < 2; ++s2) {
    bf16x8 vf[4];
#pragma unroll
    for (int dt = 0; dt < 4; ++dt) vf[dt] = *(const bf16x8*)(sv + lds_off(dt * 16 + fr, s2 * 32 + fq * 8));
#pragma unroll
    for (int n = 0; n < 2; ++n) {
      union { bf16x8 v; unsigned u[4]; } pf;
      pf.u[0] = pk_bf16(s[2 * s2][n][0], s[2 * s2][n][1]); pf.u[1] = pk_bf16(s[2 * s2][n][2], s[2 * s2][n][3]);
      pf.u[2] = pk_bf16(s[2 * s2 + 1][n][0], s[2 * s2 + 1][n][1]); pf.u[3] = pk_bf16(s[2 * s2 + 1][n][2], s[2 * s2 + 1][n][3]);
#pragma unroll
      for (int dt = 0; dt < 4; ++dt) oacc[dt][n] = mfma16(vf[dt], pf.v, oacc[dt][n]);
    }
  }
}

__device__ __forceinline__ void phase_attn(const Params& p, int j, char* sm) {
  const int t = tid_now(), lane = t & 63, w = t >> 6, fr = lane & 15, fq = lane >> 4;
  const u16* Q = (const u16*)(p.ws + WS_RA);
  const u16* Kb = (const u16*)(p.ws + WS_RB);
  const u16* VTp = (const u16*)(p.ws + WS_RD);
  const u16* VTs = VTp + (size_t)16 * 256 * 256;
  const u16* SZ = (const u16*)(p.ws + WS_RE);
  const u16* cK = (const u16*)(p.ws + WS_CK);
  const u16* cVT = (const u16*)(p.ws + WS_CVT);
  u16* Y = (u16*)(p.ws + WS_RC);
  const float sc2 = 0.125f * LOG2E;
  const int lrow = t >> 3, lcol = (t & 7) * 8;
  for (int idx = blockIdx.x; idx < 1024; idx += gridDim.x) {
    const bool sample = idx < 512;
    int hq, qb, rowbase, sb;
    if (sample) { sb = idx >> 8; hq = (idx >> 4) & 15; qb = idx & 15; rowbase = 4096 + sb * 2048; }
    else { int ii = idx - 512; sb = ii >> 5; hq = (ii >> 1) & 15; qb = ii & 1; rowbase = sb * 256; }
    const int kvh = hq >> 2;
    const int Q0 = qb * 128, q0 = Q0 + w * 32;
    bf16x8 qf[2][2];
#pragma unroll
    for (int n = 0; n < 2; ++n)
#pragma unroll
      for (int ks = 0; ks < 2; ++ks) qf[n][ks] = *(const bf16x8*)(Q + (size_t)(rowbase + q0 + 16 * n + fr) * 1024 + hq * 64 + ks * 32 + fq * 8);
    f32x4 oacc[4][2];
#pragma unroll
    for (int dt = 0; dt < 4; ++dt)
#pragma unroll
      for (int n = 0; n < 2; ++n) oacc[dt][n] = (f32x4){0.f, 0.f, 0.f, 0.f};
    const float sink2 = p.in[13][j * 16 + hq] * LOG2E;
    float mrun[2] = {sink2, sink2}, lrun[2] = {0.f, 0.f};
    const u16 *K1, *V1, *K2, *V2;
    size_t ldv1, ldv2 = 2048;
    int n1, n2 = 0, lo = 0;
    if (sample) {
      K1 = cK + ((size_t)(sb * 2 + j) * 512) * 256 + kvh * 64;
      V1 = cVT + ((size_t)(sb * 2 + j) * 256 + kvh * 64) * 512; ldv1 = 512; n1 = 8;
      K2 = Kb + (size_t)rowbase * 256 + kvh * 64;
      V2 = VTs + ((size_t)sb * 256 + kvh * 64) * 2048;
      lo = Q0 - 128; lo = lo < 0 ? 0 : lo;
      int hi = Q0 + 256; hi = hi > 2048 ? 2048 : hi;
      n2 = (hi - lo) >> 6;
    } else {
      K1 = Kb + (size_t)rowbase * 256 + kvh * 64;
      V1 = VTp + ((size_t)sb * 256 + kvh * 64) * 256; ldv1 = 256; n1 = 4;
      K2 = K1; V2 = V1;
    }
    const int total = n1 + n2;
    u32x4 rk[2], rv[2];
#define AT_GLOAD(i) do { const u16* _kp; const u16* _vp; size_t _ldv; \
      if ((i) < n1) { _kp = K1 + (size_t)(i) * 64 * 256; _vp = V1 + (i) * 64; _ldv = ldv1; } \
      else { int _k0 = lo + ((i) - n1) * 64; _kp = K2 + (size_t)_k0 * 256; _vp = V2 + _k0; _ldv = ldv2; } \
      _Pragma("unroll") for (int _i = 0; _i < 2; ++_i) { \
        rk[_i] = *(const u32x4*)(_kp + (size_t)(lrow + 32 * _i) * 256 + lcol); \
        rv[_i] = *(const u32x4*)(_vp + (size_t)(lrow + 32 * _i) * _ldv + lcol); } } while (0)
#define AT_LSTORE(buf) do { _Pragma("unroll") for (int _i = 0; _i < 2; ++_i) { \
        *(u32x4*)(sm + (buf) * 16384 + lds_off(lrow + 32 * _i, lcol)) = rk[_i]; \
        *(u32x4*)(sm + (buf) * 16384 + 8192 + lds_off(lrow + 32 * _i, lcol)) = rv[_i]; } } while (0)
    AT_GLOAD(0);
    AT_LSTORE(0);
    __syncthreads();
    for (int i = 0; i < total; ++i) {
      const int cur = i & 1;
      if (i + 1 < total) AT_GLOAD(i + 1);
      const bool masked = i >= n1;
      const int key0 = lo + (i - n1) * 64;
      const bool skip = masked && (key0 + 63 < q0 - 128 || key0 > q0 + 31 + 128);
      if (!skip) attn_comp64_lds(sm + cur * 16384, sm + cur * 16384 + 8192, qf, oacc, mrun, lrun, masked, key0, q0, sc2, fr, fq);
      if (i + 1 < total) AT_LSTORE(cur ^ 1);
      __syncthreads();
    }
#undef AT_GLOAD
#undef AT_LSTORE
#pragma unroll
    for (int n = 0; n < 2; ++n) {
      float lt = lrun[n];
      lt += __shfl_xor(lt, 16);
      lt += __shfl_xor(lt, 32);
      float inv = 1.f / (lt + fexp2(sink2 - mrun[n]));
      size_t row = (size_t)(rowbase + q0 + 16 * n + fr);
#pragma unroll
      for (int dt = 0; dt < 4; ++dt) {
        int d0 = hq * 64 + dt * 16 + 4 * fq;
        uint2 zz = *(const uint2*)(SZ + row * 1024 + d0);
        uint2 o;
        o.x = pk_bf16(oacc[dt][n][0] * inv * bflo(zz.x), oacc[dt][n][1] * inv * bfhi(zz.x));
        o.y = pk_bf16(oacc[dt][n][2] * inv * bflo(zz.y), oacc[dt][n][3] * inv * bfhi(zz.y));
        *(uint2*)(Y + (size_t)(d0 >> 5) * 262144 + row * 32 + (d0 & 31)) = o;
      }
    }
  }
}

__device__ __forceinline__ void phase_pool_inproj(const Params& p, char* sm) {
  const u16* H = (const u16*)(p.ws + WS_RF);
  const u16* W = (const u16*)(p.ws + WS_WPI);
  u16* U = (u16*)(p.ws + WS_RD);
  u16* SZ = (u16*)(p.ws + WS_RE);
  for (int idx = blockIdx.x; idx < 64 * 8; idx += gridDim.x) {
    int mt = idx & 63, nt2 = idx >> 6;
    f32x4 accL[4][4], accR[4][4];
#pragma unroll
    for (int m = 0; m < 4; ++m)
#pragma unroll
      for (int n = 0; n < 4; ++n) { accL[m][n] = (f32x4){0.f, 0.f, 0.f, 0.f}; accR[m][n] = (f32x4){0.f, 0.f, 0.f, 0.f}; }
    gemm_core_glds2(H + (size_t)mt * 128 * 32, 262144, W + (size_t)nt2 * 256 * 32, 2048 * 32, 1024, accL, accR, sm);
    if (nt2 < 4) {
      epi_store_bf16(accL, sm, U + (size_t)mt * 128 * 1024 + nt2 * 256, 1024, IdF());
      epi_store_bf16(accR, sm, U + (size_t)mt * 128 * 1024 + nt2 * 256 + 128, 1024, IdF());
    } else {
      epi_store_bf16(accL, sm, SZ + (size_t)mt * 128 * 1024 + (nt2 - 4) * 256, 1024, SiluF());
      epi_store_bf16(accR, sm, SZ + (size_t)mt * 128 * 1024 + (nt2 - 4) * 256 + 128, 1024, SiluF());
    }
  }
}

struct PoolEpiF {
  const float* scale;
  __device__ __forceinline__ float operator()(int r, int c, float v) const { return v * scale[c]; }
};
template <int W>
__device__ __forceinline__ void pool_d_strip(const u16* __restrict__ uc, u16* __restrict__ dc, int t0, int L) {
  constexpr int LEFT = W / 2, RIGHT = W - 1 - LEFT;
  float pre[49];
  pre[0] = 0.f;
  float ctr[32];
#pragma unroll
  for (int k = 0; k < 48; ++k) {
    int pos = t0 - 8 + k;
    float v = 0.f;
    if (k >= 8 - LEFT && k < 40 + RIGHT) {
      int pc = pos < 0 ? 0 : (pos >= L ? L - 1 : pos);
      float lv = bf2f(uc[(ptrdiff_t)(pc - t0) * 1024]);
      v = (pos >= 0 && pos < L) ? lv : 0.f;
    }
    pre[k + 1] = pre[k] + v;
    if (k >= 8 && k < 40) ctr[k - 8] = v;
  }
#pragma unroll
  for (int i = 0; i < 32; ++i) {
    int pos = t0 + i;
    int lo = pos - LEFT; lo = lo < 0 ? 0 : lo;
    int hi = pos + RIGHT + 1; hi = hi > L ? L : hi;
    float sum = pre[i + 8 + RIGHT + 1] - pre[i + 8 - LEFT];
    dc[(size_t)i * 32] = f2bf(sum / (float)(hi - lo) - ctr[i]);
  }
}
__device__ __forceinline__ void phase_pool_d(const Params& p) {
  const int t = tid_now();
  const u16* U = (const u16*)(p.ws + WS_RD);
  u16* Dm = (u16*)(p.ws + WS_RD + 16 * MiB);
  for (int idx = blockIdx.x; idx < 1024; idx += gridDim.x) {
    const int g = idx & 3, strip = idx >> 2;
    const int row0 = strip * 32;
    int L, t0;
    if (row0 < 4096) { L = 256; t0 = row0 & 255; } else { L = 2048; t0 = (row0 - 4096) & 2047; }
    const u16* uc = U + (size_t)row0 * 1024 + g * 256 + t;
    const int dcol = g * 256 + t;
    u16* dc = Dm + (size_t)(dcol >> 5) * 262144 + (size_t)row0 * 32 + (dcol & 31);
    if (g == 0) pool_d_strip<2>(uc, dc, t0, L);
    else if (g == 1) pool_d_strip<4>(uc, dc, t0, L);
    else if (g == 2) pool_d_strip<8>(uc, dc, t0, L);
    else pool_d_strip<16>(uc, dc, t0, L);
  }
}
__device__ __forceinline__ void phase_pool_gemm(const Params& p, char* sm) {
  const u16* Dm = (const u16*)(p.ws + WS_RD + 16 * MiB);
  const u16* SZ = (const u16*)(p.ws + WS_RE);
  u16* Y = (u16*)(p.ws + WS_RC);
  const u16* Wg = (const u16*)(p.ws + WS_WPG);
  for (int idx = blockIdx.x; idx < 512; idx += gridDim.x) {
    const int mt = idx & 63, gn = idx >> 6, g = gn >> 1, n2 = gn & 1;
    const int row0 = mt * 128;
    f32x4 acc[4][4];
#pragma unroll
    for (int m = 0; m < 4; ++m)
#pragma unroll
      for (int n = 0; n < 4; ++n) acc[m][n] = (f32x4){0.f, 0.f, 0.f, 0.f};
    gemm_core_glds(Dm + (size_t)(g * 8) * 262144 + (size_t)row0 * 32, 262144, Wg + (size_t)g * 65536 + (size_t)n2 * 128 * 32, 256 * 32, 256, acc, sm);
    int c0 = g * 256 + n2 * 128;
    PoolEpiF f{p.in[16] + c0};
    epi_store_bf16_img(acc, sm, Y, row0, c0, f, SZ + (size_t)row0 * 1024 + c0, 1024);
  }
}

__device__ __forceinline__ void phase_ret_inproj(const Params& p, char* sm) {
  const u16* H = (const u16*)(p.ws + WS_RF);
  const u16* W = (const u16*)(p.ws + WS_WRI);
  u16* Q = (u16*)(p.ws + WS_RA);
  u16* Kb = (u16*)(p.ws + WS_RB);
  u16* KTp = (u16*)(p.ws + WS_RC);
  u16* KTs = KTp + (size_t)16 * 1024 * 256;
  u16* VTp = (u16*)(p.ws + WS_RD);
  u16* VTs = VTp + (size_t)16 * 2048 * 256;
  u16* SZ = (u16*)(p.ws + WS_RE);
  for (int idx = blockIdx.x; idx < 64 * 24; idx += gridDim.x) {
    int mt = idx & 63, nt2 = idx >> 6;
    f32x4 accL[4][4], accR[4][4];
#pragma unroll
    for (int m = 0; m < 4; ++m)
#pragma unroll
      for (int n = 0; n < 4; ++n) { accL[m][n] = (f32x4){0.f, 0.f, 0.f, 0.f}; accR[m][n] = (f32x4){0.f, 0.f, 0.f, 0.f}; }
    gemm_core_glds2(H + (size_t)mt * 128 * 32, 262144, W + (size_t)nt2 * 256 * 32, 6144 * 32, 1024, accL, accR, sm);
    const int row0 = mt * 128;
    const bool sample = row0 >= 4096;
    int sb, t0;
    if (!sample) { sb = row0 >> 8; t0 = row0 & 255; } else { sb = (row0 - 4096) >> 11; t0 = (row0 - 4096) & 2047; }
#pragma unroll
    for (int half = 0; half < 2; ++half) {
    f32x4 (&acc)[4][4] = half ? accR : accL;
    const int nt = nt2 * 2 + half;
    if (nt < 8) {
      epi_store_bf16_img(acc, sm, Q, row0, nt * 128, IdF());
    } else if (nt < 16) {
      int c0 = (nt - 8) * 128;
      ScaleF f{0.0625f};
      if (!sample) epi_store_bf16_T(acc, KTp + ((size_t)sb * 1024 + c0) * 256 + t0, 256, f);
      else epi_store_bf16_T(acc, KTs + ((size_t)sb * 1024 + c0) * 2048 + t0, 2048, f);
      epi_store_bf16_img(acc, sm, Kb, row0, c0, f);
    } else if (nt < 32) {
      int c0 = (nt - 16) * 128;
      if (!sample) epi_store_bf16_T(acc, VTp + ((size_t)sb * 2048 + c0) * 256 + t0, 256, IdF());
      else epi_store_bf16_T(acc, VTs + ((size_t)sb * 2048 + c0) * 2048 + t0, 2048, IdF());
    } else {
      epi_store_bf16_img(acc, sm, SZ, row0, (nt - 32) * 128, SiluF());
    }
    }
  }
}

__device__ __forceinline__ void scan_sample64(const Params& p, int ii, char* sm) {
  const int t = tid_now(), lane = t & 63, w = t >> 6, wm = w >> 1, wn = w & 1, fr = lane & 15, fq = lane >> 4;
  const int et8 = ii & 7, dt4 = (ii >> 3) & 3, dir = (ii >> 5) & 1, h = (ii >> 6) & 3, sb = ii >> 8;
  const u16* KTs = (const u16*)(p.ws + WS_RC) + (size_t)16 * 1024 * 256;
  const u16* VTs = (const u16*)(p.ws + WS_RD) + (size_t)16 * 2048 * 256;
  u16* SNAP = (u16*)(p.ws + WS_RF);
  const float lg2 = logsig2((dir ? p.in[20] : p.in[19])[h]);
  const float cdec = fexp2(128.f * lg2);
  const int lrow = t >> 4, kc = t & 15;
  const u16* Ap = KTs + ((size_t)sb * 1024 + h * 256 + dt4 * 64 + lrow) * 2048 + kc * 8;
  const u16* Bp = VTs + ((size_t)sb * 2048 + h * 512 + et8 * 64 + lrow) * 2048 + kc * 8;
  const int ldst = (kc >> 3) * 8192 + lds_off(lrow, (kc & 7) * 8);
  float fs[8];
#pragma unroll
  for (int e = 0; e < 8; ++e) { int jj = kc * 8 + e; fs[e] = fexp2((float)(dir ? jj : 127 - jj) * lg2); }
  f32x4 acc[2][2];
  {
    const float* st = (dir ? p.in[5] : p.in[4]) + ((size_t)(sb * 4 + h) * 256 + dt4 * 64 + wm * 32) * 512 + et8 * 64 + wn * 32;
#pragma unroll
    for (int m = 0; m < 2; ++m)
#pragma unroll
      for (int n = 0; n < 2; ++n)
#pragma unroll
        for (int r = 0; r < 4; ++r) acc[m][n][r] = st[(size_t)(m * 16 + fq * 4 + r) * 512 + n * 16 + fr];
  }
  u32x4 raA[4], rbA[4], raB[4], rbB[4];
#define S6_GLOAD(cc, RA, RB) do { const size_t _o = (size_t)((dir ? 15 - (cc) : (cc)) * 128); _Pragma("unroll") for (int i = 0; i < 4; ++i) { \
    RA[i] = *(const u32x4*)(Ap + (size_t)(16 * i) * 2048 + _o); RB[i] = *(const u32x4*)(Bp + (size_t)(16 * i) * 2048 + _o); } } while (0)
#define S6_LSTORE(buf, RA, RB) do { _Pragma("unroll") for (int i = 0; i < 4; ++i) { u32x4 _v = RA[i], _o; \
    _o[0] = pk_bf16(bflo(_v[0]) * fs[0], bfhi(_v[0]) * fs[1]); _o[1] = pk_bf16(bflo(_v[1]) * fs[2], bfhi(_v[1]) * fs[3]); \
    _o[2] = pk_bf16(bflo(_v[2]) * fs[4], bfhi(_v[2]) * fs[5]); _o[3] = pk_bf16(bflo(_v[3]) * fs[6], bfhi(_v[3]) * fs[7]); \
    *(u32x4*)(sm + (buf) * 32768 + ldst + i * 2048) = _o; *(u32x4*)(sm + (buf) * 32768 + 16384 + ldst + i * 2048) = RB[i]; } } while (0)
#define S6_STEP(cc, RA, RB) do { \
    const int cur = (cc) & 1; \
    { const int c = dir ? 15 - (cc) : (cc); \
      u16* sp = SNAP + (size_t)(((sb * 16 + c) * 4 + h) * 2 + dir) * 131072 + (size_t)(dt4 * 2 + wm) * 16384 + (size_t)(et8 * 64 + wn * 32 + fr) * 32 + fq * 4; \
      _Pragma("unroll") for (int m = 0; m < 2; ++m) _Pragma("unroll") for (int n = 0; n < 2; ++n) { \
          uint2 pk; pk.x = pk_bf16(acc[m][n][0], acc[m][n][1]); pk.y = pk_bf16(acc[m][n][2], acc[m][n][3]); \
          *(uint2*)(sp + (size_t)(n * 16) * 32 + m * 16) = pk; acc[m][n] *= cdec; } } \
    const char* sa = sm + cur * 32768; const char* sb2 = sa + 16384; \
    _Pragma("unroll") for (int kh = 0; kh < 2; ++kh) _Pragma("unroll") for (int ks = 0; ks < 2; ++ks) { \
        bf16x8 a[2], b[2]; \
        _Pragma("unroll") for (int m = 0; m < 2; ++m) a[m] = *(const bf16x8*)(sa + kh * 8192 + lds_off(wm * 32 + m * 16 + fr, ks * 32 + fq * 8)); \
        _Pragma("unroll") for (int n = 0; n < 2; ++n) b[n] = *(const bf16x8*)(sb2 + kh * 8192 + lds_off(wn * 32 + n * 16 + fr, ks * 32 + fq * 8)); \
        _Pragma("unroll") for (int m = 0; m < 2; ++m) _Pragma("unroll") for (int n = 0; n < 2; ++n) acc[m][n] = mfma16(a[m], b[n], acc[m][n]); } \
    if ((cc) + 1 < 15) { S6_LSTORE(cur ^ 1, RA, RB); if ((cc) + 3 < 15) S6_GLOAD((cc) + 3, RA, RB); } \
    __syncthreads(); } while (0)
  S6_GLOAD(0, raA, rbA);
  S6_LSTORE(0, raA, rbA);
  __syncthreads();
  S6_GLOAD(1, raA, rbA);
  S6_GLOAD(2, raB, rbB);
  for (int cc = 0; cc < 15; cc += 2) {
    S6_STEP(cc, raA, rbA);
    if (cc + 1 < 15) S6_STEP(cc + 1, raB, rbB);
  }
#undef S6_STEP
#undef S6_GLOAD
#undef S6_LSTORE
  {
    const int c = dir ? 0 : 15;
    u16* sp = SNAP + (size_t)(((sb * 16 + c) * 4 + h) * 2 + dir) * 131072 + (size_t)(dt4 * 2 + wm) * 16384 + (size_t)(et8 * 64 + wn * 32 + fr) * 32 + fq * 4;
#pragma unroll
    for (int m = 0; m < 2; ++m)
#pragma unroll
      for (int n = 0; n < 2; ++n) {
        uint2 pk; pk.x = pk_bf16(acc[m][n][0], acc[m][n][1]); pk.y = pk_bf16(acc[m][n][2], acc[m][n][3]);
        *(uint2*)(sp + (size_t)(n * 16) * 32 + m * 16) = pk;
      }
  }
}

__device__ __forceinline__ void phase_ret_scan(const Params& p, char* sm) {
  WAVE_IDS;
  const u16* KTp = (const u16*)(p.ws + WS_RC);
  const u16* KTs = KTp + (size_t)16 * 1024 * 256;
  const u16* VTp = (const u16*)(p.ws + WS_RD);
  const u16* VTs = VTp + (size_t)16 * 2048 * 256;
  u16* SNAP = (u16*)(p.ws + WS_RF);
  const int lr = t >> 3, lc = (t & 7) * 8;
  for (int idx = blockIdx.x; idx < 512; idx += gridDim.x) scan_sample64(p, idx, sm);
  for (int idx = 512 + (blockIdx.x + gridDim.x - (512 % gridDim.x)) % gridDim.x; idx < 512 + 1024; idx += gridDim.x) {
    const bool sample = false;
    int ii = idx - 512;
    const int et = ii & 3, dt = (ii >> 2) & 1, dir = (ii >> 3) & 1, h = (ii >> 4) & 3, sb = ii >> 6;
    const float lg2 = logsig2((dir ? p.in[20] : p.in[19])[h]);
    const float cdec = fexp2(128.f * lg2);
    const int nch = sample ? 16 : 2;
    const int nacc = sample ? 15 : 2;
    const size_t ld = sample ? 2048 : 256;
    const u16* Ab = sample ? KTs + ((size_t)sb * 1024 + h * 256 + dt * 128) * 2048 : KTp + ((size_t)sb * 1024 + h * 256 + dt * 128) * 256;
    const u16* Bb = sample ? VTs + ((size_t)sb * 2048 + h * 512 + et * 128) * 2048 : VTp + ((size_t)sb * 2048 + h * 512 + et * 128) * 256;
    const u16* Ap = Ab + (size_t)lr * ld + lc;
    const u16* Bp = Bb + (size_t)lr * ld + lc;
    f32x4 acc[4][4];
#pragma unroll
    for (int m = 0; m < 4; ++m)
#pragma unroll
      for (int n = 0; n < 4; ++n) acc[m][n] = (f32x4){0.f, 0.f, 0.f, 0.f};
    if (sample) {
      const float* st = (dir ? p.in[5] : p.in[4]) + ((size_t)(sb * 4 + h) * 256 + dt * 128) * 512 + et * 128;
#pragma unroll
      for (int m = 0; m < 4; ++m) {
#pragma unroll
        for (int hh = 0; hh < 2; ++hh) {
          const float* pm = opaque(st + (size_t)AROW(m, 2 * hh) * 512 + ACOL(0));
#pragma unroll
          for (int n = 0; n < 4; ++n)
#pragma unroll
            for (int r = 0; r < 2; ++r) acc[m][n][2 * hh + r] = pm[r * 512 + n * 16];
        }
        __builtin_amdgcn_sched_barrier(0);
      }
    }
    float fs0[8];
#pragma unroll
    for (int e = 0; e < 8; ++e) {
      int j0 = lc + e;
      fs0[e] = fexp2((float)(dir ? j0 : 127 - j0) * lg2);
    }
    const float c64 = fexp2((dir ? 64.f : -64.f) * lg2);
    u32x4 ra[4], rb[4];
    const int nq = nacc * 2;
#define SC_TOK(q) ((size_t)((dir ? nch - 1 - ((q) >> 1) : ((q) >> 1)) * 128 + ((q) & 1) * 64))
#define SC_GLOAD(q) do { const size_t _o = SC_TOK(q); _Pragma("unroll") for (int i = 0; i < 4; ++i) { ra[i] = *(const u32x4*)(Ap + (size_t)(32 * i) * ld + _o); rb[i] = *(const u32x4*)(Bp + (size_t)(32 * i) * ld + _o); } } while (0)
#define SC_LSTORE(buf, q) do { \
    const float _cm = ((q) & 1) ? c64 : 1.f; \
    const float g0 = fs0[0] * _cm, g1 = fs0[1] * _cm, g2 = fs0[2] * _cm, g3 = fs0[3] * _cm; \
    const float g4 = fs0[4] * _cm, g5 = fs0[5] * _cm, g6 = fs0[6] * _cm, g7 = fs0[7] * _cm; \
    _Pragma("unroll") for (int i = 0; i < 4; ++i) { \
      u32x4 _v = ra[i]; u32x4 _o; \
      _o[0] = pk_bf16(bflo(_v[0]) * g0, bfhi(_v[0]) * g1); _o[1] = pk_bf16(bflo(_v[1]) * g2, bfhi(_v[1]) * g3); \
      _o[2] = pk_bf16(bflo(_v[2]) * g4, bfhi(_v[2]) * g5); _o[3] = pk_bf16(bflo(_v[3]) * g6, bfhi(_v[3]) * g7); ra[i] = _o; } \
    _Pragma("unroll") for (int i = 0; i < 4; ++i) { *(u32x4*)(sm + (buf) * 32768 + lds_off(lr + 32 * i, lc)) = ra[i]; *(u32x4*)(sm + (buf) * 32768 + 16384 + lds_off(lr + 32 * i, lc)) = rb[i]; } } while (0)
    SC_GLOAD(0);
    SC_LSTORE(0, 0);
    __syncthreads();
    for (int q = 0; q < nq; ++q) {
      const int cur = q & 1;
      if (q + 1 < nq) SC_GLOAD(q + 1);
      if ((q & 1) == 0) {
        const int cc = q >> 1, c = dir ? nch - 1 - cc : cc;
        if (sample || cc == 1) {
          int slot = sample ? ((sb * 16 + c) * 4 + h) * 2 + dir : 256 + (sb * 4 + h) * 2 + dir;
          u16* sp = SNAP + (size_t)slot * 131072;
#pragma unroll
          for (int m = 0; m < 4; ++m)
#pragma unroll
            for (int n = 0; n < 4; ++n) {
              const int dd = dt * 128 + AROW(m, 0), ee = et * 128 + ACOL(n);
              uint2 pk; pk.x = pk_bf16(acc[m][n][0], acc[m][n][1]); pk.y = pk_bf16(acc[m][n][2], acc[m][n][3]);
              *(uint2*)(sp + (size_t)(dd >> 5) * 16384 + (size_t)ee * 32 + (dd & 31)) = pk;
            }
        }
#pragma unroll
        for (int m = 0; m < 4; ++m)
#pragma unroll
          for (int n = 0; n < 4; ++n) acc[m][n] *= cdec;
      }
      const char* sa = sm + cur * 32768;
      const char* sb2 = sa + 16384;
#pragma unroll
      for (int ks = 0; ks < 2; ++ks) {
        bf16x8 a[4], b[4];
#pragma unroll
        for (int m = 0; m < 4; ++m) a[m] = *(const bf16x8*)(sa + lds_off(wm * 64 + m * 16 + fr, ks * 32 + fq * 8));
#pragma unroll
        for (int n = 0; n < 4; ++n) b[n] = *(const bf16x8*)(sb2 + lds_off(wn * 64 + n * 16 + fr, ks * 32 + fq * 8));
#pragma unroll
        for (int m = 0; m < 4; ++m)
#pragma unroll
          for (int n = 0; n < 4; ++n) acc[m][n] = mfma16(a[m], b[n], acc[m][n]);
      }
      if (q + 1 < nq) SC_LSTORE(cur ^ 1, q + 1);
      __syncthreads();
    }
#undef SC_TOK
#undef SC_GLOAD
#undef SC_LSTORE
    if (sample) {
      const int c = dir ? 0 : 15;
      u16* sp = SNAP + (size_t)(((sb * 16 + c) * 4 + h) * 2 + dir) * 131072 + (size_t)(et * 128) * 256 + dt * 128;
      epi_store_bf16_T(acc, sp, 256, IdF());
    } else {
      float* so = p.out + (dir ? O_SB : O_SF) + ((size_t)(sb * 4 + h) * 256 + dt * 128) * 512 + et * 128;
#pragma unroll
      for (int m = 0; m < 4; ++m) {
#pragma unroll
        for (int hh = 0; hh < 2; ++hh) {
          float* pm = opaque(so + (size_t)AROW(m, 2 * hh) * 512 + ACOL(0));
#pragma unroll
          for (int n = 0; n < 4; ++n)
#pragma unroll
            for (int r = 0; r < 2; ++r) pm[r * 512 + n * 16] = acc[m][n][2 * hh + r];
        }
        __builtin_amdgcn_sched_barrier(0);
      }
    }
  }
}

template <int J>
__device__ __forceinline__ void ret_ring_step(int ks, const u16* Ap, const u16* Bp, char* sm, unsigned aA, unsigned aB, int t, f32x4 (&a2)[4][8]) {
  asm volatile("s_waitcnt vmcnt(0)" ::: "memory");
  __builtin_amdgcn_s_barrier();
  if (ks + 1 < 8) {
    char* d = sm + (J ^ 1) * 36864 + t * 16;
    const int ko = (ks + 1) * 32;
    __builtin_amdgcn_global_load_lds((const unsigned*)(Ap + (size_t)(ks + 1) * 262144), (unsigned*)d, 16, 0, 0);
    const u16* bp = opaque(Bp + (size_t)(ks + 1) * 16384);
#pragma unroll
    for (int i = 0; i < 8; ++i) {
      __builtin_amdgcn_global_load_lds((const unsigned*)bp, (unsigned*)(d + 4096 + i * 4096), 16, 0, 0);
      bp = opaque(bp + 64 * 32);
    }
  }
  bf16x8 a0, a1, a2f, a3, b0, b1, b2, b3, b4, b5, b6, b7;
  asm volatile(
      "ds_read_b128 %0, %12 offset:%14\n\t"
      "ds_read_b128 %4, %13 offset:%18\n\t"
      "ds_read_b128 %5, %13 offset:%19\n\t"
      "ds_read_b128 %1, %12 offset:%15\n\t"
      "ds_read_b128 %6, %13 offset:%20\n\t"
      "ds_read_b128 %7, %13 offset:%21\n\t"
      "ds_read_b128 %2, %12 offset:%16\n\t"
      "ds_read_b128 %8, %13 offset:%22\n\t"
      "ds_read_b128 %9, %13 offset:%23\n\t"
      "ds_read_b128 %3, %12 offset:%17\n\t"
      "ds_read_b128 %10, %13 offset:%24\n\t"
      "ds_read_b128 %11, %13 offset:%25\n\t"
      "s_waitcnt lgkmcnt(0)"
      : "=&v"(a0), "=&v"(a1), "=&v"(a2f), "=&v"(a3), "=&v"(b0), "=&v"(b1), "=&v"(b2), "=&v"(b3), "=&v"(b4), "=&v"(b5), "=&v"(b6), "=&v"(b7)
      : "v"(aA), "v"(aB), "n"(J * 36864), "n"(J * 36864 + 1024), "n"(J * 36864 + 2048), "n"(J * 36864 + 3072),
        "n"(J * 36864), "n"(J * 36864 + 1024), "n"(J * 36864 + 2048), "n"(J * 36864 + 3072),
        "n"(J * 36864 + 4096), "n"(J * 36864 + 5120), "n"(J * 36864 + 6144), "n"(J * 36864 + 7168)
      : "memory");
#define RR_ROW(m, am) a2[m][0] = mfma16(am, b0, a2[m][0]); a2[m][1] = mfma16(am, b1, a2[m][1]); a2[m][2] = mfma16(am, b2, a2[m][2]); a2[m][3] = mfma16(am, b3, a2[m][3]); \
                      a2[m][4] = mfma16(am, b4, a2[m][4]); a2[m][5] = mfma16(am, b5, a2[m][5]); a2[m][6] = mfma16(am, b6, a2[m][6]); a2[m][7] = mfma16(am, b7, a2[m][7]);
  RR_ROW(0, a0) RR_ROW(1, a1) RR_ROW(2, a2f) RR_ROW(3, a3)
#undef RR_ROW
  __builtin_amdgcn_sched_barrier(0);
}
__device__ __forceinline__ void ret_ring_gemm(const u16* __restrict__ qbase, const u16* __restrict__ sbase, f32x4 (&a2)[4][8], char* sm) {
  const int t = tid_now(), lane = t & 63, w = t >> 6, fr = lane & 15, fq = lane >> 4;
  const int sb = lane * 16, swz = sb ^ (((sb >> 9) & 1) << 5);
  const int r0 = w * 16 + (swz >> 6), c0 = (swz & 63) >> 1;
  const u16* Ap = qbase + (size_t)r0 * 32 + c0;
  const u16* Bp = sbase + (size_t)r0 * 32 + c0;
  const unsigned smb = (unsigned)(uintptr_t)(LAS3 char*)sm;
  const unsigned aA = smb + lds_off32(fr, fq * 8);
  const unsigned aB = smb + 4096 + w * 8192 + lds_off32(fr, fq * 8);
  {
    char* d = sm + t * 16;
    __builtin_amdgcn_global_load_lds((const unsigned*)Ap, (unsigned*)d, 16, 0, 0);
#pragma unroll
    for (int i = 0; i < 8; ++i)
      __builtin_amdgcn_global_load_lds((const unsigned*)(Bp + (size_t)(64 * i) * 32), (unsigned*)(d + 4096 + i * 4096), 16, 0, 0);
  }
#pragma unroll 1
  for (int ks = 0; ks < 8; ks += 2) {
    ret_ring_step<0>(ks, Ap, Bp, sm, aA, aB, t, a2);
    ret_ring_step<1>(ks + 1, Ap, Bp, sm, aA, aB, t, a2);
  }
  __builtin_amdgcn_s_barrier();
}

__device__ __forceinline__ void phase_ret_out(const Params& p, char* sm) {
  for (int idx = blockIdx.x; idx < 512; idx += gridDim.x) {
    int t = tid_now();
    asm volatile("" : "+v"(t));
    const int lane = t & 63, w = t >> 6, fr = lane & 15, fq = lane >> 4;
    unsigned char* wsb = p.ws;
    asm volatile("" : "+s"(wsb));
    const u16* Q = (const u16*)(wsb + WS_RA);
    const u16* Kb = (const u16*)(wsb + WS_RB);
    const u16* VTp = (const u16*)(wsb + WS_RD);
    const u16* VTs = VTp + (size_t)16 * 2048 * 256;
    u16* SZ = (u16*)(wsb + WS_RE);
    const u16* SNAP = (const u16*)(wsb + WS_RF);
    const float* gn = p.in[21];
    int ii = idx, gc;
    if (ii < 256) gc = 32 + (ii >> 3); else { ii -= 256; gc = ii >> 3; }
    const int h = (ii >> 1) & 3, rh = ii & 1;
    const bool sample = gc >= 32;
    int sb, c;
    if (sample) { sb = (gc - 32) >> 4; c = (gc - 32) & 15; } else { sb = gc >> 1; c = gc & 1; }
    const size_t R0 = (size_t)gc * 128 + rh * 64;
    const float lgf2 = logsig2(p.in[19][h]), lgb2 = logsig2(p.in[20][h]);
    {
      f32x4 a1[4][2];
#pragma unroll
      for (int m = 0; m < 4; ++m)
#pragma unroll
        for (int n = 0; n < 2; ++n) a1[m][n] = (f32x4){0.f, 0.f, 0.f, 0.f};
      const u16* qp = Q + (size_t)(h * 8) * 262144 + (R0 + fr) * 32 + fq * 8;
      const u16* kp = Kb + (size_t)(h * 8) * 262144 + ((size_t)gc * 128 + w * 32 + fr) * 32 + fq * 8;
#pragma unroll 1
      for (int kb = 0; kb < 8; kb += 4) {
        bf16x8 af[4][4], bfr[4][2];
#pragma unroll
        for (int k2 = 0; k2 < 4; ++k2) {
#pragma unroll
          for (int m = 0; m < 4; ++m) af[k2][m] = *(const bf16x8*)(qp + (size_t)(kb + k2) * 262144 + (16 * m) * 32);
#pragma unroll
          for (int n = 0; n < 2; ++n) bfr[k2][n] = *(const bf16x8*)(kp + (size_t)(kb + k2) * 262144 + (16 * n) * 32);
        }
#pragma unroll
        for (int k2 = 0; k2 < 4; ++k2)
#pragma unroll
          for (int m = 0; m < 4; ++m)
#pragma unroll
            for (int n = 0; n < 2; ++n) a1[m][n] = mfma16(af[k2][m], bfr[k2][n], a1[m][n]);
      }
#pragma unroll
      for (int m = 0; m < 4; ++m)
#pragma unroll
        for (int n = 0; n < 2; ++n)
#pragma unroll
          for (int r = 0; r < 4; ++r) {
            int il = 16 * m + 4 * fq + r, i = rh * 64 + il, jj = w * 32 + 16 * n + fr;
            int dd = i - jj;
            float f = dd > 0 ? fexp2((float)dd * lgf2) : (dd < 0 ? fexp2((float)(-dd) * lgb2) : 2.0f);
            *(u16*)(sm + (jj >> 6) * 8192 + lds_off(il, jj & 63)) = f2bf(a1[m][n][r] * f);
          }
    }
    __syncthreads();
    f32x4 a2[4][8];
#pragma unroll
    for (int m = 0; m < 4; ++m)
#pragma unroll
      for (int n = 0; n < 8; ++n) a2[m][n] = (f32x4){0.f, 0.f, 0.f, 0.f};
    {
      const u16* vt; size_t ldv;
      if (sample) { ldv = 2048; vt = VTs + ((size_t)sb * 2048 + h * 512 + w * 128 + fr) * 2048 + c * 128 + fq * 8; }
      else { ldv = 256; vt = VTp + ((size_t)sb * 2048 + h * 512 + w * 128 + fr) * 256 + c * 128 + fq * 8; }
#pragma unroll 1
      for (int kb = 0; kb < 4; kb += 2) {
        bf16x8 bv[2][8];
#pragma unroll
        for (int k2 = 0; k2 < 2; ++k2)
#pragma unroll
          for (int n = 0; n < 8; ++n) bv[k2][n] = *(const bf16x8*)(vt + (size_t)(16 * n) * ldv + (kb + k2) * 32);
#pragma unroll
        for (int k2 = 0; k2 < 2; ++k2) {
          const int ks = kb + k2;
          bf16x8 af[4];
#pragma unroll
          for (int m = 0; m < 4; ++m) af[m] = *(const bf16x8*)(sm + (ks >> 1) * 8192 + lds_off(16 * m + fr, (ks & 1) * 32 + fq * 8));
#pragma unroll
          for (int n = 0; n < 8; ++n)
#pragma unroll
            for (int m = 0; m < 4; ++m) a2[m][n] = mfma16(af[m], bv[k2][n], a2[m][n]);
        }
        __builtin_amdgcn_sched_barrier(0);
      }
    }
    __syncthreads();
    {
      int tb = tid_now();
      asm volatile("" : "+v"(tb));
      const int fq = (tb & 63) >> 4;
      bool hasF = sample || c == 1, hasB = sample || c == 0;
      int mode = 0;
#pragma unroll 1
      for (int dir = 0; dir < 2; ++dir) {
        bool has = dir == 0 ? hasF : hasB;
        if (!has) continue;
#pragma unroll
        for (int m = 0; m < 4; ++m)
#pragma unroll
          for (int r = 0; r < 4; ++r) {
            float fi = (float)(rh * 64 + 16 * m + 4 * fq + r);
            float ecur = mode == 0 ? 0.f : (fi + 1.f) * lgf2;
            float enew = dir == 0 ? (fi + 1.f) * lgf2 : (128.f - fi) * lgb2;
            float f = fexp2(ecur - enew);
#pragma unroll
            for (int n = 0; n < 8; ++n) a2[m][n][r] *= f;
          }
        mode = dir + 1;
        int slot = sample ? ((sb * 16 + c) * 4 + h) * 2 + dir : 256 + (sb * 4 + h) * 2 + dir;
        ret_ring_gemm(Q + (size_t)(h * 8) * 262144 + R0 * 32, SNAP + (size_t)slot * 131072, a2, sm);
      }
      if (mode != 0) {
#pragma unroll
        for (int m = 0; m < 4; ++m)
#pragma unroll
          for (int r = 0; r < 4; ++r) {
            float fi = (float)(rh * 64 + 16 * m + 4 * fq + r);
            float f = fexp2(mode == 1 ? (fi + 1.f) * lgf2 : (128.f - fi) * lgb2);
#pragma unroll
            for (int n = 0; n < 8; ++n) a2[m][n][r] *= f;
          }
      }
    }
    int t3 = tid_now();
    asm volatile("" : "+v"(t3));
    {
    const int lane = t3 & 63, w = t3 >> 6, fr = lane & 15, fq = lane >> 4;
    float* red = (float*)(sm + 69632);
#pragma unroll
    for (int m = 0; m < 4; ++m)
#pragma unroll
      for (int r = 0; r < 4; ++r) {
        float s1 = 0.f, s2 = 0.f;
#pragma unroll
        for (int n = 0; n < 8; ++n) { float v = a2[m][n][r]; s1 += v; s2 += v * v; }
#pragma unroll
        for (int o = 1; o < 16; o <<= 1) { s1 += __shfl_xor(s1, o); s2 += __shfl_xor(s2, o); }
        if (fr == 0) { int row = 16 * m + 4 * fq + r; red[(w * 64 + row) * 2] = s1; red[(w * 64 + row) * 2 + 1] = s2; }
      }
    __syncthreads();
    u16* stg = (u16*)(sm + w * 17408);
    float gv[8];
#pragma unroll
    for (int n = 0; n < 8; ++n) gv[n] = gn[h * 512 + w * 128 + 16 * n + fr];
#pragma unroll
    for (int m = 0; m < 4; ++m)
#pragma unroll
      for (int r = 0; r < 4; ++r) {
        int row = 16 * m + 4 * fq + r;
        float s1 = 0.f, s2 = 0.f;
#pragma unroll
        for (int ww = 0; ww < 4; ++ww) { s1 += red[(ww * 64 + row) * 2]; s2 += red[(ww * 64 + row) * 2 + 1]; }
        float mean = s1 * (1.f / 512.f);
        float var = s2 * (1.f / 512.f) - mean * mean;
        var = var < 0.f ? 0.f : var;
        float rstd = rsqrtf(var + 1e-6f);
#pragma unroll
        for (int n = 0; n < 8; ++n) stg[row * 136 + 16 * n + fr] = f2bf((a2[m][n][r] - mean) * rstd * gv[n]);
      }
#pragma unroll 8
    for (int i = 0; i < 16; ++i) {
      int row = (lane >> 4) + 4 * i, ch = lane & 15;
      uint4 yv = *(const uint4*)(stg + row * 136 + ch * 8);
      const int zc = h * 512 + w * 128 + ch * 8;
      u16* zp = SZ + (size_t)(zc >> 5) * 262144 + (R0 + row) * 32 + (zc & 31);
      uint4 zv = *(const uint4*)zp;
      uint4 o;
      o.x = pk_bf16(bflo(yv.x) * bflo(zv.x), bfhi(yv.x) * bfhi(zv.x));
      o.y = pk_bf16(bflo(yv.y) * bflo(zv.y), bfhi(yv.y) * bfhi(zv.y));
      o.z = pk_bf16(bflo(yv.z) * bflo(zv.z), bfhi(yv.z) * bfhi(zv.z));
      o.w = pk_bf16(bflo(yv.w) * bflo(zv.w), bfhi(yv.w) * bfhi(zv.w));
      *(uint4*)zp = o;
    }
    }
    __syncthreads();
  }
}

#define XB_TMO      128
#define XB_XCNT(j)  (256  + 64 * (j))
#define XB_XSUB(j)  (1280 + 64 * (j))
#define XB_XGEN(j)  (2304 + 64 * (j))
#define XB_TOP      3328
#define XB_TOPGEN   3392
#define XCD_BAR_WORDS 3456
#define XB_SPIN_CAP (1u << 18)
#define LAS __attribute__((address_space(3)))
__device__ __forceinline__ unsigned xb_ld(unsigned* p)              { return __hip_atomic_load(p, __ATOMIC_RELAXED, __HIP_MEMORY_SCOPE_AGENT); }
__device__ __forceinline__ unsigned xb_add(unsigned* p, unsigned v) { return __hip_atomic_fetch_add(p, v, __ATOMIC_RELAXED, __HIP_MEMORY_SCOPE_AGENT); }
__device__ __forceinline__ unsigned xb_xcc_id() { return (unsigned)__builtin_amdgcn_s_getreg((3 << 11) | 20) & 0xFu; }
#define XB_SPIN(cond, bar) do { unsigned _sp = 0; while (cond) { __builtin_amdgcn_s_sleep(1); \
    if ((++_sp & 255u) == 0u) { if (xb_ld(&(bar)[XB_TMO])) break; if (_sp > XB_SPIN_CAP) { atomicAdd(&(bar)[XB_TMO], 1u); break; } } } } while (0)
struct XcdBarrier { unsigned* bar; unsigned x; volatile LAS unsigned* st; };
__device__ __forceinline__ XcdBarrier xcd_barrier_post(unsigned* bar, volatile LAS unsigned* st) {
    XcdBarrier b; b.bar = bar; b.x = xb_xcc_id(); b.st = st;
    if (tid_now() == 0) (void)xb_add(&bar[XB_XCNT(b.x)], 1u);
    return b;
}
__device__ __forceinline__ void xcd_barrier_complete(unsigned* bar, unsigned x, unsigned& nloc, unsigned& nx) {
    const unsigned G = gridDim.x * gridDim.y * gridDim.z;
    unsigned sum, cnt, mine, sp = 0u;
    for (;;) {
        sum = 0u; cnt = 0u; mine = 0u;
#pragma unroll
        for (unsigned j = 0; j < 16; ++j) { const unsigned c = xb_ld(&bar[XB_XCNT(j)]); sum += c; cnt += (c > 0u) ? 1u : 0u; mine = (j == x) ? c : mine; }
        if (sum == G) break;
        __builtin_amdgcn_s_sleep(1);
        if ((++sp & 255u) == 0u) { if (xb_ld(&bar[XB_TMO])) break; if (sp > XB_SPIN_CAP) { atomicAdd(&bar[XB_TMO], 1u); break; } }
    }
    nloc = mine > 0u ? mine : 1u; nx = cnt > 0u ? cnt : 1u;
}
__device__ __forceinline__ void xcd_barrier(const XcdBarrier& b) {
    asm volatile("s_waitcnt vmcnt(0)" ::: "memory");
    __syncthreads();
    if (tid_now() == 0) {
        unsigned* bar = b.bar;
        __builtin_amdgcn_s_waitcnt(0);
        unsigned nloc = b.st[0], nx = b.st[1];
        if (nloc == 0u) { xcd_barrier_complete(bar, b.x, nloc, nx); b.st[0] = nloc; b.st[1] = nx; }
        const unsigned old = xb_add(&bar[XB_XSUB(b.x)], 1u);
        const unsigned gen = old / nloc;
        if (old + 1u == (gen + 1u) * nloc) {
            __builtin_amdgcn_fence(__ATOMIC_RELEASE, "agent");
            asm volatile("s_waitcnt vmcnt(0)" ::: "memory");
            const unsigned og = xb_add(&bar[XB_TOP], 1u);
            const unsigned tg = og / nx;
            if (og + 1u == (tg + 1u) * nx) xb_add(&bar[XB_TOPGEN], 1u);
            else XB_SPIN(xb_ld(&bar[XB_TOPGEN]) == tg, bar);
            __builtin_amdgcn_fence(__ATOMIC_ACQUIRE, "agent");
            xb_add(&bar[XB_XGEN(b.x)], 1u);
            asm volatile("s_waitcnt vmcnt(0)" ::: "memory");
        } else {
            XB_SPIN(xb_ld(&bar[XB_XGEN(b.x)]) == gen, bar);
            __builtin_amdgcn_fence(__ATOMIC_ACQUIRE, "agent");
            asm volatile("s_waitcnt vmcnt(0)" ::: "memory");
        }
    }
    __syncthreads();
}

__global__ void __launch_bounds__(NTHREADS, 2) mega(Params p, int ph_lo, int ph_hi) {
  __shared__ __attribute__((aligned(16))) char sm[SMEM_BYTES];
  cg::grid_group grid = cg::this_grid();
  __shared__ uint4 xb_words;
  if ((threadIdx.x & 63) == 0) g_wave_tab[hw_slot()] = (int)(threadIdx.x >> 6);
  if (threadIdx.x == 0) xb_words = make_uint4(0u, 0u, 0u, 0u);
  __syncthreads();
  (void)xcd_barrier_post((unsigned*)(p.ws + WS_BAR), (volatile LAS unsigned*)&xb_words);
  if (ph_lo < 0) grid.sync();
  const float* xp0 = p.in[0];
  const float* xs0 = p.in[1];
  const float* xp1 = p.out;
  const float* xs1 = p.out + (size_t)4096 * 1024;
#ifndef PH_ONLY
#define PH_ONLY -1
#endif
#define PHON(x) (PH_ONLY < 0 || PH_ONLY == (x))
#define RUN(k, call) do { if (ph_lo <= (k) && (k) < ph_hi) { if (PHON(k)) { call; } if ((k) + 1 < ph_hi) { XcdBarrier xb; xb.bar = (unsigned*)(p.ws + WS_BAR); xb.x = xb_xcc_id(); xb.st = (volatile LAS unsigned*)&xb_words; xcd_barrier(xb); } } } while (0)
  RUN(0, phase_prep(p, sm));
  RUN(1, phase_norm(p, 0, xp0, xs0));
  RUN(2, phase_attn_inproj(p, 0, sm));
  RUN(3, phase_attn(p, 0, sm));
  RUN(4, phase_outproj(p, 0, (const u16*)(p.ws + WS_RC), 1024, (const u16*)(p.ws + WS_WAO), xp0, xs0, sm));
  RUN(5, phase_norm(p, 1, xp1, xs1));
  RUN(6, phase_pool_inproj(p, sm));
  RUN(7, phase_pool_d(p));
  RUN(8, phase_pool_gemm(p, sm));
  RUN(9, phase_outproj(p, 1, (const u16*)(p.ws + WS_RC), 1024, (const u16*)(p.ws + WS_WPO), xp1, xs1, sm));
  RUN(10, phase_norm(p, 2, xp1, xs1));
  RUN(11, phase_ret_inproj(p, sm));
  RUN(12, phase_ret_scan(p, sm));
  RUN(13, phase_ret_out(p, sm));
  RUN(14, phase_outproj(p, 2, (const u16*)(p.ws + WS_RE), 2048, (const u16*)(p.ws + WS_WRO), xp1, xs1, sm));
  RUN(15, phase_norm(p, 3, xp1, xs1));
  RUN(16, phase_attn_inproj(p, 1, sm));
  RUN(17, phase_attn(p, 1, sm));
  RUN(18, phase_outproj(p, 3, (const u16*)(p.ws + WS_RC), 1024, (const u16*)(p.ws + WS_WAO) + (size_t)1024 * 1024, xp1, xs1, sm));
  RUN(19, phase_final_norm(p));
}

extern "C" void kernel_launch(void* const* d_in, const int* in_sizes, int n_in, void* d_out, int out_size, void* d_ws, size_t ws_size,
                              hipStream_t stream) {
  static int grid_blocks = 0;
  if (!grid_blocks) {
    int dev = 0, cus = 0, per_cu = 0;
    hipGetDevice(&dev);
    hipDeviceGetAttribute(&cus, hipDeviceAttributeMultiprocessorCount, dev);
    hipOccupancyMaxActiveBlocksPerMultiprocessor(&per_cu, mega, NTHREADS, 0);
    if (per_cu < 1) per_cu = 1;
    if (per_cu > 2) per_cu = 2;
    grid_blocks = cus * per_cu;
    if (ws_size < WS_END) fprintf(stderr, "kernel_launch: workspace too small: %zu < %zu\n", ws_size, (size_t)WS_END);
  }
  Params p{};
  for (int i = 0; i < 24; ++i) p.in[i] = (const float*)d_in[i];
  p.out = (float*)d_out;
  p.ws = (unsigned char*)d_ws;
#ifndef N_SPLIT
#define N_SPLIT 1
#endif
#ifndef PH_END
#define PH_END 20
#endif
  if (PH_END < 20) (void)hipMemsetAsync(d_out, 0, (size_t)out_size * 4, stream);
  (void)hipMemsetAsync((char*)d_ws + WS_BAR, 0, XCD_BAR_WORDS * 4, stream);
#ifndef PROBE_DUP
#define PROBE_DUP -1
#endif
  {
    int seg[4][2]; int nseg = 0;
    if (PROBE_DUP < 0) { seg[0][0] = 0; seg[0][1] = PH_END; nseg = 1; }
#ifndef PROBE_LO
#define PROBE_LO PROBE_DUP
#endif
    else { seg[0][0] = 0; seg[0][1] = PROBE_DUP + 1; seg[1][0] = PROBE_LO; seg[1][1] = PROBE_DUP + 1; nseg = 2; if (PROBE_DUP + 1 < 20) { seg[2][0] = PROBE_DUP + 1; seg[2][1] = 20; nseg = 3; } }
    for (int li = 0; li < nseg; ++li) {
      int lo = seg[li][0], hi = seg[li][1];
      if (li > 0) (void)hipMemsetAsync((char*)d_ws + WS_BAR, 0, XCD_BAR_WORDS * 4, stream);
      void* args[] = {&p, &lo, &hi};
      hipError_t e = hipLaunchCooperativeKernel((void*)mega, dim3(grid_blocks), dim3(NTHREADS), args, 0, stream);
      if (e != hipSuccess) fprintf(stderr, "cooperative launch failed: %s (grid %d)\n", hipGetErrorString(e), grid_blocks);
    }
  }
}
```

```cpp
#include <hip/hip_runtime.h>
#include <hip/hip_cooperative_groups.h>
#include <cstdio>
#include <cstdint>
namespace cg = cooperative_groups;

typedef unsigned short u16;
typedef short bf16x8 __attribute__((ext_vector_type(8)));
typedef float f32x4 __attribute__((ext_vector_type(4)));
typedef unsigned u32x4 __attribute__((ext_vector_type(4)));

#define NTHREADS 256
#define SMEM_BYTES 73728
constexpr float LOG2E = 1.4426950408889634f;

constexpr size_t MiB = 1048576;
constexpr size_t WS_MOD  = 0;
constexpr size_t WS_ROPE = 147456;
constexpr size_t WS_BAR  = 155648;
constexpr size_t WS_WAI  = 262144;
constexpr size_t WS_WAO  = WS_WAI + 2 * 2560 * 1024 * 2;
constexpr size_t WS_WPI  = WS_WAO + 2 * 1024 * 1024 * 2;
constexpr size_t WS_WPG  = WS_WPI + 2048 * 1024 * 2;
constexpr size_t WS_WPO  = WS_WPG + 4 * 256 * 256 * 2;
constexpr size_t WS_WRI  = WS_WPO + 1024 * 1024 * 2;
constexpr size_t WS_WRO  = WS_WRI + 6144 * 1024 * 2;
constexpr size_t WS_CK   = WS_WRO + 1024 * 2048 * 2;
constexpr size_t WS_CVT  = WS_CK + 2 * 2 * 512 * 256 * 2;
constexpr size_t WS_RA   = WS_CVT + 2 * 2 * 512 * 256 * 2;
constexpr size_t WS_RB   = WS_RA + 16 * MiB;
constexpr size_t WS_RC   = WS_RB + 16 * MiB;
constexpr size_t WS_RD   = WS_RC + 16 * MiB;
constexpr size_t WS_RE   = WS_RD + 32 * MiB;
constexpr size_t WS_RF   = WS_RE + 32 * MiB;
constexpr size_t WS_END  = WS_RF + 96 * MiB;

constexpr size_t O_NK = 8388608, O_NV = 10485760, O_SF = 12582912, O_SB = 20971520;

struct Params {
  const float* in[24];
  float* out;
  unsigned char* ws;
};

typedef __bf16 bf16x2_t __attribute__((ext_vector_type(2)));
__device__ __forceinline__ unsigned pk_bf16(float lo, float hi) { bf16x2_t v; v.x = (__bf16)lo; v.y = (__bf16)hi; return __builtin_bit_cast(unsigned, v); }
__device__ __forceinline__ u16 f2bf(float f) { return __builtin_bit_cast(u16, (__bf16)f); }
__device__ __forceinline__ float bf2f(u16 h) { return __uint_as_float(((unsigned)h) << 16); }
__device__ __forceinline__ float bflo(unsigned u) { return __uint_as_float(u << 16); }
__device__ __forceinline__ float bfhi(unsigned u) { return __uint_as_float(u & 0xffff0000u); }
__device__ __forceinline__ float fexp2(float x) { return __builtin_amdgcn_exp2f(x); }
__shared__ int g_wave_tab[64];
__device__ __forceinline__ int hw_slot() { return (int)(__builtin_amdgcn_s_getreg(((6 - 1) << 11) | 4) & 63u); }
__device__ __forceinline__ int lane_now() { return (int)__builtin_amdgcn_mbcnt_hi(~0u, __builtin_amdgcn_mbcnt_lo(~0u, 0u)); }
__device__ __forceinline__ int tid_now() { return __builtin_amdgcn_readfirstlane(g_wave_tab[hw_slot()]) * 64 + lane_now(); }
__device__ __forceinline__ float silu(float x) { return x / (1.f + __expf(-x)); }
__device__ __forceinline__ float logsig2(float x) { return -log1pf(expf(-x)) * LOG2E; }
__device__ __forceinline__ f32x4 mfma16(bf16x8 a, bf16x8 b, f32x4 c) { return __builtin_amdgcn_mfma_f32_16x16x32_bf16(a, b, c, 0, 0, 0); }

template <typename T> __device__ __forceinline__ T* opaque(T* p) { asm volatile("" : "+v"(p)); return p; }

__device__ __forceinline__ int lds_off(int r, int c) {
  int st = (r >> 4) * 2 + (c >> 5), ob = (r & 15) * 64 + (c & 31) * 2;
  return st * 1024 + (ob ^ (((ob >> 9) & 1) << 5));
}

__device__ __forceinline__ bf16x8 scale_frag(bf16x8 v, float s) {
  union { bf16x8 v; unsigned u[4]; } x; x.v = v;
#pragma unroll
  for (int i = 0; i < 4; ++i) x.u[i] = pk_bf16(bflo(x.u[i]) * s, bfhi(x.u[i]) * s);
  return x.v;
}

template <bool SCALE>
__device__ __forceinline__ void gemm_core(const u16* __restrict__ A, size_t lda, const u16* __restrict__ B, size_t ldb, int K,
                                          f32x4 (&acc)[4][4], char* sm, float lg2 = 0.f, int dir = 0) {
  const int t = tid_now(), lane = t & 63, w = t >> 6, wm = w >> 1, wn = w & 1, fr = lane & 15, fq = lane >> 4;
  const int lr = t >> 3, lc = (t & 7) * 8;
  uint4 ra[4], rb[4];
  const int nk = K >> 6;
  const u16* Ap = A + (size_t)lr * lda + lc;
  const u16* Bp = B + (size_t)lr * ldb + lc;
#define GLOAD(kt) do { _Pragma("unroll") for (int i = 0; i < 4; ++i) { ra[i] = *(const uint4*)(Ap + (size_t)(32 * i) * lda + (kt) * 64); rb[i] = *(const uint4*)(Bp + (size_t)(32 * i) * ldb + (kt) * 64); } } while (0)
#define LSTORE(buf, kt) do { \
    if (SCALE) { float fs[8]; _Pragma("unroll") for (int e = 0; e < 8; ++e) { int j = (kt) * 64 + lc + e; fs[e] = fexp2((float)(dir ? j : 127 - j) * lg2); } \
      _Pragma("unroll") for (int i = 0; i < 4; ++i) { unsigned* u = (unsigned*)&ra[i]; _Pragma("unroll") for (int e = 0; e < 4; ++e) u[e] = pk_bf16(bflo(u[e]) * fs[2 * e], bfhi(u[e]) * fs[2 * e + 1]); } } \
    _Pragma("unroll") for (int i = 0; i < 4; ++i) { *(uint4*)(sm + (buf) * 32768 + lds_off(lr + 32 * i, lc)) = ra[i]; *(uint4*)(sm + (buf) * 32768 + 16384 + lds_off(lr + 32 * i, lc)) = rb[i]; } } while (0)
  GLOAD(0);
  LSTORE(0, 0);
  __syncthreads();
  for (int kt = 0; kt < nk; ++kt) {
    const int cur = kt & 1;
    if (kt + 1 < nk) GLOAD(kt + 1);
    const char* sa = sm + cur * 32768;
    const char* sb = sa + 16384;
#pragma unroll
    for (int ks = 0; ks < 2; ++ks) {
      bf16x8 a[4], b[4];
#pragma unroll
      for (int m = 0; m < 4; ++m) a[m] = *(const bf16x8*)(sa + lds_off(wm * 64 + m * 16 + fr, ks * 32 + fq * 8));
#pragma unroll
      for (int n = 0; n < 4; ++n) b[n] = *(const bf16x8*)(sb + lds_off(wn * 64 + n * 16 + fr, ks * 32 + fq * 8));
#pragma unroll
      for (int m = 0; m < 4; ++m)
#pragma unroll
        for (int n = 0; n < 4; ++n) acc[m][n] = mfma16(a[m], b[n], acc[m][n]);
    }
    if (kt + 1 < nk) LSTORE(cur ^ 1, kt + 1);
    __syncthreads();
  }
#undef GLOAD
#undef LSTORE
}

__device__ __forceinline__ int lds_off32(int r, int c) {
  int ob = (r & 15) * 64 + c * 2;
  return (r >> 4) * 1024 + (ob ^ (((ob >> 9) & 1) << 5));
}
#define LAS3 __attribute__((address_space(3)))
template <int J>
__device__ __forceinline__ void glds_step(int kt, int nk, const u16* Ap, size_t lda, const u16* Bp, size_t ldb, char* sm, unsigned aA, unsigned aB,
                                          f32x4 (&acc)[4][4]) {
  const int t = tid_now();
  if (kt + 2 < nk) asm volatile("s_waitcnt vmcnt(8)" ::: "memory");
  else if (kt + 1 < nk) asm volatile("s_waitcnt vmcnt(4)" ::: "memory");
  else asm volatile("s_waitcnt vmcnt(0)" ::: "memory");
  __builtin_amdgcn_s_barrier();
  bf16x8 a0, a1, a2, a3, b0, b1, b2, b3;
  asm volatile(
      "ds_read_b128 %0, %8 offset:%10\n\t"
      "ds_read_b128 %4, %9 offset:%10\n\t"
      "ds_read_b128 %5, %9 offset:%11\n\t"
      "ds_read_b128 %1, %8 offset:%11\n\t"
      "ds_read_b128 %6, %9 offset:%12\n\t"
      "ds_read_b128 %7, %9 offset:%13\n\t"
      "ds_read_b128 %2, %8 offset:%12\n\t"
      "ds_read_b128 %3, %8 offset:%13\n\t"
      "s_waitcnt lgkmcnt(0)"
      : "=&v"(a0), "=&v"(a1), "=&v"(a2), "=&v"(a3), "=&v"(b0), "=&v"(b1), "=&v"(b2), "=&v"(b3)
      : "v"(aA), "v"(aB), "n"(J * 16384), "n"(J * 16384 + 1024), "n"(J * 16384 + 2048), "n"(J * 16384 + 3072)
      : "memory");
  if (kt + 3 < nk) {
    char* d = sm + ((J + 3) & 3) * 16384 + t * 16;
    const size_t ko = (size_t)(kt + 3) * 32;
#pragma unroll
    for (int i = 0; i < 2; ++i) {
      __builtin_amdgcn_global_load_lds((const unsigned*)(Ap + (size_t)(64 * i) * 32 + (size_t)(kt + 3) * lda), (unsigned*)(d + i * 4096), 16, 0, 0);
      __builtin_amdgcn_global_load_lds((const unsigned*)(Bp + (size_t)(64 * i) * 32 + (size_t)(kt + 3) * ldb), (unsigned*)(d + 8192 + i * 4096), 16, 0, 0);
    }
  }
  acc[0][0] = mfma16(a0, b0, acc[0][0]); acc[0][1] = mfma16(a0, b1, acc[0][1]); acc[0][2] = mfma16(a0, b2, acc[0][2]); acc[0][3] = mfma16(a0, b3, acc[0][3]);
  acc[1][0] = mfma16(a1, b0, acc[1][0]); acc[1][1] = mfma16(a1, b1, acc[1][1]); acc[1][2] = mfma16(a1, b2, acc[1][2]); acc[1][3] = mfma16(a1, b3, acc[1][3]);
  acc[2][0] = mfma16(a2, b0, acc[2][0]); acc[2][1] = mfma16(a2, b1, acc[2][1]); acc[2][2] = mfma16(a2, b2, acc[2][2]); acc[2][3] = mfma16(a2, b3, acc[2][3]);
  acc[3][0] = mfma16(a3, b0, acc[3][0]); acc[3][1] = mfma16(a3, b1, acc[3][1]); acc[3][2] = mfma16(a3, b2, acc[3][2]); acc[3][3] = mfma16(a3, b3, acc[3][3]);
}
__device__ __forceinline__ void gemm_core_glds(const u16* __restrict__ A, size_t lda, const u16* __restrict__ B, size_t ldb, int K,
                                               f32x4 (&acc)[4][4], char* sm) {
  const int t = tid_now(), lane = t & 63, w = t >> 6, wm = w >> 1, wn = w & 1, fr = lane & 15, fq = lane >> 4;
  const int sb = lane * 16, swz = sb ^ (((sb >> 9) & 1) << 5);
  const int r0 = w * 16 + (swz >> 6), c0 = (swz & 63) >> 1;
  const u16* Ap = A + (size_t)r0 * 32 + c0;
  const u16* Bp = B + (size_t)r0 * 32 + c0;
  const int nk = K >> 5;
  const unsigned smb = (unsigned)(uintptr_t)(LAS3 char*)sm;
  const unsigned aA = smb + lds_off32(wm * 64 + fr, fq * 8);
  const unsigned aB = smb + 8192 + lds_off32(wn * 64 + fr, fq * 8);
#pragma unroll
  for (int j = 0; j < 3; ++j) {
    char* d = sm + j * 16384 + t * 16;
#pragma unroll
    for (int i = 0; i < 2; ++i) {
      __builtin_amdgcn_global_load_lds((const unsigned*)(Ap + (size_t)(64 * i) * 32 + (size_t)j * lda), (unsigned*)(d + i * 4096), 16, 0, 0);
      __builtin_amdgcn_global_load_lds((const unsigned*)(Bp + (size_t)(64 * i) * 32 + (size_t)j * ldb), (unsigned*)(d + 8192 + i * 4096), 16, 0, 0);
    }
  }
  for (int kt0 = 0; kt0 < nk; kt0 += 4) {
    glds_step<0>(kt0, nk, Ap, lda, Bp, ldb, sm, aA, aB, acc);
    glds_step<1>(kt0 + 1, nk, Ap, lda, Bp, ldb, sm, aA, aB, acc);
    glds_step<2>(kt0 + 2, nk, Ap, lda, Bp, ldb, sm, aA, aB, acc);
    glds_step<3>(kt0 + 3, nk, Ap, lda, Bp, ldb, sm, aA, aB, acc);
  }
  __syncthreads();
}

template <int J>
__device__ __forceinline__ void glds2_step(int kt, int nk, const u16* Ap, size_t lda, const u16* Bp, size_t ldb, char* sm, unsigned aA, unsigned aB, int t,
                                           f32x4 (&accL)[4][4], f32x4 (&accR)[4][4]) {
  if (kt + 1 < nk) asm volatile("s_waitcnt vmcnt(6)" ::: "memory");
  else asm volatile("s_waitcnt vmcnt(0)" ::: "memory");
  __builtin_amdgcn_s_barrier();
  bf16x8 a0, a1, a2, a3, b0, b1, b2, b3, b4, b5, b6, b7;
  asm volatile(
      "ds_read_b128 %0, %12 offset:%14\n\t"
      "ds_read_b128 %4, %13 offset:%14\n\t"
      "ds_read_b128 %5, %13 offset:%15\n\t"
      "ds_read_b128 %1, %12 offset:%15\n\t"
      "ds_read_b128 %6, %13 offset:%16\n\t"
      "ds_read_b128 %7, %13 offset:%17\n\t"
      "ds_read_b128 %2, %12 offset:%16\n\t"
      "ds_read_b128 %8, %13 offset:%18\n\t"
      "ds_read_b128 %9, %13 offset:%19\n\t"
      "ds_read_b128 %3, %12 offset:%17\n\t"
      "ds_read_b128 %10, %13 offset:%20\n\t"
      "ds_read_b128 %11, %13 offset:%21\n\t"
      "s_waitcnt lgkmcnt(0)"
      : "=&v"(a0), "=&v"(a1), "=&v"(a2), "=&v"(a3), "=&v"(b0), "=&v"(b1), "=&v"(b2), "=&v"(b3), "=&v"(b4), "=&v"(b5), "=&v"(b6), "=&v"(b7)
      : "v"(aA), "v"(aB), "n"(J * 24576), "n"(J * 24576 + 1024), "n"(J * 24576 + 2048), "n"(J * 24576 + 3072),
        "n"(J * 24576 + 8192), "n"(J * 24576 + 9216), "n"(J * 24576 + 10240), "n"(J * 24576 + 11264)
      : "memory");
  if (kt + 2 < nk) {
    char* d = sm + ((J + 2) % 3) * 24576 + t * 16;
    const size_t ko = (size_t)(kt + 2) * 32;
#pragma unroll
    for (int i = 0; i < 2; ++i) __builtin_amdgcn_global_load_lds((const unsigned*)(Ap + (size_t)(64 * i) * 32 + (size_t)(kt + 2) * lda), (unsigned*)(d + i * 4096), 16, 0, 0);
#pragma unroll
    for (int i = 0; i < 4; ++i) __builtin_amdgcn_global_load_lds((const unsigned*)(Bp + (size_t)(64 * i) * 32 + (size_t)(kt + 2) * ldb), (unsigned*)(d + 8192 + i * 4096), 16, 0, 0);
  }
#define G2_ROW(m, am) accL[m][0] = mfma16(am, b0, accL[m][0]); accL[m][1] = mfma16(am, b1, accL[m][1]); accL[m][2] = mfma16(am, b2, accL[m][2]); accL[m][3] = mfma16(am, b3, accL[m][3]); \
                      accR[m][0] = mfma16(am, b4, accR[m][0]); accR[m][1] = mfma16(am, b5, accR[m][1]); accR[m][2] = mfma16(am, b6, accR[m][2]); accR[m][3] = mfma16(am, b7, accR[m][3]);
  G2_ROW(0, a0) G2_ROW(1, a1) G2_ROW(2, a2) G2_ROW(3, a3)
#undef G2_ROW
  __builtin_amdgcn_sched_barrier(0);
}
__device__ __forceinline__ void gemm_core_glds2(const u16* __restrict__ A, size_t lda, const u16* __restrict__ B, size_t ldb, int K,
                                                f32x4 (&accL)[4][4], f32x4 (&accR)[4][4], char* sm) {
  const int t = tid_now(), lane = t & 63, w = t >> 6, wm = w >> 1, wn = w & 1, fr = lane & 15, fq = lane >> 4;
  const int sb = lane * 16, swz = sb ^ (((sb >> 9) & 1) << 5);
  const int r0 = w * 16 + (swz >> 6), c0 = (swz & 63) >> 1;
  const u16* Ap = A + (size_t)r0 * 32 + c0;
  const u16* Bp = B + (size_t)r0 * 32 + c0;
  const int nk = K >> 5;
  const unsigned smb = (unsigned)(uintptr_t)(LAS3 char*)sm;
  const unsigned aA = smb + lds_off32(wm * 64 + fr, fq * 8);
  const unsigned aB = smb + 8192 + lds_off32(wn * 64 + fr, fq * 8);
#pragma unroll
  for (int j = 0; j < 2; ++j) {
    char* d = sm + j * 24576 + t * 16;
#pragma unroll
    for (int i = 0; i < 2; ++i) __builtin_amdgcn_global_load_lds((const unsigned*)(Ap + (size_t)(64 * i) * 32 + (size_t)j * lda), (unsigned*)(d + i * 4096), 16, 0, 0);
#pragma unroll
    for (int i = 0; i < 4; ++i) __builtin_amdgcn_global_load_lds((const unsigned*)(Bp + (size_t)(64 * i) * 32 + (size_t)j * ldb), (unsigned*)(d + 8192 + i * 4096), 16, 0, 0);
  }
  for (int kt0 = 0; kt0 < nk; kt0 += 3) {
    glds2_step<0>(kt0, nk, Ap, lda, Bp, ldb, sm, aA, aB, t, accL, accR);
    if (kt0 + 1 < nk) glds2_step<1>(kt0 + 1, nk, Ap, lda, Bp, ldb, sm, aA, aB, t, accL, accR);
    if (kt0 + 2 < nk) glds2_step<2>(kt0 + 2, nk, Ap, lda, Bp, ldb, sm, aA, aB, t, accL, accR);
  }
  __syncthreads();
}

#define WAVE_IDS const int t = tid_now(), lane = t & 63, w = t >> 6, wm = w >> 1, wn = w & 1, fr = lane & 15, fq = lane >> 4; (void)wm; (void)wn; (void)fr; (void)fq; (void)lane; (void)w; (void)t
#define AROW(m, r) (wm * 64 + (m) * 16 + fq * 4 + (r))
#define ACOL(n) (wn * 64 + (n) * 16 + fr)

template <class F>
__device__ __forceinline__ void epi_store_bf16(const f32x4 (&acc)[4][4], char* sm, u16* dst, size_t ldd, F f, const u16* mulp = nullptr, size_t ldm = 0) {
  WAVE_IDS;
  u16* cs = (u16*)sm;
#pragma unroll
  for (int m = 0; m < 4; ++m) {
#pragma unroll
    for (int n = 0; n < 4; ++n)
#pragma unroll
      for (int r = 0; r < 4; ++r) cs[AROW(m, r) * 136 + ACOL(n)] = f2bf(f(AROW(m, r), ACOL(n), acc[m][n][r]));
    __builtin_amdgcn_sched_barrier(0);
  }
  __syncthreads();
#pragma unroll
  for (int i = 0; i < 8; ++i) {
    int row = (t >> 4) + 16 * i, ch = t & 15;
    uint4 v = *(const uint4*)(cs + row * 136 + ch * 8);
    if (mulp) {
      uint4 z = *(const uint4*)(mulp + (size_t)row * ldm + ch * 8);
      v.x = pk_bf16(bflo(v.x) * bflo(z.x), bfhi(v.x) * bfhi(z.x));
      v.y = pk_bf16(bflo(v.y) * bflo(z.y), bfhi(v.y) * bfhi(z.y));
      v.z = pk_bf16(bflo(v.z) * bflo(z.z), bfhi(v.z) * bfhi(z.z));
      v.w = pk_bf16(bflo(v.w) * bflo(z.w), bfhi(v.w) * bfhi(z.w));
    }
    *(uint4*)(dst + (size_t)row * ldd + ch * 8) = v;
  }
  __syncthreads();
}

template <class F>
__device__ __forceinline__ void epi_store_bf16_T(const f32x4 (&acc)[4][4], u16* dstT, size_t ldt, F f) {
  WAVE_IDS;
#pragma unroll
  for (int m = 0; m < 4; ++m)
#pragma unroll
    for (int n = 0; n < 4; ++n) {
      float v0 = f(AROW(m, 0), ACOL(n), acc[m][n][0]), v1 = f(AROW(m, 1), ACOL(n), acc[m][n][1]);
      float v2 = f(AROW(m, 2), ACOL(n), acc[m][n][2]), v3 = f(AROW(m, 3), ACOL(n), acc[m][n][3]);
      uint2 pk; pk.x = pk_bf16(v0, v1); pk.y = pk_bf16(v2, v3);
      *(uint2*)(dstT + (size_t)ACOL(n) * ldt + AROW(m, 0)) = pk;
    }
}

template <class F>
__device__ __forceinline__ void epi_store_bf16_img(const f32x4 (&acc)[4][4], char* sm, u16* img, int row0, int col0, F f, const u16* mulp = nullptr, size_t ldm = 0) {
  WAVE_IDS;
  u16* cs = (u16*)sm;
#pragma unroll
  for (int m = 0; m < 4; ++m) {
#pragma unroll
    for (int n = 0; n < 4; ++n)
#pragma unroll
      for (int r = 0; r < 4; ++r) cs[AROW(m, r) * 136 + ACOL(n)] = f2bf(f(AROW(m, r), ACOL(n), acc[m][n][r]));
    __builtin_amdgcn_sched_barrier(0);
  }
  __syncthreads();
#pragma unroll
  for (int i = 0; i < 8; ++i) {
    int ch = (t & 3) + 4 * ((t >> 6) & 3), row = ((t >> 2) & 15) + 16 * i;
    uint4 v = *(const uint4*)(cs + row * 136 + ch * 8);
    if (mulp) {
      uint4 z = *(const uint4*)(mulp + (size_t)row * ldm + ch * 8);
      v.x = pk_bf16(bflo(v.x) * bflo(z.x), bfhi(v.x) * bfhi(z.x));
      v.y = pk_bf16(bflo(v.y) * bflo(z.y), bfhi(v.y) * bfhi(z.y));
      v.z = pk_bf16(bflo(v.z) * bflo(z.z), bfhi(v.z) * bfhi(z.z));
      v.w = pk_bf16(bflo(v.w) * bflo(z.w), bfhi(v.w) * bfhi(z.w));
    }
    const int col = col0 + ch * 8;
    *(uint4*)(img + (size_t)(col >> 5) * 262144 + (size_t)(row0 + row) * 32 + (col & 31)) = v;
  }
  __syncthreads();
}

struct IdF { __device__ __forceinline__ float operator()(int, int, float v) const { return v; } };
struct SiluF { __device__ __forceinline__ float operator()(int, int, float v) const { return silu(v); } };
struct ScaleF { float s; __device__ __forceinline__ float operator()(int, int, float v) const { return v * s; } };

__device__ __forceinline__ void transpose_tile(const float* __restrict__ src, size_t ldn, u16* __restrict__ dst, size_t ldk, int k0, int n0, char* smc, size_t bstep) {
  float* sm = (float*)smc;
  const int t = tid_now(), l = t & 63, w = t >> 6;
  float4 v[16];
#pragma unroll
  for (int i = 0; i < 16; ++i) v[i] = *(const float4*)(src + (size_t)(k0 + w + 4 * i) * ldn + n0 + l * 4);
#pragma unroll
  for (int i = 0; i < 16; ++i) {
    float* d = sm + (w + 4 * i) * 257 + l * 4;
    d[0] = v[i].x; d[1] = v[i].y; d[2] = v[i].z; d[3] = v[i].w;
  }
  __syncthreads();
  const int kq = t & 7;
#pragma unroll
  for (int j = 0; j < 8; ++j) {
    int n = (t >> 3) + 32 * j;
    const float* r = sm + (kq * 8) * 257 + n;
    uint4 o;
    o.x = pk_bf16(r[0], r[257]); o.y = pk_bf16(r[2 * 257], r[3 * 257]); o.z = pk_bf16(r[4 * 257], r[5 * 257]); o.w = pk_bf16(r[6 * 257], r[7 * 257]);
    const int kk = k0 + kq * 8;
    if (bstep) *(uint4*)(dst + (size_t)(kk >> 5) * bstep + (size_t)(n0 + n) * 32 + (kk & 31)) = o;
    else *(uint4*)(dst + (size_t)(n0 + n) * ldk + kk) = o;
  }
  __syncthreads();
}

__device__ __forceinline__ void phase_prep(const Params& p, char* sm) {
  const int t = tid_now();
  unsigned char* ws = p.ws;
  float* mod = (float*)(ws + WS_MOD);
  const int N_ADA = 384, N_TR = 1200, N_CK = 256;
  for (int idx = blockIdx.x; idx < N_ADA + N_TR + N_CK + 1; idx += gridDim.x) {
    if (idx < N_ADA) {
      int i = idx / 96, nb = idx % 96, n0 = nb * 32;
      float* sv = (float*)sm;
      float* red = (float*)(sm + 12288);
      for (int e = t; e < 3072; e += NTHREADS) {
        int k = e / 3, cd = e % 3;
        float cv = (cd == 0) ? p.in[7][k] : p.in[6][(cd - 1) * 1024 + k];
        sv[e] = silu(cv);
      }
      __syncthreads();
      const int kg = t >> 3, c4 = (t & 7) * 4;
      float a0[4] = {0, 0, 0, 0}, a1[4] = {0, 0, 0, 0}, a2[4] = {0, 0, 0, 0};
      const float* wp = p.in[9] + ((size_t)i * 1024 + kg * 32) * 3072 + n0 + c4;
#pragma unroll 16
      for (int kk = 0; kk < 32; ++kk) {
        float4 wv = *(const float4*)(wp + (size_t)kk * 3072);
        const float* svp = sv + (kg * 32 + kk) * 3;
        float s0 = svp[0], s1 = svp[1], s2 = svp[2];
        a0[0] += s0 * wv.x; a0[1] += s0 * wv.y; a0[2] += s0 * wv.z; a0[3] += s0 * wv.w;
        a1[0] += s1 * wv.x; a1[1] += s1 * wv.y; a1[2] += s1 * wv.z; a1[3] += s1 * wv.w;
        a2[0] += s2 * wv.x; a2[1] += s2 * wv.y; a2[2] += s2 * wv.z; a2[3] += s2 * wv.w;
      }
#pragma unroll
      for (int e = 0; e < 4; ++e) { red[(kg * 3 + 0) * 32 + c4 + e] = a0[e]; red[(kg * 3 + 1) * 32 + c4 + e] = a1[e]; red[(kg * 3 + 2) * 32 + c4 + e] = a2[e]; }
      __syncthreads();
      if (t < 96) {
        int cd = t >> 5, col = t & 31;
        float sacc = p.in[10][(size_t)i * 3072 + n0 + col];
        for (int g = 0; g < 32; ++g) sacc += red[(g * 3 + cd) * 32 + col];
        mod[((size_t)i * 3 + cd) * 3072 + n0 + col] = sacc;
      }
      __syncthreads();
    } else if (idx < N_ADA + N_TR) {
      int q = idx - N_ADA;
      const float* src; u16* dst; size_t ldn, ldk; int tk, tn;
      bool q_is_cache = false;
      if (q < 320) { int j = q / 160, r = q % 160; src = p.in[11] + (size_t)j * 1024 * 2560; dst = (u16*)(ws + WS_WAI) + (size_t)j * 2560 * 1024; ldn = 2560; ldk = 1024; tk = r / 10; tn = r % 10; }
      else if (q < 448) { q -= 320; int j = q / 64, r = q % 64; src = p.in[12] + (size_t)j * 1024 * 1024; dst = (u16*)(ws + WS_WAO) + (size_t)j * 1024 * 1024; ldn = 1024; ldk = 1024; tk = r / 4; tn = r % 4; }
      else if (q < 576) { q -= 448; src = p.in[14]; dst = (u16*)(ws + WS_WPI); ldn = 2048; ldk = 1024; tk = q / 8; tn = q % 8; }
      else if (q < 592) { q -= 576; int g = q / 4, r = q % 4; src = p.in[15] + (size_t)g * 65536; dst = (u16*)(ws + WS_WPG) + (size_t)g * 65536; ldn = 256; ldk = 256; tk = r; tn = 0; }
      else if (q < 656) { q -= 592; src = p.in[17]; dst = (u16*)(ws + WS_WPO); ldn = 1024; ldk = 1024; tk = q / 4; tn = q % 4; }
      else if (q < 1040) { q -= 656; src = p.in[18]; dst = (u16*)(ws + WS_WRI); ldn = 6144; ldk = 1024; tk = q / 24; tn = q % 24; }
      else if (q < 1168) { q -= 1040; src = p.in[22]; dst = (u16*)(ws + WS_WRO); ldn = 1024; ldk = 2048; tk = q / 4; tn = q % 4; }
      else { q_is_cache = true; q -= 1168; int bj = q / 8, r = q % 8; src = p.in[3] + (size_t)bj * 512 * 256; dst = (u16*)(ws + WS_CVT) + (size_t)bj * 256 * 512; ldn = 256; ldk = 512; tk = r; tn = 0; }
      transpose_tile(src, ldn, dst, ldk, tk * 64, tn * 256, sm, q_is_cache ? 0 : ldn * 32);
    } else if (idx < N_ADA + N_TR + N_CK) {
      int q = idx - N_ADA - N_TR;
      size_t off = (size_t)q * 2048 + t * 8;
      float4 v0 = *(const float4*)(p.in[2] + off), v1 = *(const float4*)(p.in[2] + off + 4);
      *(uint4*)((u16*)(ws + WS_CK) + off) = make_uint4(pk_bf16(v0.x, v0.y), pk_bf16(v0.z, v0.w), pk_bf16(v1.x, v1.y), pk_bf16(v1.z, v1.w));
    } else {
      if (t < 16) {
        double r = 0.5623413251903491, th = 1.0;
        for (int i = 0; i < t; ++i) th *= r;
        double x2 = th * th, cs = 1.0, sn = th, tc = 1.0, ts = th;
        for (int i = 1; i < 14; ++i) { tc *= -x2 / ((2.0 * i - 1.0) * (2.0 * i)); ts *= -x2 / ((2.0 * i) * (2.0 * i + 1.0)); cs += tc; sn += ts; }
        double c = 1.0, s = 0.0;
        float* tab = (float*)(ws + WS_ROPE);
        for (int pos = 0; pos < 64; ++pos) {
          tab[(pos * 16 + t) * 2] = (float)c; tab[(pos * 16 + t) * 2 + 1] = (float)s;
          double c2 = c * cs - s * sn, s2 = s * cs + c * sn; c = c2; s = s2;
        }
      }
    }
  }
}

__device__ __forceinline__ void phase_norm(const Params& p, int layer, const float* xp, const float* xs) {
  const int t = tid_now(), lane = t & 63, w = t >> 6;
  u16* H = (u16*)(p.ws + WS_RF);
  const float* g = p.in[8] + (size_t)layer * 1024;
  for (int base = (blockIdx.x * 4 + w) * 4; base < 8192; base += gridDim.x * 16) {
    const float* x = base < 4096 ? xp + (size_t)base * 1024 : xs + (size_t)(base - 4096) * 1024;
    int cnd = base < 4096 ? 0 : 1 + ((base - 4096) >> 11);
    const float* md = (const float*)(p.ws + WS_MOD) + ((size_t)layer * 3 + cnd) * 3072;
    float4 v[4][4];
#pragma unroll
    for (int j = 0; j < 4; ++j)
#pragma unroll
      for (int i = 0; i < 4; ++i) v[j][i] = *(const float4*)(x + (size_t)j * 1024 + (i * 64 + lane) * 4);
    float rstd[4];
#pragma unroll
    for (int j = 0; j < 4; ++j) {
      float ss = 0.f;
#pragma unroll
      for (int i = 0; i < 4; ++i) ss += v[j][i].x * v[j][i].x + v[j][i].y * v[j][i].y + v[j][i].z * v[j][i].z + v[j][i].w * v[j][i].w;
#pragma unroll
      for (int o = 32; o > 0; o >>= 1) ss += __shfl_xor(ss, o);
      rstd[j] = rsqrtf(ss * (1.f / 1024.f) + 1e-6f);
    }
#pragma unroll
    for (int i = 0; i < 4; ++i) {
      int c = (i * 64 + lane) * 4;
      float4 gv = *(const float4*)(g + c), sh = *(const float4*)(md + c), sc = *(const float4*)(md + 1024 + c);
      float m0 = gv.x * (1.f + sc.x), m1 = gv.y * (1.f + sc.y), m2 = gv.z * (1.f + sc.z), m3 = gv.w * (1.f + sc.w);
#pragma unroll
      for (int j = 0; j < 4; ++j) {
        float h0 = v[j][i].x * rstd[j] * m0 + sh.x, h1 = v[j][i].y * rstd[j] * m1 + sh.y;
        float h2 = v[j][i].z * rstd[j] * m2 + sh.z, h3 = v[j][i].w * rstd[j] * m3 + sh.w;
        uint2 pk; pk.x = pk_bf16(h0, h1); pk.y = pk_bf16(h2, h3);
        *(uint2*)(H + (size_t)(c >> 5) * 262144 + (size_t)(base + j) * 32 + (c & 31)) = pk;
      }
    }
  }
}

__device__ __forceinline__ void phase_final_norm(const Params& p) {
  const int t = tid_now(), lane = t & 63, w = t >> 6;
  const float* g = p.in[23];
  for (int base = (blockIdx.x * 4 + w) * 4; base < 8192; base += gridDim.x * 16) {
    float* x = p.out + (size_t)base * 1024;
    float4 v[4][4];
#pragma unroll
    for (int j = 0; j < 4; ++j)
#pragma unroll
      for (int i = 0; i < 4; ++i) v[j][i] = *(const float4*)(x + (size_t)j * 1024 + (i * 64 + lane) * 4);
    float rstd[4];
#pragma unroll
    for (int j = 0; j < 4; ++j) {
      float ss = 0.f;
#pragma unroll
      for (int i = 0; i < 4; ++i) ss += v[j][i].x * v[j][i].x + v[j][i].y * v[j][i].y + v[j][i].z * v[j][i].z + v[j][i].w * v[j][i].w;
#pragma unroll
      for (int o = 32; o > 0; o >>= 1) ss += __shfl_xor(ss, o);
      rstd[j] = rsqrtf(ss * (1.f / 1024.f) + 1e-6f);
    }
#pragma unroll
    for (int i = 0; i < 4; ++i) {
      int c = (i * 64 + lane) * 4;
      float4 gv = *(const float4*)(g + c);
#pragma unroll
      for (int j = 0; j < 4; ++j) {
        float4 o; o.x = v[j][i].x * rstd[j] * gv.x; o.y = v[j][i].y * rstd[j] * gv.y; o.z = v[j][i].z * rstd[j] * gv.z; o.w = v[j][i].w * rstd[j] * gv.w;
        *(float4*)(x + (size_t)j * 1024 + c) = o;
      }
    }
  }
}

__device__ __forceinline__ void phase_outproj(const Params& p, int layer, const u16* Y, int K, const u16* Wt, const float* xp, const float* xs, char* sm) {
  WAVE_IDS;
  float* X = p.out;
  for (int idx = blockIdx.x; idx < 512; idx += gridDim.x) {
    int mt = idx & 63, nt = idx >> 6;
    f32x4 acc[4][4];
#pragma unroll
    for (int m = 0; m < 4; ++m)
#pragma unroll
      for (int n = 0; n < 4; ++n) acc[m][n] = (f32x4){0.f, 0.f, 0.f, 0.f};
    gemm_core_glds(Y + (size_t)mt * 128 * 32, 262144, Wt + (size_t)nt * 128 * 32, 1024 * 32, K, acc, sm);
    int row0 = mt * 128, col0 = nt * 128;
    int cnd = row0 < 4096 ? 0 : 1 + ((row0 - 4096) >> 11);
    const float* gate = (const float*)(p.ws + WS_MOD) + ((size_t)layer * 3 + cnd) * 3072 + 2048;
    const float* xres = row0 < 4096 ? xp + (size_t)row0 * 1024 : xs + (size_t)(row0 - 4096) * 1024;
    const int c4 = (t & 31) * 4, rb = t >> 5;
    const float4 g4 = *(const float4*)(gate + col0 + c4);
    float4 xv[16];
#pragma unroll
    for (int i = 0; i < 16; ++i) xv[i] = *(const float4*)(xres + (size_t)(rb + 8 * i) * 1024 + col0 + c4);
    float* cs = (float*)sm;
#pragma unroll
    for (int m = 0; m < 4; ++m) {
#pragma unroll
      for (int n = 0; n < 4; ++n)
#pragma unroll
        for (int r = 0; r < 4; ++r) cs[AROW(m, r) * 132 + ACOL(n)] = acc[m][n][r];
      __builtin_amdgcn_sched_barrier(0);
    }
    __syncthreads();
#pragma unroll
    for (int i = 0; i < 16; ++i) {
      const float4 a = *(const float4*)(cs + (rb + 8 * i) * 132 + c4);
      float4 o; o.x = xv[i].x + g4.x * a.x; o.y = xv[i].y + g4.y * a.y; o.z = xv[i].z + g4.z * a.z; o.w = xv[i].w + g4.w * a.w;
      *(float4*)(X + (size_t)(row0 + rb + 8 * i) * 1024 + col0 + c4) = o;
    }
    __syncthreads();
  }
}

__device__ __forceinline__ void attn_inproj_epi(const Params& p, int j, int mt, int nt, f32x4 (&acc)[4][4], char* sm) {
  WAVE_IDS;
  u16* Q = (u16*)(p.ws + WS_RA);
  u16* Kb = (u16*)(p.ws + WS_RB);
  u16* VTp = (u16*)(p.ws + WS_RD);
  u16* VTs = VTp + (size_t)16 * 256 * 256;
  u16* SZ = (u16*)(p.ws + WS_RE);
  const float* rope = (const float*)(p.ws + WS_ROPE);
  const int row0 = mt * 128;
  const bool sample = row0 >= 4096;
  if (nt < 10 && sample) {
#pragma unroll
    for (int m = 0; m < 4; ++m) {
      __builtin_amdgcn_sched_barrier(0);
#pragma unroll
      for (int r = 0; r < 4; ++r) {
        int tk = (row0 + AROW(m, r) - 4096) & 2047;
        int rp = tk >> 6, cp = tk & 63;
        float2 a = *(const float2*)(rope + (rp * 16 + fr) * 2), b = *(const float2*)(rope + (cp * 16 + fr) * 2);
        float x1r = acc[m][0][r], x2r = acc[m][1][r], x1c = acc[m][2][r], x2c = acc[m][3][r];
        acc[m][0][r] = x1r * a.x - x2r * a.y; acc[m][1][r] = x2r * a.x + x1r * a.y;
        acc[m][2][r] = x1c * b.x - x2c * b.y; acc[m][3][r] = x2c * b.x + x1c * b.y;
      }
    }
  }
  if (nt < 8) {
    epi_store_bf16(acc, sm, Q + (size_t)row0 * 1024 + nt * 128, 1024, IdF());
  } else if (nt < 10) {
    int c0 = (nt - 8) * 128;
    if (!sample) {
      int b = row0 >> 8, t0 = row0 & 255;
      float* dk = p.out + O_NK + ((size_t)(b * 2 + j) * 256 + t0) * 256 + c0;
#pragma unroll
      for (int m = 0; m < 4; ++m) {
        float* pm = opaque(dk + (size_t)AROW(m, 0) * 256 + ACOL(0));
#pragma unroll
        for (int n = 0; n < 4; ++n)
#pragma unroll
          for (int r = 0; r < 4; ++r) pm[r * 256 + n * 16] = acc[m][n][r];
        __builtin_amdgcn_sched_barrier(0);
      }
    }
    epi_store_bf16(acc, sm, Kb + (size_t)row0 * 256 + c0, 256, IdF());
  } else if (nt < 12) {
    int c0 = (nt - 10) * 128;
    if (!sample) {
      int b = row0 >> 8, t0 = row0 & 255;
      float* dv = p.out + O_NV + ((size_t)(b * 2 + j) * 256 + t0) * 256 + c0;
#pragma unroll
      for (int m = 0; m < 4; ++m) {
        float* pm = opaque(dv + (size_t)AROW(m, 0) * 256 + ACOL(0));
#pragma unroll
        for (int n = 0; n < 4; ++n)
#pragma unroll
          for (int r = 0; r < 4; ++r) pm[r * 256 + n * 16] = acc[m][n][r];
        __builtin_amdgcn_sched_barrier(0);
      }
      epi_store_bf16_T(acc, VTp + ((size_t)b * 256 + c0) * 256 + t0, 256, IdF());
    } else {
      int s = (row0 - 4096) >> 11, t0 = (row0 - 4096) & 2047;
      epi_store_bf16_T(acc, VTs + ((size_t)s * 256 + c0) * 2048 + t0, 2048, IdF());
    }
  } else {
    epi_store_bf16(acc, sm, SZ + (size_t)row0 * 1024 + (nt - 12) * 128, 1024, SiluF());
  }
}

__device__ __forceinline__ void phase_attn_inproj(const Params& p, int j, char* sm) {
  const u16* H = (const u16*)(p.ws + WS_RF);
  const u16* W = (const u16*)(p.ws + WS_WAI) + (size_t)j * 2560 * 1024;
  for (int idx = blockIdx.x; idx < 768; idx += gridDim.x) {
    if (idx < 512) {
      const int mt = idx & 63, nt2 = idx >> 6;
      f32x4 accL[4][4], accR[4][4];
#pragma unroll
      for (int m = 0; m < 4; ++m)
#pragma unroll
        for (int n = 0; n < 4; ++n) { accL[m][n] = (f32x4){0.f, 0.f, 0.f, 0.f}; accR[m][n] = (f32x4){0.f, 0.f, 0.f, 0.f}; }
      gemm_core_glds2(H + (size_t)mt * 128 * 32, 262144, W + (size_t)nt2 * 256 * 32, 2560 * 32, 1024, accL, accR, sm);
      attn_inproj_epi(p, j, mt, nt2 * 2, accL, sm);
      attn_inproj_epi(p, j, mt, nt2 * 2 + 1, accR, sm);
    } else {
      const int j2 = idx - 512, mt = j2 & 63, nt = 16 + (j2 >> 6);
      f32x4 acc[4][4];
#pragma unroll
      for (int m = 0; m < 4; ++m)
#pragma unroll
        for (int n = 0; n < 4; ++n) acc[m][n] = (f32x4){0.f, 0.f, 0.f, 0.f};
      gemm_core_glds(H + (size_t)mt * 128 * 32, 262144, W + (size_t)nt * 128 * 32, 2560 * 32, 1024, acc, sm);
      attn_inproj_epi(p, j, mt, nt, acc, sm);
    }
  }
}

__device__ __forceinline__ void attn_comp64_lds(const char* sk, const char* sv, const bf16x8 (&qf)[2][2], f32x4 (&oacc)[4][2],
                                                float (&mrun)[2], float (&lrun)[2], bool masked, int key0, int qbase, float sc2, int fr, int fq) {
  f32x4 s[4][2];
#pragma unroll
  for (int m = 0; m < 4; ++m) {
    const int krow = 32 * (m >> 1) + 8 * (fr >> 2) + 4 * (m & 1) + (fr & 3);
    bf16x8 k0 = *(const bf16x8*)(sk + lds_off(krow, fq * 8));
    bf16x8 k1 = *(const bf16x8*)(sk + lds_off(krow, 32 + fq * 8));
#pragma unroll
    for (int n = 0; n < 2; ++n) {
      s[m][n] = mfma16(k0, qf[n][0], (f32x4){0.f, 0.f, 0.f, 0.f});
      s[m][n] = mfma16(k1, qf[n][1], s[m][n]);
    }
  }
  if (masked) {
#pragma unroll
    for (int n = 0; n < 2; ++n)
#pragma unroll
      for (int m = 0; m < 4; ++m)
#pragma unroll
        for (int r = 0; r < 4; ++r) {
          int kpos = key0 + 32 * (m >> 1) + 8 * fq + 4 * (m & 1) + r, qpos = qbase + 16 * n + fr;
          int dd = qpos - kpos; dd = dd < 0 ? -dd : dd;
          s[m][n][r] = dd <= 128 ? s[m][n][r] : -1.0e30f;
        }
  }
#pragma unroll
  for (int n = 0; n < 2; ++n) {
    float mx = -3.0e38f;
#pragma unroll
    for (int m = 0; m < 4; ++m)
#pragma unroll
      for (int r = 0; r < 4; ++r) { float v = s[m][n][r] * sc2; s[m][n][r] = v; mx = fmaxf(mx, v); }
    mx = fmaxf(mx, __shfl_xor(mx, 16));
    mx = fmaxf(mx, __shfl_xor(mx, 32));
    float mnew = fmaxf(mrun[n], mx);
    float alpha = fexp2(mrun[n] - mnew);
    mrun[n] = mnew;
    float ls = 0.f;
#pragma unroll
    for (int m = 0; m < 4; ++m)
#pragma unroll
      for (int r = 0; r < 4; ++r) { float pv = fexp2(s[m][n][r] - mnew); s[m][n][r] = pv; ls += pv; }
    lrun[n] = lrun[n] * alpha + ls;
#pragma unroll
    for (int dt = 0; dt < 4; ++dt) oacc[dt][n] *= alpha;
  }
#pragma unroll
  for (int s2 = 0; s2 < 2; ++s2) {
    bf16x8 vf[4];
#pragma unroll
    for (int dt = 0; dt < 4; ++dt) vf[dt] = *(const bf16x8*)(sv + lds_off(dt * 16 + fr, s2 * 32 + fq * 8));
#pragma unroll
    for (int n = 0; n < 2; ++n) {
      union { bf16x8 v; unsigned u[4]; } pf;
      pf.u[0] = pk_bf16(s[2 * s2][n][0], s[2 * s2][n][1]); pf.u[1] = pk_bf16(s[2 * s2][n][2], s[2 * s2][n][3]);
      pf.u[2] = pk_bf16(s[2 * s2 + 1][n][0], s[2 * s2 + 1][n][1]); pf.u[3] = pk_bf16(s[2 * s2 + 1][n][2], s[2 * s2 + 1][n][3]);
#pragma unroll
      for (int dt = 0; dt < 4; ++dt) oacc[dt][n] = mfma16(vf[dt], pf.v, oacc[dt][n]);
    }
  }
}

__device__ __forceinline__ void phase_attn(const Params& p, int j, char* sm) {
  const int t = tid_now(), lane = t & 63, w = t >> 6, fr = lane & 15, fq = lane >> 4;
  const u16* Q = (const u16*)(p.ws + WS_RA);
  const u16* Kb = (const u16*)(p.ws + WS_RB);
  const u16* VTp = (const u16*)(p.ws + WS_RD);
  const u16* VTs = VTp + (size_t)16 * 256 * 256;
  const u16* SZ = (const u16*)(p.ws + WS_RE);
  const u16* cK = (const u16*)(p.ws + WS_CK);
  const u16* cVT = (const u16*)(p.ws + WS_CVT);
  u16* Y = (u16*)(p.ws + WS_RC);
  const float sc2 = 0.125f * LOG2E;
  const int lrow = t >> 3, lcol = (t & 7) * 8;
  for (int idx = blockIdx.x; idx < 1024; idx += gridDim.x) {
    const bool sample = idx < 512;
    int hq, qb, rowbase, sb;
    if (sample) { sb = idx >> 8; hq = (idx >> 4) & 15; qb = idx & 15; rowbase = 4096 + sb * 2048; }
    else { int ii = idx - 512; sb = ii >> 5; hq = (ii >> 1) & 15; qb = ii & 1; rowbase = sb * 256; }
    const int kvh = hq >> 2;
    const int Q0 = qb * 128, q0 = Q0 + w * 32;
    bf16x8 qf[2][2];
#pragma unroll
    for (int n = 0; n < 2; ++n)
#pragma unroll
      for (int ks = 0; ks < 2; ++ks) qf[n][ks] = *(const bf16x8*)(Q + (size_t)(rowbase + q0 + 16 * n + fr) * 1024 + hq * 64 + ks * 32 + fq * 8);
    f32x4 oacc[4][2];
#pragma unroll
    for (int dt = 0; dt < 4; ++dt)
#pragma unroll
      for (int n = 0; n < 2; ++n) oacc[dt][n] = (f32x4){0.f, 0.f, 0.f, 0.f};
    const float sink2 = p.in[13][j * 16 + hq] * LOG2E;
    float mrun[2] = {sink2, sink2}, lrun[2] = {0.f, 0.f};
    const u16 *K1, *V1, *K2, *V2;
    size_t ldv1, ldv2 = 2048;
    int n1, n2 = 0, lo = 0;
    if (sample) {
      K1 = cK + ((size_t)(sb * 2 + j) * 512) * 256 + kvh * 64;
      V1 = cVT + ((size_t)(sb * 2 + j) * 256 + kvh * 64) * 512; ldv1 = 512; n1 = 8;
      K2 = Kb + (size_t)rowbase * 256 + kvh * 64;
      V2 = VTs + ((size_t)sb * 256 + kvh * 64) * 2048;
      lo = Q0 - 128; lo = lo < 0 ? 0 : lo;
      int hi = Q0 + 256; hi = hi > 2048 ? 2048 : hi;
      n2 = (hi - lo) >> 6;
    } else {
      K1 = Kb + (size_t)rowbase * 256 + kvh * 64;
      V1 = VTp + ((size_t)sb * 256 + kvh * 64) * 256; ldv1 = 256; n1 = 4;
      K2 = K1; V2 = V1;
    }
    const int total = n1 + n2;
    u32x4 rk[2], rv[2];
#define AT_GLOAD(i) do { const u16* _kp; const u16* _vp; size_t _ldv; \
      if ((i) < n1) { _kp = K1 + (size_t)(i) * 64 * 256; _vp = V1 + (i) * 64; _ldv = ldv1; } \
      else { int _k0 = lo + ((i) - n1) * 64; _kp = K2 + (size_t)_k0 * 256; _vp = V2 + _k0; _ldv = ldv2; } \
      _Pragma("unroll") for (int _i = 0; _i < 2; ++_i) { \
        rk[_i] = *(const u32x4*)(_kp + (size_t)(lrow + 32 * _i) * 256 + lcol); \
        rv[_i] = *(const u32x4*)(_vp + (size_t)(lrow + 32 * _i) * _ldv + lcol); } } while (0)
#define AT_LSTORE(buf) do { _Pragma("unroll") for (int _i = 0; _i < 2; ++_i) { \
        *(u32x4*)(sm + (buf) * 16384 + lds_off(lrow + 32 * _i, lcol)) = rk[_i]; \
        *(u32x4*)(sm + (buf) * 16384 + 8192 + lds_off(lrow + 32 * _i, lcol)) = rv[_i]; } } while (0)
    AT_GLOAD(0);
    AT_LSTORE(0);
    __syncthreads();
    for (int i = 0; i < total; ++i) {
      const int cur = i & 1;
      if (i + 1 < total) AT_GLOAD(i + 1);
      const bool masked = i >= n1;
      const int key0 = lo + (i - n1) * 64;
      const bool skip = masked && (key0 + 63 < q0 - 128 || key0 > q0 + 31 + 128);
      if (!skip) attn_comp64_lds(sm + cur * 16384, sm + cur * 16384 + 8192, qf, oacc, mrun, lrun, masked, key0, q0, sc2, fr, fq);
      if (i + 1 < total) AT_LSTORE(cur ^ 1);
      __syncthreads();
    }
#undef AT_GLOAD
#undef AT_LSTORE
#pragma unroll
    for (int n = 0; n < 2; ++n) {
      float lt = lrun[n];
      lt += __shfl_xor(lt, 16);
      lt += __shfl_xor(lt, 32);
      float inv = 1.f / (lt + fexp2(sink2 - mrun[n]));
      size_t row = (size_t)(rowbase + q0 + 16 * n + fr);
#pragma unroll
      for (int dt = 0; dt < 4; ++dt) {
        int d0 = hq * 64 + dt * 16 + 4 * fq;
        uint2 zz = *(const uint2*)(SZ + row * 1024 + d0);
        uint2 o;
        o.x = pk_bf16(oacc[dt][n][0] * inv * bflo(zz.x), oacc[dt][n][1] * inv * bfhi(zz.x));
        o.y = pk_bf16(oacc[dt][n][2] * inv * bflo(zz.y), oacc[dt][n][3] * inv * bfhi(zz.y));
        *(uint2*)(Y + (size_t)(d0 >> 5) * 262144 + row * 32 + (d0 & 31)) = o;
      }
    }
  }
}

__device__ __forceinline__ void phase_pool_inproj(const Params& p, char* sm) {
  const u16* H = (const u16*)(p.ws + WS_RF);
  const u16* W = (const u16*)(p.ws + WS_WPI);
  u16* U = (u16*)(p.ws + WS_RD);
  u16* SZ = (u16*)(p.ws + WS_RE);
  for (int idx = blockIdx.x; idx < 64 * 8; idx += gridDim.x) {
    int mt = idx & 63, nt2 = idx >> 6;
    f32x4 accL[4][4], accR[4][4];
#pragma unroll
    for (int m = 0; m < 4; ++m)
#pragma unroll
      for (int n = 0; n < 4; ++n) { accL[m][n] = (f32x4){0.f, 0.f, 0.f, 0.f}; accR[m][n] = (f32x4){0.f, 0.f, 0.f, 0.f}; }
    gemm_core_glds2(H + (size_t)mt * 128 * 32, 262144, W + (size_t)nt2 * 256 * 32, 2048 * 32, 1024, accL, accR, sm);
    if (nt2 < 4) {
      epi_store_bf16(accL, sm, U + (size_t)mt * 128 * 1024 + nt2 * 256, 1024, IdF());
      epi_store_bf16(accR, sm, U + (size_t)mt * 128 * 1024 + nt2 * 256 + 128, 1024, IdF());
    } else {
      epi_store_bf16(accL, sm, SZ + (size_t)mt * 128 * 1024 + (nt2 - 4) * 256, 1024, SiluF());
      epi_store_bf16(accR, sm, SZ + (size_t)mt * 128 * 1024 + (nt2 - 4) * 256 + 128, 1024, SiluF());
    }
  }
}

struct PoolEpiF {
  const float* scale;
  __device__ __forceinline__ float operator()(int r, int c, float v) const { return v * scale[c]; }
};
template <int W>
__device__ __forceinline__ void pool_d_strip(const u16* __restrict__ uc, u16* __restrict__ dc, int t0, int L) {
  constexpr int LEFT = W / 2, RIGHT = W - 1 - LEFT;
  float pre[49];
  pre[0] = 0.f;
  float ctr[32];
#pragma unroll
  for (int k = 0; k < 48; ++k) {
    int pos = t0 - 8 + k;
    float v = 0.f;
    if (k >= 8 - LEFT && k < 40 + RIGHT) {
      int pc = pos < 0 ? 0 : (pos >= L ? L - 1 : pos);
      float lv = bf2f(uc[(ptrdiff_t)(pc - t0) * 1024]);
      v = (pos >= 0 && pos < L) ? lv : 0.f;
    }
    pre[k + 1] = pre[k] + v;
    if (k >= 8 && k < 40) ctr[k - 8] = v;
  }
#pragma unroll
  for (int i = 0; i < 32; ++i) {
    int pos = t0 + i;
    int lo = pos - LEFT; lo = lo < 0 ? 0 : lo;
    int hi = pos + RIGHT + 1; hi = hi > L ? L : hi;
    float sum = pre[i + 8 + RIGHT + 1] - pre[i + 8 - LEFT];
    dc[(size_t)i * 32] = f2bf(sum / (float)(hi - lo) - ctr[i]);
  }
}
__device__ __forceinline__ void phase_pool_d(const Params& p) {
  const int t = tid_now();
  const u16* U = (const u16*)(p.ws + WS_RD);
  u16* Dm = (u16*)(p.ws + WS_RD + 16 * MiB);
  for (int idx = blockIdx.x; idx < 1024; idx += gridDim.x) {
    const int g = idx & 3, strip = idx >> 2;
    const int row0 = strip * 32;
    int L, t0;
    if (row0 < 4096) { L = 256; t0 = row0 & 255; } else { L = 2048; t0 = (row0 - 4096) & 2047; }
    const u16* uc = U + (size_t)row0 * 1024 + g * 256 + t;
    const int dcol = g * 256 + t;
    u16* dc = Dm + (size_t)(dcol >> 5) * 262144 + (size_t)row0 * 32 + (dcol & 31);
    if (g == 0) pool_d_strip<2>(uc, dc, t0, L);
    else if (g == 1) pool_d_strip<4>(uc, dc, t0, L);
    else if (g == 2) pool_d_strip<8>(uc, dc, t0, L);
    else pool_d_strip<16>(uc, dc, t0, L);
  }
}
__device__ __forceinline__ void phase_pool_gemm(const Params& p, char* sm) {
  const u16* Dm = (const u16*)(p.ws + WS_RD + 16 * MiB);
  const u16* SZ = (const u16*)(p.ws + WS_RE);
  u16* Y = (u16*)(p.ws + WS_RC);
  const u16* Wg = (const u16*)(p.ws + WS_WPG);
  for (int idx = blockIdx.x; idx < 512; idx += gridDim.x) {
    const int mt = idx & 63, gn = idx >> 6, g = gn >> 1, n2 = gn & 1;
    const int row0 = mt * 128;
    f32x4 acc[4][4];
#pragma unroll
    for (int m = 0; m < 4; ++m)
#pragma unroll
      for (int n = 0; n < 4; ++n) acc[m][n] = (f32x4){0.f, 0.f, 0.f, 0.f};
    gemm_core_glds(Dm + (size_t)(g * 8) * 262144 + (size_t)row0 * 32, 262144, Wg + (size_t)g * 65536 + (size_t)n2 * 128 * 32, 256 * 32, 256, acc, sm);
    int c0 = g * 256 + n2 * 128;
    PoolEpiF f{p.in[16] + c0};
    epi_store_bf16_img(acc, sm, Y, row0, c0, f, SZ + (size_t)row0 * 1024 + c0, 1024);
  }
}

__device__ __forceinline__ void phase_ret_inproj(const Params& p, char* sm) {
  const u16* H = (const u16*)(p.ws + WS_RF);
  const u16* W = (const u16*)(p.ws + WS_WRI);
  u16* Q = (u16*)(p.ws + WS_RA);
  u16* Kb = (u16*)(p.ws + WS_RB);
  u16* KTp = (u16*)(p.ws + WS_RC);
  u16* KTs = KTp + (size_t)16 * 1024 * 256;
  u16* VTp = (u16*)(p.ws + WS_RD);
  u16* VTs = VTp + (size_t)16 * 2048 * 256;
  u16* SZ = (u16*)(p.ws + WS_RE);
  for (int idx = blockIdx.x; idx < 64 * 24; idx += gridDim.x) {
    int mt = idx & 63, nt2 = idx >> 6;
    f32x4 accL[4][4], accR[4][4];
#pragma unroll
    for (int m = 0; m < 4; ++m)
#pragma unroll
      for (int n = 0; n < 4; ++n) { accL[m][n] = (f32x4){0.f, 0.f, 0.f, 0.f}; accR[m][n] = (f32x4){0.f, 0.f, 0.f, 0.f}; }
    gemm_core_glds2(H + (size_t)mt * 128 * 32, 262144, W + (size_t)nt2 * 256 * 32, 6144 * 32, 1024, accL, accR, sm);
    const int row0 = mt * 128;
    const bool sample = row0 >= 4096;
    int sb, t0;
    if (!sample) { sb = row0 >> 8; t0 = row0 & 255; } else { sb = (row0 - 4096) >> 11; t0 = (row0 - 4096) & 2047; }
#pragma unroll
    for (int half = 0; half < 2; ++half) {
    f32x4 (&acc)[4][4] = half ? accR : accL;
    const int nt = nt2 * 2 + half;
    if (nt < 8) {
      epi_store_bf16_img(acc, sm, Q, row0, nt * 128, IdF());
    } else if (nt < 16) {
      int c0 = (nt - 8) * 128;
      ScaleF f{0.0625f};
      if (!sample) epi_store_bf16_T(acc, KTp + ((size_t)sb * 1024 + c0) * 256 + t0, 256, f);
      else epi_store_bf16_T(acc, KTs + ((size_t)sb * 1024 + c0) * 2048 + t0, 2048, f);
      epi_store_bf16_img(acc, sm, Kb, row0, c0, f);
    } else if (nt < 32) {
      int c0 = (nt - 16) * 128;
      if (!sample) epi_store_bf16_T(acc, VTp + ((size_t)sb * 2048 + c0) * 256 + t0, 256, IdF());
      else epi_store_bf16_T(acc, VTs + ((size_t)sb * 2048 + c0) * 2048 + t0, 2048, IdF());
    } else {
      epi_store_bf16_img(acc, sm, SZ, row0, (nt - 32) * 128, SiluF());
    }
    }
  }
}

__device__ __forceinline__ void scan_sample64(const Params& p, int ii, char* sm) {
  const int t = tid_now(), lane = t & 63, w = t >> 6, wm = w >> 1, wn = w & 1, fr = lane & 15, fq = lane >> 4;
  const int xl = ii & 7, rest = ii >> 3;
  const int h = xl & 3, sb = xl >> 2, et8 = rest & 7, dt4 = (rest >> 3) & 3, dir = rest >> 5;
  const u16* KTs = (const u16*)(p.ws + WS_RC) + (size_t)16 * 1024 * 256;
  const u16* VTs = (const u16*)(p.ws + WS_RD) + (size_t)16 * 2048 * 256;
  u16* SNAP = (u16*)(p.ws + WS_RF);
  const float lg2 = logsig2((dir ? p.in[20] : p.in[19])[h]);
  const float cdec = fexp2(128.f * lg2);
  const int lrow = t >> 4, kc = t & 15;
  const u16* Ap = KTs + ((size_t)sb * 1024 + h * 256 + dt4 * 64 + lrow) * 2048 + kc * 8;
  const u16* Bp = VTs + ((size_t)sb * 2048 + h * 512 + et8 * 64 + lrow) * 2048 + kc * 8;
  const int ldst = (kc >> 3) * 8192 + lds_off(lrow, (kc & 7) * 8);
  float fs[8];
#pragma unroll
  for (int e = 0; e < 8; ++e) { int jj = kc * 8 + e; fs[e] = fexp2((float)(dir ? jj : 127 - jj) * lg2); }
  f32x4 acc[2][2];
  {
    const float* st = (dir ? p.in[5] : p.in[4]) + ((size_t)(sb * 4 + h) * 256 + dt4 * 64 + wm * 32) * 512 + et8 * 64 + wn * 32;
#pragma unroll
    for (int m = 0; m < 2; ++m)
#pragma unroll
      for (int n = 0; n < 2; ++n)
#pragma unroll
        for (int r = 0; r < 4; ++r) acc[m][n][r] = st[(size_t)(m * 16 + fq * 4 + r) * 512 + n * 16 + fr];
  }
  u32x4 raA[4], rbA[4], raB[4], rbB[4];
#define S6_GLOAD(cc, RA, RB) do { const size_t _o = (size_t)((dir ? 15 - (cc) : (cc)) * 128); _Pragma("unroll") for (int i = 0; i < 4; ++i) { \
    RA[i] = *(const u32x4*)(Ap + (size_t)(16 * i) * 2048 + _o); RB[i] = *(const u32x4*)(Bp + (size_t)(16 * i) * 2048 + _o); } } while (0)
#define S6_LSTORE(buf, RA, RB) do { _Pragma("unroll") for (int i = 0; i < 4; ++i) { u32x4 _v = RA[i], _o; \
    _o[0] = pk_bf16(bflo(_v[0]) * fs[0], bfhi(_v[0]) * fs[1]); _o[1] = pk_bf16(bflo(_v[1]) * fs[2], bfhi(_v[1]) * fs[3]); \
    _o[2] = pk_bf16(bflo(_v[2]) * fs[4], bfhi(_v[2]) * fs[5]); _o[3] = pk_bf16(bflo(_v[3]) * fs[6], bfhi(_v[3]) * fs[7]); \
    *(u32x4*)(sm + (buf) * 32768 + ldst + i * 2048) = _o; *(u32x4*)(sm + (buf) * 32768 + 16384 + ldst + i * 2048) = RB[i]; } } while (0)
#define S6_STEP(cc, RA, RB) do { \
    const int cur = (cc) & 1; \
    { const int c = dir ? 15 - (cc) : (cc); \
      u16* sp = SNAP + (size_t)(((sb * 16 + c) * 4 + h) * 2 + dir) * 131072 + (size_t)(dt4 * 2 + wm) * 16384 + (size_t)(et8 * 64 + wn * 32 + fr) * 32 + fq * 4; \
      _Pragma("unroll") for (int m = 0; m < 2; ++m) _Pragma("unroll") for (int n = 0; n < 2; ++n) { \
          uint2 pk; pk.x = pk_bf16(acc[m][n][0], acc[m][n][1]); pk.y = pk_bf16(acc[m][n][2], acc[m][n][3]); \
          *(uint2*)(sp + (size_t)(n * 16) * 32 + m * 16) = pk; acc[m][n] *= cdec; } } \
    const char* sa = sm + cur * 32768; const char* sb2 = sa + 16384; \
    _Pragma("unroll") for (int kh = 0; kh < 2; ++kh) _Pragma("unroll") for (int ks = 0; ks < 2; ++ks) { \
        bf16x8 a[2], b[2]; \
        _Pragma("unroll") for (int m = 0; m < 2; ++m) a[m] = *(const bf16x8*)(sa + kh * 8192 + lds_off(wm * 32 + m * 16 + fr, ks * 32 + fq * 8)); \
        _Pragma("unroll") for (int n = 0; n < 2; ++n) b[n] = *(const bf16x8*)(sb2 + kh * 8192 + lds_off(wn * 32 + n * 16 + fr, ks * 32 + fq * 8)); \
        _Pragma("unroll") for (int m = 0; m < 2; ++m) _Pragma("unroll") for (int n = 0; n < 2; ++n) acc[m][n] = mfma16(a[m], b[n], acc[m][n]); } \
    if ((cc) + 1 < 15) { S6_LSTORE(cur ^ 1, RA, RB); if ((cc) + 3 < 15) S6_GLOAD((cc) + 3, RA, RB); } \
    __syncthreads(); } while (0)
  S6_GLOAD(0, raA, rbA);
  S6_LSTORE(0, raA, rbA);
  __syncthreads();
  S6_GLOAD(1, raA, rbA);
  S6_GLOAD(2, raB, rbB);
  for (int cc = 0; cc < 15; cc += 2) {
    S6_STEP(cc, raA, rbA);
    if (cc + 1 < 15) S6_STEP(cc + 1, raB, rbB);
  }
#undef S6_STEP
#undef S6_GLOAD
#undef S6_LSTORE
  {
    const int c = dir ? 0 : 15;
    u16* sp = SNAP + (size_t)(((sb * 16 + c) * 4 + h) * 2 + dir) * 131072 + (size_t)(dt4 * 2 + wm) * 16384 + (size_t)(et8 * 64 + wn * 32 + fr) * 32 + fq * 4;
#pragma unroll
    for (int m = 0; m < 2; ++m)
#pragma unroll
      for (int n = 0; n < 2; ++n) {
        uint2 pk; pk.x = pk_bf16(acc[m][n][0], acc[m][n][1]); pk.y = pk_bf16(acc[m][n][2], acc[m][n][3]);
        *(uint2*)(sp + (size_t)(n * 16) * 32 + m * 16) = pk;
      }
  }
}

__device__ __forceinline__ void phase_ret_scan(const Params& p, char* sm) {
  WAVE_IDS;
  const u16* KTp = (const u16*)(p.ws + WS_RC);
  const u16* KTs = KTp + (size_t)16 * 1024 * 256;
  const u16* VTp = (const u16*)(p.ws + WS_RD);
  const u16* VTs = VTp + (size_t)16 * 2048 * 256;
  u16* SNAP = (u16*)(p.ws + WS_RF);
  const int lr = t >> 3, lc = (t & 7) * 8;
  for (int idx = blockIdx.x; idx < 512; idx += gridDim.x) scan_sample64(p, idx, sm);
  for (int idx = 512 + (blockIdx.x + gridDim.x - (512 % gridDim.x)) % gridDim.x; idx < 512 + 1024; idx += gridDim.x) {
    const bool sample = false;
    int ii = idx - 512;
    const int xl = ii & 7, rest = ii >> 3;
    const int h = xl & 3, et = rest & 3, dt = (rest >> 2) & 1, dir = (rest >> 3) & 1, sb = (rest >> 4) * 2 + (xl >> 2);
    const float lg2 = logsig2((dir ? p.in[20] : p.in[19])[h]);
    const float cdec = fexp2(128.f * lg2);
    const int nch = sample ? 16 : 2;
    const int nacc = sample ? 15 : 2;
    const size_t ld = sample ? 2048 : 256;
    const u16* Ab = sample ? KTs + ((size_t)sb * 1024 + h * 256 + dt * 128) * 2048 : KTp + ((size_t)sb * 1024 + h * 256 + dt * 128) * 256;
    const u16* Bb = sample ? VTs + ((size_t)sb * 2048 + h * 512 + et * 128) * 2048 : VTp + ((size_t)sb * 2048 + h * 512 + et * 128) * 256;
    const u16* Ap = Ab + (size_t)lr * ld + lc;
    const u16* Bp = Bb + (size_t)lr * ld + lc;
    f32x4 acc[4][4];
#pragma unroll
    for (int m = 0; m < 4; ++m)
#pragma unroll
      for (int n = 0; n < 4; ++n) acc[m][n] = (f32x4){0.f, 0.f, 0.f, 0.f};
    if (sample) {
      const float* st = (dir ? p.in[5] : p.in[4]) + ((size_t)(sb * 4 + h) * 256 + dt * 128) * 512 + et * 128;
#pragma unroll
      for (int m = 0; m < 4; ++m) {
#pragma unroll
        for (int hh = 0; hh < 2; ++hh) {
          const float* pm = opaque(st + (size_t)AROW(m, 2 * hh) * 512 + ACOL(0));
#pragma unroll
          for (int n = 0; n < 4; ++n)
#pragma unroll
            for (int r = 0; r < 2; ++r) acc[m][n][2 * hh + r] = pm[r * 512 + n * 16];
        }
        __builtin_amdgcn_sched_barrier(0);
      }
    }
    float fs0[8];
#pragma unroll
    for (int e = 0; e < 8; ++e) {
      int j0 = lc + e;
      fs0[e] = fexp2((float)(dir ? j0 : 127 - j0) * lg2);
    }
    const float c64 = fexp2((dir ? 64.f : -64.f) * lg2);
    u32x4 ra[4], rb[4];
    const int nq = nacc * 2;
#define SC_TOK(q) ((size_t)((dir ? nch - 1 - ((q) >> 1) : ((q) >> 1)) * 128 + ((q) & 1) * 64))
#define SC_GLOAD(q) do { const size_t _o = SC_TOK(q); _Pragma("unroll") for (int i = 0; i < 4; ++i) { ra[i] = *(const u32x4*)(Ap + (size_t)(32 * i) * ld + _o); rb[i] = *(const u32x4*)(Bp + (size_t)(32 * i) * ld + _o); } } while (0)
#define SC_LSTORE(buf, q) do { \
    const float _cm = ((q) & 1) ? c64 : 1.f; \
    const float g0 = fs0[0] * _cm, g1 = fs0[1] * _cm, g2 = fs0[2] * _cm, g3 = fs0[3] * _cm; \
    const float g4 = fs0[4] * _cm, g5 = fs0[5] * _cm, g6 = fs0[6] * _cm, g7 = fs0[7] * _cm; \
    _Pragma("unroll") for (int i = 0; i < 4; ++i) { \
      u32x4 _v = ra[i]; u32x4 _o; \
      _o[0] = pk_bf16(bflo(_v[0]) * g0, bfhi(_v[0]) * g1); _o[1] = pk_bf16(bflo(_v[1]) * g2, bfhi(_v[1]) * g3); \
      _o[2] = pk_bf16(bflo(_v[2]) * g4, bfhi(_v[2]) * g5); _o[3] = pk_bf16(bflo(_v[3]) * g6, bfhi(_v[3]) * g7); ra[i] = _o; } \
    _Pragma("unroll") for (int i = 0; i < 4; ++i) { *(u32x4*)(sm + (buf) * 32768 + lds_off(lr + 32 * i, lc)) = ra[i]; *(u32x4*)(sm + (buf) * 32768 + 16384 + lds_off(lr + 32 * i, lc)) = rb[i]; } } while (0)
    SC_GLOAD(0);
    SC_LSTORE(0, 0);
    __syncthreads();
    for (int q = 0; q < nq; ++q) {
      const int cur = q & 1;
      if (q + 1 < nq) SC_GLOAD(q + 1);
      if ((q & 1) == 0) {
        const int cc = q >> 1, c = dir ? nch - 1 - cc : cc;
        if (sample || cc == 1) {
          int slot = sample ? ((sb * 16 + c) * 4 + h) * 2 + dir : 256 + (sb * 4 + h) * 2 + dir;
          u16* sp = SNAP + (size_t)slot * 131072;
#pragma unroll
          for (int m = 0; m < 4; ++m)
#pragma unroll
            for (int n = 0; n < 4; ++n) {
              const int dd = dt * 128 + AROW(m, 0), ee = et * 128 + ACOL(n);
              uint2 pk; pk.x = pk_bf16(acc[m][n][0], acc[m][n][1]); pk.y = pk_bf16(acc[m][n][2], acc[m][n][3]);
              *(uint2*)(sp + (size_t)(dd >> 5) * 16384 + (size_t)ee * 32 + (dd & 31)) = pk;
            }
        }
#pragma unroll
        for (int m = 0; m < 4; ++m)
#pragma unroll
          for (int n = 0; n < 4; ++n) acc[m][n] *= cdec;
      }
      const char* sa = sm + cur * 32768;
      const char* sb2 = sa + 16384;
#pragma unroll
      for (int ks = 0; ks < 2; ++ks) {
        bf16x8 a[4], b[4];
#pragma unroll
        for (int m = 0; m < 4; ++m) a[m] = *(const bf16x8*)(sa + lds_off(wm * 64 + m * 16 + fr, ks * 32 + fq * 8));
#pragma unroll
        for (int n = 0; n < 4; ++n) b[n] = *(const bf16x8*)(sb2 + lds_off(wn * 64 + n * 16 + fr, ks * 32 + fq * 8));
#pragma unroll
        for (int m = 0; m < 4; ++m)
#pragma unroll
          for (int n = 0; n < 4; ++n) acc[m][n] = mfma16(a[m], b[n], acc[m][n]);
      }
      if (q + 1 < nq) SC_LSTORE(cur ^ 1, q + 1);
      __syncthreads();
    }
#undef SC_TOK
#undef SC_GLOAD
#undef SC_LSTORE
    if (sample) {
      const int c = dir ? 0 : 15;
      u16* sp = SNAP + (size_t)(((sb * 16 + c) * 4 + h) * 2 + dir) * 131072 + (size_t)(et * 128) * 256 + dt * 128;
      epi_store_bf16_T(acc, sp, 256, IdF());
    } else {
      float* so = p.out + (dir ? O_SB : O_SF) + ((size_t)(sb * 4 + h) * 256 + dt * 128) * 512 + et * 128;
#pragma unroll
      for (int m = 0; m < 4; ++m) {
#pragma unroll
        for (int hh = 0; hh < 2; ++hh) {
          float* pm = opaque(so + (size_t)AROW(m, 2 * hh) * 512 + ACOL(0));
#pragma unroll
          for (int n = 0; n < 4; ++n)
#pragma unroll
            for (int r = 0; r < 2; ++r) pm[r * 512 + n * 16] = acc[m][n][2 * hh + r];
        }
        __builtin_amdgcn_sched_barrier(0);
      }
    }
  }
}

template <int J>
__device__ __forceinline__ void ret_ring_step(int ks, const u16* Ap, const u16* Bp, char* sm, unsigned aA, unsigned aB, int t, f32x4 (&a2)[4][8]) {
  asm volatile("s_waitcnt vmcnt(0)" ::: "memory");
  __builtin_amdgcn_s_barrier();
  if (ks + 1 < 8) {
    char* d = sm + (J ^ 1) * 36864 + t * 16;
    const int ko = (ks + 1) * 32;
    __builtin_amdgcn_global_load_lds((const unsigned*)(Ap + (size_t)(ks + 1) * 262144), (unsigned*)d, 16, 0, 0);
    const u16* bp = opaque(Bp + (size_t)(ks + 1) * 16384);
#pragma unroll
    for (int i = 0; i < 8; ++i) {
      __builtin_amdgcn_global_load_lds((const unsigned*)bp, (unsigned*)(d + 4096 + i * 4096), 16, 0, 0);
      bp = opaque(bp + 64 * 32);
    }
  }
  bf16x8 a0, a1, a2f, a3, b0, b1, b2, b3, b4, b5, b6, b7;
  asm volatile(
      "ds_read_b128 %0, %12 offset:%14\n\t"
      "ds_read_b128 %4, %13 offset:%18\n\t"
      "ds_read_b128 %5, %13 offset:%19\n\t"
      "ds_read_b128 %1, %12 offset:%15\n\t"
      "ds_read_b128 %6, %13 offset:%20\n\t"
      "ds_read_b128 %7, %13 offset:%21\n\t"
      "ds_read_b128 %2, %12 offset:%16\n\t"
      "ds_read_b128 %8, %13 offset:%22\n\t"
      "ds_read_b128 %9, %13 offset:%23\n\t"
      "ds_read_b128 %3, %12 offset:%17\n\t"
      "ds_read_b128 %10, %13 offset:%24\n\t"
      "ds_read_b128 %11, %13 offset:%25\n\t"
      "s_waitcnt lgkmcnt(0)"
      : "=&v"(a0), "=&v"(a1), "=&v"(a2f), "=&v"(a3), "=&v"(b0), "=&v"(b1), "=&v"(b2), "=&v"(b3), "=&v"(b4), "=&v"(b5), "=&v"(b6), "=&v"(b7)
      : "v"(aA), "v"(aB), "n"(J * 36864), "n"(J * 36864 + 1024), "n"(J * 36864 + 2048), "n"(J * 36864 + 3072),
        "n"(J * 36864), "n"(J * 36864 + 1024), "n"(J * 36864 + 2048), "n"(J * 36864 + 3072),
        "n"(J * 36864 + 4096), "n"(J * 36864 + 5120), "n"(J * 36864 + 6144), "n"(J * 36864 + 7168)
      : "memory");
#define RR_ROW(m, am) a2[m][0] = mfma16(am, b0, a2[m][0]); a2[m][1] = mfma16(am, b1, a2[m][1]); a2[m][2] = mfma16(am, b2, a2[m][2]); a2[m][3] = mfma16(am, b3, a2[m][3]); \
                      a2[m][4] = mfma16(am, b4, a2[m][4]); a2[m][5] = mfma16(am, b5, a2[m][5]); a2[m][6] = mfma16(am, b6, a2[m][6]); a2[m][7] = mfma16(am, b7, a2[m][7]);
  RR_ROW(0, a0) RR_ROW(1, a1) RR_ROW(2, a2f) RR_ROW(3, a3)
#undef RR_ROW
  __builtin_amdgcn_sched_barrier(0);
}
__device__ __forceinline__ void ret_ring_gemm(const u16* __restrict__ qbase, const u16* __restrict__ sbase, f32x4 (&a2)[4][8], char* sm) {
  const int t = tid_now(), lane = t & 63, w = t >> 6, fr = lane & 15, fq = lane >> 4;
  const int sb = lane * 16, swz = sb ^ (((sb >> 9) & 1) << 5);
  const int r0 = w * 16 + (swz >> 6), c0 = (swz & 63) >> 1;
  const u16* Ap = qbase + (size_t)r0 * 32 + c0;
  const u16* Bp = sbase + (size_t)r0 * 32 + c0;
  const unsigned smb = (unsigned)(uintptr_t)(LAS3 char*)sm;
  const unsigned aA = smb + lds_off32(fr, fq * 8);
  const unsigned aB = smb + 4096 + w * 8192 + lds_off32(fr, fq * 8);
  {
    char* d = sm + t * 16;
    __builtin_amdgcn_global_load_lds((const unsigned*)Ap, (unsigned*)d, 16, 0, 0);
#pragma unroll
    for (int i = 0; i < 8; ++i)
      __builtin_amdgcn_global_load_lds((const unsigned*)(Bp + (size_t)(64 * i) * 32), (unsigned*)(d + 4096 + i * 4096), 16, 0, 0);
  }
#pragma unroll 1
  for (int ks = 0; ks < 8; ks += 2) {
    ret_ring_step<0>(ks, Ap, Bp, sm, aA, aB, t, a2);
    ret_ring_step<1>(ks + 1, Ap, Bp, sm, aA, aB, t, a2);
  }
  __builtin_amdgcn_s_barrier();
}

__device__ __forceinline__ void phase_ret_out(const Params& p, char* sm) {
  for (int idx = blockIdx.x; idx < 512; idx += gridDim.x) {
    int t = tid_now();
    asm volatile("" : "+v"(t));
    const int lane = t & 63, w = t >> 6, fr = lane & 15, fq = lane >> 4;
    unsigned char* wsb = p.ws;
    asm volatile("" : "+s"(wsb));
    const u16* Q = (const u16*)(wsb + WS_RA);
    const u16* Kb = (const u16*)(wsb + WS_RB);
    const u16* VTp = (const u16*)(wsb + WS_RD);
    const u16* VTs = VTp + (size_t)16 * 2048 * 256;
    u16* SZ = (u16*)(wsb + WS_RE);
    const u16* SNAP = (const u16*)(wsb + WS_RF);
    const float* gn = p.in[21];
    int ii = idx, gbase = 32;
    if (ii >= 256) { ii -= 256; gbase = 0; }
    const int xl = ii & 7, yy = ii >> 3;
    const int rh = yy & 1, h = xl & 3;
    const int gc = gbase + (yy >> 1) * 2 + (xl >> 2);
    const bool sample = gc >= 32;
    int sb, c;
    if (sample) { sb = (gc - 32) >> 4; c = (gc - 32) & 15; } else { sb = gc >> 1; c = gc & 1; }
    const size_t R0 = (size_t)gc * 128 + rh * 64;
    const float lgf2 = logsig2(p.in[19][h]), lgb2 = logsig2(p.in[20][h]);
    {
      f32x4 a1[4][2];
#pragma unroll
      for (int m = 0; m < 4; ++m)
#pragma unroll
        for (int n = 0; n < 2; ++n) a1[m][n] = (f32x4){0.f, 0.f, 0.f, 0.f};
      const u16* qp = Q + (size_t)(h * 8) * 262144 + (R0 + fr) * 32 + fq * 8;
      const u16* kp = Kb + (size_t)(h * 8) * 262144 + ((size_t)gc * 128 + w * 32 + fr) * 32 + fq * 8;
#pragma unroll 1
      for (int kb = 0; kb < 8; kb += 4) {
        bf16x8 af[4][4], bfr[4][2];
#pragma unroll
        for (int k2 = 0; k2 < 4; ++k2) {
#pragma unroll
          for (int m = 0; m < 4; ++m) af[k2][m] = *(const bf16x8*)(qp + (size_t)(kb + k2) * 262144 + (16 * m) * 32);
#pragma unroll
          for (int n = 0; n < 2; ++n) bfr[k2][n] = *(const bf16x8*)(kp + (size_t)(kb + k2) * 262144 + (16 * n) * 32);
        }
#pragma unroll
        for (int k2 = 0; k2 < 4; ++k2)
#pragma unroll
          for (int m = 0; m < 4; ++m)
#pragma unroll
            for (int n = 0; n < 2; ++n) a1[m][n] = mfma16(af[k2][m], bfr[k2][n], a1[m][n]);
      }
#pragma unroll
      for (int m = 0; m < 4; ++m)
#pragma unroll
        for (int n = 0; n < 2; ++n)
#pragma unroll
          for (int r = 0; r < 4; ++r) {
            int il = 16 * m + 4 * fq + r, i = rh * 64 + il, jj = w * 32 + 16 * n + fr;
            int dd = i - jj;
            float f = dd > 0 ? fexp2((float)dd * lgf2) : (dd < 0 ? fexp2((float)(-dd) * lgb2) : 2.0f);
            *(u16*)(sm + (jj >> 6) * 8192 + lds_off(il, jj & 63)) = f2bf(a1[m][n][r] * f);
          }
    }
    __syncthreads();
    f32x4 a2[4][8];
#pragma unroll
    for (int m = 0; m < 4; ++m)
#pragma unroll
      for (int n = 0; n < 8; ++n) a2[m][n] = (f32x4){0.f, 0.f, 0.f, 0.f};
    {
      const u16* vt; size_t ldv;
      if (sample) { ldv = 2048; vt = VTs + ((size_t)sb * 2048 + h * 512 + w * 128 + fr) * 2048 + c * 128 + fq * 8; }
      else { ldv = 256; vt = VTp + ((size_t)sb * 2048 + h * 512 + w * 128 + fr) * 256 + c * 128 + fq * 8; }
#pragma unroll 1
      for (int kb = 0; kb < 4; kb += 2) {
        bf16x8 bv[2][8];
#pragma unroll
        for (int k2 = 0; k2 < 2; ++k2)
#pragma unroll
          for (int n = 0; n < 8; ++n) bv[k2][n] = *(const bf16x8*)(vt + (size_t)(16 * n) * ldv + (kb + k2) * 32);
#pragma unroll
        for (int k2 = 0; k2 < 2; ++k2) {
          const int ks = kb + k2;
          bf16x8 af[4];
#pragma unroll
          for (int m = 0; m < 4; ++m) af[m] = *(const bf16x8*)(sm + (ks >> 1) * 8192 + lds_off(16 * m + fr, (ks & 1) * 32 + fq * 8));
#pragma unroll
          for (int n = 0; n < 8; ++n)
#pragma unroll
            for (int m = 0; m < 4; ++m) a2[m][n] = mfma16(af[m], bv[k2][n], a2[m][n]);
        }
        __builtin_amdgcn_sched_barrier(0);
      }
    }
    __syncthreads();
    {
      int tb = tid_now();
      asm volatile("" : "+v"(tb));
      const int fq = (tb & 63) >> 4;
      bool hasF = sample || c == 1, hasB = sample || c == 0;
      int mode = 0;
#pragma unroll 1
      for (int dir = 0; dir < 2; ++dir) {
        bool has = dir == 0 ? hasF : hasB;
        if (!has) continue;
#pragma unroll
        for (int m = 0; m < 4; ++m)
#pragma unroll
          for (int r = 0; r < 4; ++r) {
            float fi = (float)(rh * 64 + 16 * m + 4 * fq + r);
            float ecur = mode == 0 ? 0.f : (fi + 1.f) * lgf2;
            float enew = dir == 0 ? (fi + 1.f) * lgf2 : (128.f - fi) * lgb2;
            float f = fexp2(ecur - enew);
#pragma unroll
            for (int n = 0; n < 8; ++n) a2[m][n][r] *= f;
          }
        mode = dir + 1;
        int slot = sample ? ((sb * 16 + c) * 4 + h) * 2 + dir : 256 + (sb * 4 + h) * 2 + dir;
        ret_ring_gemm(Q + (size_t)(h * 8) * 262144 + R0 * 32, SNAP + (size_t)slot * 131072, a2, sm);
      }
      if (mode != 0) {
#pragma unroll
        for (int m = 0; m < 4; ++m)
#pragma unroll
          for (int r = 0; r < 4; ++r) {
            float fi = (float)(rh * 64 + 16 * m + 4 * fq + r);
            float f = fexp2(mode == 1 ? (fi + 1.f) * lgf2 : (128.f - fi) * lgb2);
#pragma unroll
            for (int n = 0; n < 8; ++n) a2[m][n][r] *= f;
          }
      }
    }
    int t3 = tid_now();
    asm volatile("" : "+v"(t3));
    {
    const int lane = t3 & 63, w = t3 >> 6, fr = lane & 15, fq = lane >> 4;
    float* red = (float*)(sm + 69632);
#pragma unroll
    for (int m = 0; m < 4; ++m)
#pragma unroll
      for (int r = 0; r < 4; ++r) {
        float s1 = 0.f, s2 = 0.f;
#pragma unroll
        for (int n = 0; n < 8; ++n) { float v = a2[m][n][r]; s1 += v; s2 += v * v; }
#pragma unroll
        for (int o = 1; o < 16; o <<= 1) { s1 += __shfl_xor(s1, o); s2 += __shfl_xor(s2, o); }
        if (fr == 0) { int row = 16 * m + 4 * fq + r; red[(w * 64 + row) * 2] = s1; red[(w * 64 + row) * 2 + 1] = s2; }
      }
    __syncthreads();
    u16* stg = (u16*)(sm + w * 17408);
    float gv[8];
#pragma unroll
    for (int n = 0; n < 8; ++n) gv[n] = gn[h * 512 + w * 128 + 16 * n + fr];
#pragma unroll
    for (int m = 0; m < 4; ++m)
#pragma unroll
      for (int r = 0; r < 4; ++r) {
        int row = 16 * m + 4 * fq + r;
        float s1 = 0.f, s2 = 0.f;
#pragma unroll
        for (int ww = 0; ww < 4; ++ww) { s1 += red[(ww * 64 + row) * 2]; s2 += red[(ww * 64 + row) * 2 + 1]; }
        float mean = s1 * (1.f / 512.f);
        float var = s2 * (1.f / 512.f) - mean * mean;
        var = var < 0.f ? 0.f : var;
        float rstd = rsqrtf(var + 1e-6f);
#pragma unroll
        for (int n = 0; n < 8; ++n) stg[row * 136 + 16 * n + fr] = f2bf((a2[m][n][r] - mean) * rstd * gv[n]);
      }
#pragma unroll 8
    for (int i = 0; i < 16; ++i) {
      int row = (lane >> 4) + 4 * i, ch = lane & 15;
      uint4 yv = *(const uint4*)(stg + row * 136 + ch * 8);
      const int zc = h * 512 + w * 128 + ch * 8;
      u16* zp = SZ + (size_t)(zc >> 5) * 262144 + (R0 + row) * 32 + (zc & 31);
      uint4 zv = *(const uint4*)zp;
      uint4 o;
      o.x = pk_bf16(bflo(yv.x) * bflo(zv.x), bfhi(yv.x) * bfhi(zv.x));
      o.y = pk_bf16(bflo(yv.y) * bflo(zv.y), bfhi(yv.y) * bfhi(zv.y));
      o.z = pk_bf16(bflo(yv.z) * bflo(zv.z), bfhi(yv.z) * bfhi(zv.z));
      o.w = pk_bf16(bflo(yv.w) * bflo(zv.w), bfhi(yv.w) * bfhi(zv.w));
      *(uint4*)zp = o;
    }
    }
    __syncthreads();
  }
}

#define XB_TMO      128
#define XB_XCNT(j)  (256  + 64 * (j))
#define XB_XSUB(j)  (1280 + 64 * (j))
#define XB_XGEN(j)  (2304 + 64 * (j))
#define XB_TOP      3328
#define XB_TOPGEN   3392
#define XCD_BAR_WORDS 3456
#define XB_SPIN_CAP (1u << 18)
#define LAS __attribute__((address_space(3)))
__device__ __forceinline__ unsigned xb_ld(unsigned* p)              { return __hip_atomic_load(p, __ATOMIC_RELAXED, __HIP_MEMORY_SCOPE_AGENT); }
__device__ __forceinline__ unsigned xb_add(unsigned* p, unsigned v) { return __hip_atomic_fetch_add(p, v, __ATOMIC_RELAXED, __HIP_MEMORY_SCOPE_AGENT); }
__device__ __forceinline__ unsigned xb_xcc_id() { return (unsigned)__builtin_amdgcn_s_getreg((3 << 11) | 20) & 0xFu; }
#define XB_SPIN(cond, bar) do { unsigned _sp = 0; while (cond) { __builtin_amdgcn_s_sleep(1); \
    if ((++_sp & 255u) == 0u) { if (xb_ld(&(bar)[XB_TMO])) break; if (_sp > XB_SPIN_CAP) { atomicAdd(&(bar)[XB_TMO], 1u); break; } } } } while (0)
struct XcdBarrier { unsigned* bar; unsigned x; volatile LAS unsigned* st; };
__device__ __forceinline__ XcdBarrier xcd_barrier_post(unsigned* bar, volatile LAS unsigned* st) {
    XcdBarrier b; b.bar = bar; b.x = xb_xcc_id(); b.st = st;
    if (tid_now() == 0) (void)xb_add(&bar[XB_XCNT(b.x)], 1u);
    return b;
}
__device__ __forceinline__ void xcd_barrier_complete(unsigned* bar, unsigned x, unsigned& nloc, unsigned& nx) {
    const unsigned G = gridDim.x * gridDim.y * gridDim.z;
    unsigned sum, cnt, mine, sp = 0u;
    for (;;) {
        sum = 0u; cnt = 0u; mine = 0u;
#pragma unroll
        for (unsigned j = 0; j < 16; ++j) { const unsigned c = xb_ld(&bar[XB_XCNT(j)]); sum += c; cnt += (c > 0u) ? 1u : 0u; mine = (j == x) ? c : mine; }
        if (sum == G) break;
        __builtin_amdgcn_s_sleep(1);
        if ((++sp & 255u) == 0u) { if (xb_ld(&bar[XB_TMO])) break; if (sp > XB_SPIN_CAP) { atomicAdd(&bar[XB_TMO], 1u); break; } }
    }
    nloc = mine > 0u ? mine : 1u; nx = cnt > 0u ? cnt : 1u;
}
__device__ __forceinline__ void xcd_barrier(const XcdBarrier& b) {
    asm volatile("s_waitcnt vmcnt(0)" ::: "memory");
    __syncthreads();
    if (tid_now() == 0) {
        unsigned* bar = b.bar;
        __builtin_amdgcn_s_waitcnt(0);
        unsigned nloc = b.st[0], nx = b.st[1];
        if (nloc == 0u) { xcd_barrier_complete(bar, b.x, nloc, nx); b.st[0] = nloc; b.st[1] = nx; }
        const unsigned old = xb_add(&bar[XB_XSUB(b.x)], 1u);
        const unsigned gen = old / nloc;
        if (old + 1u == (gen + 1u) * nloc) {
            __builtin_amdgcn_fence(__ATOMIC_RELEASE, "agent");
            asm volatile("s_waitcnt vmcnt(0)" ::: "memory");
            const unsigned og = xb_add(&bar[XB_TOP], 1u);
            const unsigned tg = og / nx;
            if (og + 1u == (tg + 1u) * nx) xb_add(&bar[XB_TOPGEN], 1u);
            else XB_SPIN(xb_ld(&bar[XB_TOPGEN]) == tg, bar);
            __builtin_amdgcn_fence(__ATOMIC_ACQUIRE, "agent");
            xb_add(&bar[XB_XGEN(b.x)], 1u);
            asm volatile("s_waitcnt vmcnt(0)" ::: "memory");
        } else {
            XB_SPIN(xb_ld(&bar[XB_XGEN(b.x)]) == gen, bar);
            __builtin_amdgcn_fence(__ATOMIC_ACQUIRE, "agent");
            asm volatile("s_waitcnt vmcnt(0)" ::: "memory");
        }
    }
    __syncthreads();
}

__global__ void __launch_bounds__(NTHREADS, 2) mega(Params p, int ph_lo, int ph_hi) {
  __shared__ __attribute__((aligned(16))) char sm[SMEM_BYTES];
  cg::grid_group grid = cg::this_grid();
  __shared__ uint4 xb_words;
  if ((threadIdx.x & 63) == 0) g_wave_tab[hw_slot()] = (int)(threadIdx.x >> 6);
  if (threadIdx.x == 0) xb_words = make_uint4(0u, 0u, 0u, 0u);
  __syncthreads();
  (void)xcd_barrier_post((unsigned*)(p.ws + WS_BAR), (volatile LAS unsigned*)&xb_words);
  if (ph_lo < 0) grid.sync();
  const float* xp0 = p.in[0];
  const float* xs0 = p.in[1];
  const float* xp1 = p.out;
  const float* xs1 = p.out + (size_t)4096 * 1024;
#ifndef PH_ONLY
#define PH_ONLY -1
#endif
#define PHON(x) (PH_ONLY < 0 || PH_ONLY == (x))
#define RUN(k, call) do { if (ph_lo <= (k) && (k) < ph_hi) { if (PHON(k)) { call; } if ((k) + 1 < ph_hi) { XcdBarrier xb; xb.bar = (unsigned*)(p.ws + WS_BAR); xb.x = xb_xcc_id(); xb.st = (volatile LAS unsigned*)&xb_words; xcd_barrier(xb); } } } while (0)
  RUN(0, phase_prep(p, sm));
  RUN(1, phase_norm(p, 0, xp0, xs0));
  RUN(2, phase_attn_inproj(p, 0, sm));
  RUN(3, phase_attn(p, 0, sm));
  RUN(4, phase_outproj(p, 0, (const u16*)(p.ws + WS_RC), 1024, (const u16*)(p.ws + WS_WAO), xp0, xs0, sm));
  RUN(5, phase_norm(p, 1, xp1, xs1));
  RUN(6, phase_pool_inproj(p, sm));
  RUN(7, phase_pool_d(p));
  RUN(8, phase_pool_gemm(p, sm));
  RUN(9, phase_outproj(p, 1, (const u16*)(p.ws + WS_RC), 1024, (const u16*)(p.ws + WS_WPO), xp1, xs1, sm));
  RUN(10, phase_norm(p, 2, xp1, xs1));
  RUN(11, phase_ret_inproj(p, sm));
  RUN(12, phase_ret_scan(p, sm));
  RUN(13, phase_ret_out(p, sm));
  RUN(14, phase_outproj(p, 2, (const u16*)(p.ws + WS_RE), 2048, (const u16*)(p.ws + WS_WRO), xp1, xs1, sm));
  RUN(15, phase_norm(p, 3, xp1, xs1));
  RUN(16, phase_attn_inproj(p, 1, sm));
  RUN(17, phase_attn(p, 1, sm));
  RUN(18, phase_outproj(p, 3, (const u16*)(p.ws + WS_RC), 1024, (const u16*)(p.ws + WS_WAO) + (size_t)1024 * 1024, xp1, xs1, sm));
  RUN(19, phase_final_norm(p));
}

extern "C" void kernel_launch(void* const* d_in, const int* in_sizes, int n_in, void* d_out, int out_size, void* d_ws, size_t ws_size,
                              hipStream_t stream) {
  static int grid_blocks = 0;
  if (!grid_blocks) {
    int dev = 0, cus = 0, per_cu = 0;
    hipGetDevice(&dev);
    hipDeviceGetAttribute(&cus, hipDeviceAttributeMultiprocessorCount, dev);
    hipOccupancyMaxActiveBlocksPerMultiprocessor(&per_cu, mega, NTHREADS, 0);
    if (per_cu < 1) per_cu = 1;
    if (per_cu > 2) per_cu = 2;
    grid_blocks = cus * per_cu;
    if (ws_size < WS_END) fprintf(stderr, "kernel_launch: workspace too small: %zu < %zu\n", ws_size, (size_t)WS_END);
  }
  Params p{};
  for (int i = 0; i < 24; ++i) p.in[i] = (const float*)d_in[i];
  p.out = (float*)d_out;
  p.ws = (unsigned char*)d_ws;
#ifndef N_SPLIT
#define N_SPLIT 1
#endif
#ifndef PH_END
#define PH_END 20
#endif
  if (PH_END < 20) (void)hipMemsetAsync(d_out, 0, (size_t)out_size * 4, stream);
  (void)hipMemsetAsync((char*)d_ws + WS_BAR, 0, XCD_BAR_WORDS * 4, stream);
#ifndef PROBE_DUP
#define PROBE_DUP -1
#endif
  {
    int seg[4][2]; int nseg = 0;
    if (PROBE_DUP < 0) { seg[0][0] = 0; seg[0][1] = PH_END; nseg = 1; }
#ifndef PROBE_LO
#define PROBE_LO PROBE_DUP
#endif
    else { seg[0][0] = 0; seg[0][1] = PROBE_DUP + 1; seg[1][0] = PROBE_LO; seg[1][1] = PROBE_DUP + 1; nseg = 2; if (PROBE_DUP + 1 < 20) { seg[2][0] = PROBE_DUP + 1; seg[2][1] = 20; nseg = 3; } }
    for (int li = 0; li < nseg; ++li) {
      int lo = seg[li][0], hi = seg[li][1];
      if (li > 0) (void)hipMemsetAsync((char*)d_ws + WS_BAR, 0, XCD_BAR_WORDS * 4, stream);
      void* args[] = {&p, &lo, &hi};
      hipError_t e = hipLaunchCooperativeKernel((void*)mega, dim3(grid_blocks), dim3(NTHREADS), args, 0, stream);
      if (e != hipSuccess) fprintf(stderr, "cooperative launch failed: %s (grid %d)\n", hipGetErrorString(e), grid_blocks);
    }
  }
}
```

```cpp
#include <hip/hip_runtime.h>
#include <hip/hip_cooperative_groups.h>
#include <cstdio>
#include <cstdint>
namespace cg = cooperative_groups;

typedef unsigned short u16;
typedef short bf16x8 __attribute__((ext_vector_type(8)));
typedef float f32x4 __attribute__((ext_vector_type(4)));
typedef unsigned u32x4 __attribute__((ext_vector_type(4)));
typedef float f32x4v __attribute__((ext_vector_type(4)));

#define NTHREADS 256
#define SMEM_BYTES 73728
constexpr float LOG2E = 1.4426950408889634f;

constexpr size_t MiB = 1048576;
constexpr size_t WS_MOD  = 0;
constexpr size_t WS_ROPE = 147456;
constexpr size_t WS_BAR  = 155648;
constexpr size_t WS_WAI  = 262144;
constexpr size_t WS_WAO  = WS_WAI + 2 * 2560 * 1024 * 2;
constexpr size_t WS_WPI  = WS_WAO + 2 * 1024 * 1024 * 2;
constexpr size_t WS_WPG  = WS_WPI + 2048 * 1024 * 2;
constexpr size_t WS_WPO  = WS_WPG + 4 * 256 * 256 * 2;
constexpr size_t WS_WRI  = WS_WPO + 1024 * 1024 * 2;
constexpr size_t WS_WRO  = WS_WRI + 6144 * 1024 * 2;
constexpr size_t WS_CK   = WS_WRO + 1024 * 2048 * 2;
constexpr size_t WS_CVT  = WS_CK + 2 * 2 * 512 * 256 * 2;
constexpr size_t WS_RA   = WS_CVT + 2 * 2 * 512 * 256 * 2;
constexpr size_t WS_RB   = WS_RA + 16 * MiB;
constexpr size_t WS_RC   = WS_RB + 16 * MiB;
constexpr size_t WS_RD   = WS_RC + 16 * MiB;
constexpr size_t WS_RE   = WS_RD + 32 * MiB;
constexpr size_t WS_RF   = WS_RE + 32 * MiB;
constexpr size_t WS_END  = WS_RF + 96 * MiB;

constexpr size_t O_NK = 8388608, O_NV = 10485760, O_SF = 12582912, O_SB = 20971520;

struct Params {
  const float* in[24];
  float* out;
  unsigned char* ws;
};

typedef __bf16 bf16x2_t __attribute__((ext_vector_type(2)));
__device__ __forceinline__ unsigned pk_bf16(float lo, float hi) { bf16x2_t v; v.x = (__bf16)lo; v.y = (__bf16)hi; return __builtin_bit_cast(unsigned, v); }
__device__ __forceinline__ u16 f2bf(float f) { return __builtin_bit_cast(u16, (__bf16)f); }
__device__ __forceinline__ float bf2f(u16 h) { return __uint_as_float(((unsigned)h) << 16); }
__device__ __forceinline__ float bflo(unsigned u) { return __uint_as_float(u << 16); }
__device__ __forceinline__ float bfhi(unsigned u) { return __uint_as_float(u & 0xffff0000u); }
__device__ __forceinline__ float fexp2(float x) { return __builtin_amdgcn_exp2f(x); }
__shared__ int g_wave_tab[64];
__device__ __forceinline__ int hw_slot() { return (int)(__builtin_amdgcn_s_getreg(((6 - 1) << 11) | 4) & 63u); }
__device__ __forceinline__ int lane_now() { return (int)__builtin_amdgcn_mbcnt_hi(~0u, __builtin_amdgcn_mbcnt_lo(~0u, 0u)); }
__device__ __forceinline__ int tid_now() { return __builtin_amdgcn_readfirstlane(g_wave_tab[hw_slot()]) * 64 + lane_now(); }
__device__ __forceinline__ float silu(float x) { return x / (1.f + __expf(-x)); }
__device__ __forceinline__ float logsig2(float x) { return -log1pf(expf(-x)) * LOG2E; }
__device__ __forceinline__ f32x4 mfma16(bf16x8 a, bf16x8 b, f32x4 c) { return __builtin_amdgcn_mfma_f32_16x16x32_bf16(a, b, c, 0, 0, 0); }

template <typename T> __device__ __forceinline__ T* opaque(T* p) { asm volatile("" : "+v"(p)); return p; }

__device__ __forceinline__ int lds_off(int r, int c) {
  int st = (r >> 4) * 2 + (c >> 5), ob = (r & 15) * 64 + (c & 31) * 2;
  return st * 1024 + (ob ^ (((ob >> 9) & 1) << 5));
}

__device__ __forceinline__ bf16x8 scale_frag(bf16x8 v, float s) {
  union { bf16x8 v; unsigned u[4]; } x; x.v = v;
#pragma unroll
  for (int i = 0; i < 4; ++i) x.u[i] = pk_bf16(bflo(x.u[i]) * s, bfhi(x.u[i]) * s);
  return x.v;
}

template <bool SCALE>
__device__ __forceinline__ void gemm_core(const u16* __restrict__ A, size_t lda, const u16* __restrict__ B, size_t ldb, int K,
                                          f32x4 (&acc)[4][4], char* sm, float lg2 = 0.f, int dir = 0) {
  const int t = tid_now(), lane = t & 63, w = t >> 6, wm = w >> 1, wn = w & 1, fr = lane & 15, fq = lane >> 4;
  const int lr = t >> 3, lc = (t & 7) * 8;
  uint4 ra[4], rb[4];
  const int nk = K >> 6;
  const u16* Ap = A + (size_t)lr * lda + lc;
  const u16* Bp = B + (size_t)lr * ldb + lc;
#define GLOAD(kt) do { _Pragma("unroll") for (int i = 0; i < 4; ++i) { ra[i] = *(const uint4*)(Ap + (size_t)(32 * i) * lda + (kt) * 64); rb[i] = *(const uint4*)(Bp + (size_t)(32 * i) * ldb + (kt) * 64); } } while (0)
#define LSTORE(buf, kt) do { \
    if (SCALE) { float fs[8]; _Pragma("unroll") for (int e = 0; e < 8; ++e) { int j = (kt) * 64 + lc + e; fs[e] = fexp2((float)(dir ? j : 127 - j) * lg2); } \
      _Pragma("unroll") for (int i = 0; i < 4; ++i) { unsigned* u = (unsigned*)&ra[i]; _Pragma("unroll") for (int e = 0; e < 4; ++e) u[e] = pk_bf16(bflo(u[e]) * fs[2 * e], bfhi(u[e]) * fs[2 * e + 1]); } } \
    _Pragma("unroll") for (int i = 0; i < 4; ++i) { *(uint4*)(sm + (buf) * 32768 + lds_off(lr + 32 * i, lc)) = ra[i]; *(uint4*)(sm + (buf) * 32768 + 16384 + lds_off(lr + 32 * i, lc)) = rb[i]; } } while (0)
  GLOAD(0);
  LSTORE(0, 0);
  __syncthreads();
  for (int kt = 0; kt < nk; ++kt) {
    const int cur = kt & 1;
    if (kt + 1 < nk) GLOAD(kt + 1);
    const char* sa = sm + cur * 32768;
    const char* sb = sa + 16384;
#pragma unroll
    for (int ks = 0; ks < 2; ++ks) {
      bf16x8 a[4], b[4];
#pragma unroll
      for (int m = 0; m < 4; ++m) a[m] = *(const bf16x8*)(sa + lds_off(wm * 64 + m * 16 + fr, ks * 32 + fq * 8));
#pragma unroll
      for (int n = 0; n < 4; ++n) b[n] = *(const bf16x8*)(sb + lds_off(wn * 64 + n * 16 + fr, ks * 32 + fq * 8));
#pragma unroll
      for (int m = 0; m < 4; ++m)
#pragma unroll
        for (int n = 0; n < 4; ++n) acc[m][n] = mfma16(a[m], b[n], acc[m][n]);
    }
    if (kt + 1 < nk) LSTORE(cur ^ 1, kt + 1);
    __syncthreads();
  }
#undef GLOAD
#undef LSTORE
}

__device__ __forceinline__ int lds_off32(int r, int c) {
  int ob = (r & 15) * 64 + c * 2;
  return (r >> 4) * 1024 + (ob ^ (((ob >> 9) & 1) << 5));
}
#define LAS3 __attribute__((address_space(3)))
template <int J>
__device__ __forceinline__ void glds_step(int kt, int nk, const u16* Ap, size_t lda, const u16* Bp, size_t ldb, char* sm, unsigned aA, unsigned aB,
                                          f32x4 (&acc)[4][4]) {
  const int t = tid_now();
  if (kt + 2 < nk) asm volatile("s_waitcnt vmcnt(8)" ::: "memory");
  else if (kt + 1 < nk) asm volatile("s_waitcnt vmcnt(4)" ::: "memory");
  else asm volatile("s_waitcnt vmcnt(0)" ::: "memory");
  __builtin_amdgcn_s_barrier();
  bf16x8 a0, a1, a2, a3, b0, b1, b2, b3;
  asm volatile(
      "ds_read_b128 %0, %8 offset:%10\n\t"
      "ds_read_b128 %4, %9 offset:%10\n\t"
      "ds_read_b128 %5, %9 offset:%11\n\t"
      "ds_read_b128 %1, %8 offset:%11\n\t"
      "ds_read_b128 %6, %9 offset:%12\n\t"
      "ds_read_b128 %7, %9 offset:%13\n\t"
      "ds_read_b128 %2, %8 offset:%12\n\t"
      "ds_read_b128 %3, %8 offset:%13\n\t"
      "s_waitcnt lgkmcnt(0)"
      : "=&v"(a0), "=&v"(a1), "=&v"(a2), "=&v"(a3), "=&v"(b0), "=&v"(b1), "=&v"(b2), "=&v"(b3)
      : "v"(aA), "v"(aB), "n"(J * 16384), "n"(J * 16384 + 1024), "n"(J * 16384 + 2048), "n"(J * 16384 + 3072)
      : "memory");
  if (kt + 3 < nk) {
    char* d = sm + ((J + 3) & 3) * 16384 + t * 16;
    const size_t ko = (size_t)(kt + 3) * 32;
#pragma unroll
    for (int i = 0; i < 2; ++i) {
      __builtin_amdgcn_global_load_lds((const unsigned*)(Ap + (size_t)(64 * i) * 32 + (size_t)(kt + 3) * lda), (unsigned*)(d + i * 4096), 16, 0, 0);
      __builtin_amdgcn_global_load_lds((const unsigned*)(Bp + (size_t)(64 * i) * 32 + (size_t)(kt + 3) * ldb), (unsigned*)(d + 8192 + i * 4096), 16, 0, 0);
    }
  }
  acc[0][0] = mfma16(a0, b0, acc[0][0]); acc[0][1] = mfma16(a0, b1, acc[0][1]); acc[0][2] = mfma16(a0, b2, acc[0][2]); acc[0][3] = mfma16(a0, b3, acc[0][3]);
  acc[1][0] = mfma16(a1, b0, acc[1][0]); acc[1][1] = mfma16(a1, b1, acc[1][1]); acc[1][2] = mfma16(a1, b2, acc[1][2]); acc[1][3] = mfma16(a1, b3, acc[1][3]);
  acc[2][0] = mfma16(a2, b0, acc[2][0]); acc[2][1] = mfma16(a2, b1, acc[2][1]); acc[2][2] = mfma16(a2, b2, acc[2][2]); acc[2][3] = mfma16(a2, b3, acc[2][3]);
  acc[3][0] = mfma16(a3, b0, acc[3][0]); acc[3][1] = mfma16(a3, b1, acc[3][1]); acc[3][2] = mfma16(a3, b2, acc[3][2]); acc[3][3] = mfma16(a3, b3, acc[3][3]);
}
__device__ __forceinline__ void gemm_core_glds(const u16* __restrict__ A, size_t lda, const u16* __restrict__ B, size_t ldb, int K,
                                               f32x4 (&acc)[4][4], char* sm) {
  const int t = tid_now(), lane = t & 63, w = t >> 6, wm = w >> 1, wn = w & 1, fr = lane & 15, fq = lane >> 4;
  const int sb = lane * 16, swz = sb ^ (((sb >> 9) & 1) << 5);
  const int r0 = w * 16 + (swz >> 6), c0 = (swz & 63) >> 1;
  const u16* Ap = A + (size_t)r0 * 32 + c0;
  const u16* Bp = B + (size_t)r0 * 32 + c0;
  const int nk = K >> 5;
  const unsigned smb = (unsigned)(uintptr_t)(LAS3 char*)sm;
  const unsigned aA = smb + lds_off32(wm * 64 + fr, fq * 8);
  const unsigned aB = smb + 8192 + lds_off32(wn * 64 + fr, fq * 8);
#pragma unroll
  for (int j = 0; j < 3; ++j) {
    char* d = sm + j * 16384 + t * 16;
#pragma unroll
    for (int i = 0; i < 2; ++i) {
      __builtin_amdgcn_global_load_lds((const unsigned*)(Ap + (size_t)(64 * i) * 32 + (size_t)j * lda), (unsigned*)(d + i * 4096), 16, 0, 0);
      __builtin_amdgcn_global_load_lds((const unsigned*)(Bp + (size_t)(64 * i) * 32 + (size_t)j * ldb), (unsigned*)(d + 8192 + i * 4096), 16, 0, 0);
    }
  }
  for (int kt0 = 0; kt0 < nk; kt0 += 4) {
    glds_step<0>(kt0, nk, Ap, lda, Bp, ldb, sm, aA, aB, acc);
    glds_step<1>(kt0 + 1, nk, Ap, lda, Bp, ldb, sm, aA, aB, acc);
    glds_step<2>(kt0 + 2, nk, Ap, lda, Bp, ldb, sm, aA, aB, acc);
    glds_step<3>(kt0 + 3, nk, Ap, lda, Bp, ldb, sm, aA, aB, acc);
  }
  __syncthreads();
}

template <int J>
__device__ __forceinline__ void glds2_step(int kt, int nk, const u16* Ap, size_t lda, const u16* Bp, size_t ldb, char* sm, unsigned aA, unsigned aB, int t,
                                           f32x4 (&accL)[4][4], f32x4 (&accR)[4][4]) {
  if (kt + 1 < nk) asm volatile("s_waitcnt vmcnt(6)" ::: "memory");
  else asm volatile("s_waitcnt vmcnt(0)" ::: "memory");
  __builtin_amdgcn_s_barrier();
  bf16x8 a0, a1, a2, a3, b0, b1, b2, b3, b4, b5, b6, b7;
  asm volatile(
      "ds_read_b128 %0, %12 offset:%14\n\t"
      "ds_read_b128 %4, %13 offset:%14\n\t"
      "ds_read_b128 %5, %13 offset:%15\n\t"
      "ds_read_b128 %1, %12 offset:%15\n\t"
      "ds_read_b128 %6, %13 offset:%16\n\t"
      "ds_read_b128 %7, %13 offset:%17\n\t"
      "ds_read_b128 %2, %12 offset:%16\n\t"
      "ds_read_b128 %8, %13 offset:%18\n\t"
      "ds_read_b128 %9, %13 offset:%19\n\t"
      "ds_read_b128 %3, %12 offset:%17\n\t"
      "ds_read_b128 %10, %13 offset:%20\n\t"
      "ds_read_b128 %11, %13 offset:%21\n\t"
      "s_waitcnt lgkmcnt(0)"
      : "=&v"(a0), "=&v"(a1), "=&v"(a2), "=&v"(a3), "=&v"(b0), "=&v"(b1), "=&v"(b2), "=&v"(b3), "=&v"(b4), "=&v"(b5), "=&v"(b6), "=&v"(b7)
      : "v"(aA), "v"(aB), "n"(J * 24576), "n"(J * 24576 + 1024), "n"(J * 24576 + 2048), "n"(J * 24576 + 3072),
        "n"(J * 24576 + 8192), "n"(J * 24576 + 9216), "n"(J * 24576 + 10240), "n"(J * 24576 + 11264)
      : "memory");
  if (kt + 2 < nk) {
    char* d = sm + ((J + 2) % 3) * 24576 + t * 16;
    const size_t ko = (size_t)(kt + 2) * 32;
#pragma unroll
    for (int i = 0; i < 2; ++i) __builtin_amdgcn_global_load_lds((const unsigned*)(Ap + (size_t)(64 * i) * 32 + (size_t)(kt + 2) * lda), (unsigned*)(d + i * 4096), 16, 0, 0);
#pragma unroll
    for (int i = 0; i < 4; ++i) __builtin_amdgcn_global_load_lds((const unsigned*)(Bp + (size_t)(64 * i) * 32 + (size_t)(kt + 2) * ldb), (unsigned*)(d + 8192 + i * 4096), 16, 0, 0);
  }
#define G2_ROW(m, am) accL[m][0] = mfma16(am, b0, accL[m][0]); accL[m][1] = mfma16(am, b1, accL[m][1]); accL[m][2] = mfma16(am, b2, accL[m][2]); accL[m][3] = mfma16(am, b3, accL[m][3]); \
                      accR[m][0] = mfma16(am, b4, accR[m][0]); accR[m][1] = mfma16(am, b5, accR[m][1]); accR[m][2] = mfma16(am, b6, accR[m][2]); accR[m][3] = mfma16(am, b7, accR[m][3]);
  G2_ROW(0, a0) G2_ROW(1, a1) G2_ROW(2, a2) G2_ROW(3, a3)
#undef G2_ROW
  __builtin_amdgcn_sched_barrier(0);
}
__device__ __forceinline__ void gemm_core_glds2(const u16* __restrict__ A, size_t lda, const u16* __restrict__ B, size_t ldb, int K,
                                                f32x4 (&accL)[4][4], f32x4 (&accR)[4][4], char* sm) {
  const int t = tid_now(), lane = t & 63, w = t >> 6, wm = w >> 1, wn = w & 1, fr = lane & 15, fq = lane >> 4;
  const int sb = lane * 16, swz = sb ^ (((sb >> 9) & 1) << 5);
  const int r0 = w * 16 + (swz >> 6), c0 = (swz & 63) >> 1;
  const u16* Ap = A + (size_t)r0 * 32 + c0;
  const u16* Bp = B + (size_t)r0 * 32 + c0;
  const int nk = K >> 5;
  const unsigned smb = (unsigned)(uintptr_t)(LAS3 char*)sm;
  const unsigned aA = smb + lds_off32(wm * 64 + fr, fq * 8);
  const unsigned aB = smb + 8192 + lds_off32(wn * 64 + fr, fq * 8);
#pragma unroll
  for (int j = 0; j < 2; ++j) {
    char* d = sm + j * 24576 + t * 16;
#pragma unroll
    for (int i = 0; i < 2; ++i) __builtin_amdgcn_global_load_lds((const unsigned*)(Ap + (size_t)(64 * i) * 32 + (size_t)j * lda), (unsigned*)(d + i * 4096), 16, 0, 0);
#pragma unroll
    for (int i = 0; i < 4; ++i) __builtin_amdgcn_global_load_lds((const unsigned*)(Bp + (size_t)(64 * i) * 32 + (size_t)j * ldb), (unsigned*)(d + 8192 + i * 4096), 16, 0, 0);
  }
  for (int kt0 = 0; kt0 < nk; kt0 += 3) {
    glds2_step<0>(kt0, nk, Ap, lda, Bp, ldb, sm, aA, aB, t, accL, accR);
    if (kt0 + 1 < nk) glds2_step<1>(kt0 + 1, nk, Ap, lda, Bp, ldb, sm, aA, aB, t, accL, accR);
    if (kt0 + 2 < nk) glds2_step<2>(kt0 + 2, nk, Ap, lda, Bp, ldb, sm, aA, aB, t, accL, accR);
  }
  __syncthreads();
}

#define WAVE_IDS const int t = tid_now(), lane = t & 63, w = t >> 6, wm = w >> 1, wn = w & 1, fr = lane & 15, fq = lane >> 4; (void)wm; (void)wn; (void)fr; (void)fq; (void)lane; (void)w; (void)t
#define AROW(m, r) (wm * 64 + (m) * 16 + fq * 4 + (r))
#define ACOL(n) (wn * 64 + (n) * 16 + fr)

template <class F>
__device__ __forceinline__ void epi_store_bf16(const f32x4 (&acc)[4][4], char* sm, u16* dst, size_t ldd, F f, const u16* mulp = nullptr, size_t ldm = 0) {
  WAVE_IDS;
  u16* cs = (u16*)sm;
#pragma unroll
  for (int m = 0; m < 4; ++m) {
#pragma unroll
    for (int n = 0; n < 4; ++n)
#pragma unroll
      for (int r = 0; r < 4; ++r) cs[AROW(m, r) * 136 + ACOL(n)] = f2bf(f(AROW(m, r), ACOL(n), acc[m][n][r]));
    __builtin_amdgcn_sched_barrier(0);
  }
  __syncthreads();
#pragma unroll
  for (int i = 0; i < 8; ++i) {
    int row = (t >> 4) + 16 * i, ch = t & 15;
    uint4 v = *(const uint4*)(cs + row * 136 + ch * 8);
    if (mulp) {
      uint4 z = *(const uint4*)(mulp + (size_t)row * ldm + ch * 8);
      v.x = pk_bf16(bflo(v.x) * bflo(z.x), bfhi(v.x) * bfhi(z.x));
      v.y = pk_bf16(bflo(v.y) * bflo(z.y), bfhi(v.y) * bfhi(z.y));
      v.z = pk_bf16(bflo(v.z) * bflo(z.z), bfhi(v.z) * bfhi(z.z));
      v.w = pk_bf16(bflo(v.w) * bflo(z.w), bfhi(v.w) * bfhi(z.w));
    }
    *(uint4*)(dst + (size_t)row * ldd + ch * 8) = v;
  }
  __syncthreads();
}

template <class F>
__device__ __forceinline__ void epi_store_bf16_T(const f32x4 (&acc)[4][4], u16* dstT, size_t ldt, F f) {
  WAVE_IDS;
#pragma unroll
  for (int m = 0; m < 4; ++m)
#pragma unroll
    for (int n = 0; n < 4; ++n) {
      float v0 = f(AROW(m, 0), ACOL(n), acc[m][n][0]), v1 = f(AROW(m, 1), ACOL(n), acc[m][n][1]);
      float v2 = f(AROW(m, 2), ACOL(n), acc[m][n][2]), v3 = f(AROW(m, 3), ACOL(n), acc[m][n][3]);
      uint2 pk; pk.x = pk_bf16(v0, v1); pk.y = pk_bf16(v2, v3);
      *(uint2*)(dstT + (size_t)ACOL(n) * ldt + AROW(m, 0)) = pk;
    }
}

template <class F>
__device__ __forceinline__ void epi_store_bf16_img(const f32x4 (&acc)[4][4], char* sm, u16* img, int row0, int col0, F f, const u16* mulp = nullptr, size_t ldm = 0) {
  WAVE_IDS;
  u16* cs = (u16*)sm;
#pragma unroll
  for (int m = 0; m < 4; ++m) {
#pragma unroll
    for (int n = 0; n < 4; ++n)
#pragma unroll
      for (int r = 0; r < 4; ++r) cs[AROW(m, r) * 136 + ACOL(n)] = f2bf(f(AROW(m, r), ACOL(n), acc[m][n][r]));
    __builtin_amdgcn_sched_barrier(0);
  }
  __syncthreads();
#pragma unroll
  for (int i = 0; i < 8; ++i) {
    int ch = (t & 3) + 4 * ((t >> 6) & 3), row = ((t >> 2) & 15) + 16 * i;
    uint4 v = *(const uint4*)(cs + row * 136 + ch * 8);
    if (mulp) {
      uint4 z = *(const uint4*)(mulp + (size_t)row * ldm + ch * 8);
      v.x = pk_bf16(bflo(v.x) * bflo(z.x), bfhi(v.x) * bfhi(z.x));
      v.y = pk_bf16(bflo(v.y) * bflo(z.y), bfhi(v.y) * bfhi(z.y));
      v.z = pk_bf16(bflo(v.z) * bflo(z.z), bfhi(v.z) * bfhi(z.z));
      v.w = pk_bf16(bflo(v.w) * bflo(z.w), bfhi(v.w) * bfhi(z.w));
    }
    const int col = col0 + ch * 8;
    *(uint4*)(img + (size_t)(col >> 5) * 262144 + (size_t)(row0 + row) * 32 + (col & 31)) = v;
  }
  __syncthreads();
}

struct IdF { __device__ __forceinline__ float operator()(int, int, float v) const { return v; } };
struct SiluF { __device__ __forceinline__ float operator()(int, int, float v) const { return silu(v); } };
struct ScaleF { float s; __device__ __forceinline__ float operator()(int, int, float v) const { return v * s; } };

__device__ __forceinline__ void transpose_tile(const float* __restrict__ src, size_t ldn, u16* __restrict__ dst, size_t ldk, int k0, int n0, char* smc, size_t bstep) {
  float* sm = (float*)smc;
  const int t = tid_now(), l = t & 63, w = t >> 6;
  float4 v[16];
#pragma unroll
  for (int i = 0; i < 16; ++i) { f32x4v nv = __builtin_nontemporal_load((const f32x4v*)(src + (size_t)(k0 + w + 4 * i) * ldn + n0 + l * 4)); v[i] = make_float4(nv[0], nv[1], nv[2], nv[3]); }
#pragma unroll
  for (int i = 0; i < 16; ++i) {
    float* d = sm + (w + 4 * i) * 257 + l * 4;
    d[0] = v[i].x; d[1] = v[i].y; d[2] = v[i].z; d[3] = v[i].w;
  }
  __syncthreads();
  const int kq = t & 7;
#pragma unroll
  for (int j = 0; j < 8; ++j) {
    int n = (t >> 3) + 32 * j;
    const float* r = sm + (kq * 8) * 257 + n;
    uint4 o;
    o.x = pk_bf16(r[0], r[257]); o.y = pk_bf16(r[2 * 257], r[3 * 257]); o.z = pk_bf16(r[4 * 257], r[5 * 257]); o.w = pk_bf16(r[6 * 257], r[7 * 257]);
    const int kk = k0 + kq * 8;
    if (bstep) *(uint4*)(dst + (size_t)(kk >> 5) * bstep + (size_t)(n0 + n) * 32 + (kk & 31)) = o;
    else *(uint4*)(dst + (size_t)(n0 + n) * ldk + kk) = o;
  }
  __syncthreads();
}

__device__ __forceinline__ void phase_prep(const Params& p, char* sm) {
  const int t = tid_now();
  unsigned char* ws = p.ws;
  float* mod = (float*)(ws + WS_MOD);
  const int N_ADA = 384, N_TR = 1200, N_CK = 256;
  for (int idx = blockIdx.x; idx < N_ADA + N_TR + N_CK + 1; idx += gridDim.x) {
    if (idx < N_ADA) {
      int i = idx / 96, nb = idx % 96, n0 = nb * 32;
      float* sv = (float*)sm;
      float* red = (float*)(sm + 12288);
      for (int e = t; e < 3072; e += NTHREADS) {
        int k = e / 3, cd = e % 3;
        float cv = (cd == 0) ? p.in[7][k] : p.in[6][(cd - 1) * 1024 + k];
        sv[e] = silu(cv);
      }
      __syncthreads();
      const int kg = t >> 3, c4 = (t & 7) * 4;
      float a0[4] = {0, 0, 0, 0}, a1[4] = {0, 0, 0, 0}, a2[4] = {0, 0, 0, 0};
      const float* wp = p.in[9] + ((size_t)i * 1024 + kg * 32) * 3072 + n0 + c4;
#pragma unroll 16
      for (int kk = 0; kk < 32; ++kk) {
        const f32x4v nv = __builtin_nontemporal_load((const f32x4v*)(wp + (size_t)kk * 3072));
        float4 wv = make_float4(nv[0], nv[1], nv[2], nv[3]);
        const float* svp = sv + (kg * 32 + kk) * 3;
        float s0 = svp[0], s1 = svp[1], s2 = svp[2];
        a0[0] += s0 * wv.x; a0[1] += s0 * wv.y; a0[2] += s0 * wv.z; a0[3] += s0 * wv.w;
        a1[0] += s1 * wv.x; a1[1] += s1 * wv.y; a1[2] += s1 * wv.z; a1[3] += s1 * wv.w;
        a2[0] += s2 * wv.x; a2[1] += s2 * wv.y; a2[2] += s2 * wv.z; a2[3] += s2 * wv.w;
      }
#pragma unroll
      for (int e = 0; e < 4; ++e) { red[(kg * 3 + 0) * 32 + c4 + e] = a0[e]; red[(kg * 3 + 1) * 32 + c4 + e] = a1[e]; red[(kg * 3 + 2) * 32 + c4 + e] = a2[e]; }
      __syncthreads();
      if (t < 96) {
        int cd = t >> 5, col = t & 31;
        float sacc = p.in[10][(size_t)i * 3072 + n0 + col];
        for (int g = 0; g < 32; ++g) sacc += red[(g * 3 + cd) * 32 + col];
        mod[((size_t)i * 3 + cd) * 3072 + n0 + col] = sacc;
      }
      __syncthreads();
    } else if (idx < N_ADA + N_TR) {
      int q = idx - N_ADA;
      const float* src; u16* dst; size_t ldn, ldk; int tk, tn;
      bool q_is_cache = false;
      if (q < 320) { int j = q / 160, r = q % 160; src = p.in[11] + (size_t)j * 1024 * 2560; dst = (u16*)(ws + WS_WAI) + (size_t)j * 2560 * 1024; ldn = 2560; ldk = 1024; tk = r / 10; tn = r % 10; }
      else if (q < 448) { q -= 320; int j = q / 64, r = q % 64; src = p.in[12] + (size_t)j * 1024 * 1024; dst = (u16*)(ws + WS_WAO) + (size_t)j * 1024 * 1024; ldn = 1024; ldk = 1024; tk = r / 4; tn = r % 4; }
      else if (q < 576) { q -= 448; src = p.in[14]; dst = (u16*)(ws + WS_WPI); ldn = 2048; ldk = 1024; tk = q / 8; tn = q % 8; }
      else if (q < 592) { q -= 576; int g = q / 4, r = q % 4; src = p.in[15] + (size_t)g * 65536; dst = (u16*)(ws + WS_WPG) + (size_t)g * 65536; ldn = 256; ldk = 256; tk = r; tn = 0; }
      else if (q < 656) { q -= 592; src = p.in[17]; dst = (u16*)(ws + WS_WPO); ldn = 1024; ldk = 1024; tk = q / 4; tn = q % 4; }
      else if (q < 1040) { q -= 656; src = p.in[18]; dst = (u16*)(ws + WS_WRI); ldn = 6144; ldk = 1024; tk = q / 24; tn = q % 24; }
      else if (q < 1168) { q -= 1040; src = p.in[22]; dst = (u16*)(ws + WS_WRO); ldn = 1024; ldk = 2048; tk = q / 4; tn = q % 4; }
      else { q_is_cache = true; q -= 1168; int bj = q / 8, r = q % 8; src = p.in[3] + (size_t)bj * 512 * 256; dst = (u16*)(ws + WS_CVT) + (size_t)bj * 256 * 512; ldn = 256; ldk = 512; tk = r; tn = 0; }
      transpose_tile(src, ldn, dst, ldk, tk * 64, tn * 256, sm, q_is_cache ? 0 : ldn * 32);
    } else if (idx < N_ADA + N_TR + N_CK) {
      int q = idx - N_ADA - N_TR;
      size_t off = (size_t)q * 2048 + t * 8;
      float4 v0 = *(const float4*)(p.in[2] + off), v1 = *(const float4*)(p.in[2] + off + 4);
      *(uint4*)((u16*)(ws + WS_CK) + off) = make_uint4(pk_bf16(v0.x, v0.y), pk_bf16(v0.z, v0.w), pk_bf16(v1.x, v1.y), pk_bf16(v1.z, v1.w));
    } else {
      if (t < 16) {
        double r = 0.5623413251903491, th = 1.0;
        for (int i = 0; i < t; ++i) th *= r;
        double x2 = th * th, cs = 1.0, sn = th, tc = 1.0, ts = th;
        for (int i = 1; i < 14; ++i) { tc *= -x2 / ((2.0 * i - 1.0) * (2.0 * i)); ts *= -x2 / ((2.0 * i) * (2.0 * i + 1.0)); cs += tc; sn += ts; }
        double c = 1.0, s = 0.0;
        float* tab = (float*)(ws + WS_ROPE);
        for (int pos = 0; pos < 64; ++pos) {
          tab[(pos * 16 + t) * 2] = (float)c; tab[(pos * 16 + t) * 2 + 1] = (float)s;
          double c2 = c * cs - s * sn, s2 = s * cs + c * sn; c = c2; s = s2;
        }
      }
    }
  }
}

__device__ __forceinline__ void phase_norm(const Params& p, int layer, const float* xp, const float* xs) {
  const int t = tid_now(), lane = t & 63, w = t >> 6;
  u16* H = (u16*)(p.ws + WS_RF);
  const float* g = p.in[8] + (size_t)layer * 1024;
  for (int base = (blockIdx.x * 4 + w) * 4; base < 8192; base += gridDim.x * 16) {
    const float* x = base < 4096 ? xp + (size_t)base * 1024 : xs + (size_t)(base - 4096) * 1024;
    int cnd = base < 4096 ? 0 : 1 + ((base - 4096) >> 11);
    const float* md = (const float*)(p.ws + WS_MOD) + ((size_t)layer * 3 + cnd) * 3072;
    float4 v[4][4];
#pragma unroll
    for (int j = 0; j < 4; ++j)
#pragma unroll
      for (int i = 0; i < 4; ++i) v[j][i] = *(const float4*)(x + (size_t)j * 1024 + (i * 64 + lane) * 4);
    float rstd[4];
#pragma unroll
    for (int j = 0; j < 4; ++j) {
      float ss = 0.f;
#pragma unroll
      for (int i = 0; i < 4; ++i) ss += v[j][i].x * v[j][i].x + v[j][i].y * v[j][i].y + v[j][i].z * v[j][i].z + v[j][i].w * v[j][i].w;
#pragma unroll
      for (int o = 32; o > 0; o >>= 1) ss += __shfl_xor(ss, o);
      rstd[j] = rsqrtf(ss * (1.f / 1024.f) + 1e-6f);
    }
#pragma unroll
    for (int i = 0; i < 4; ++i) {
      int c = (i * 64 + lane) * 4;
      float4 gv = *(const float4*)(g + c), sh = *(const float4*)(md + c), sc = *(const float4*)(md + 1024 + c);
      float m0 = gv.x * (1.f + sc.x), m1 = gv.y * (1.f + sc.y), m2 = gv.z * (1.f + sc.z), m3 = gv.w * (1.f + sc.w);
#pragma unroll
      for (int j = 0; j < 4; ++j) {
        float h0 = v[j][i].x * rstd[j] * m0 + sh.x, h1 = v[j][i].y * rstd[j] * m1 + sh.y;
        float h2 = v[j][i].z * rstd[j] * m2 + sh.z, h3 = v[j][i].w * rstd[j] * m3 + sh.w;
        uint2 pk; pk.x = pk_bf16(h0, h1); pk.y = pk_bf16(h2, h3);
        *(uint2*)(H + (size_t)(c >> 5) * 262144 + (size_t)(base + j) * 32 + (c & 31)) = pk;
      }
    }
  }
}

__device__ __forceinline__ void phase_final_norm(const Params& p) {
  const int t = tid_now(), lane = t & 63, w = t >> 6;
  const float* g = p.in[23];
  for (int base = (blockIdx.x * 4 + w) * 4; base < 8192; base += gridDim.x * 16) {
    float* x = p.out + (size_t)base * 1024;
    float4 v[4][4];
#pragma unroll
    for (int j = 0; j < 4; ++j)
#pragma unroll
      for (int i = 0; i < 4; ++i) v[j][i] = *(const float4*)(x + (size_t)j * 1024 + (i * 64 + lane) * 4);
    float rstd[4];
#pragma unroll
    for (int j = 0; j < 4; ++j) {
      float ss = 0.f;
#pragma unroll
      for (int i = 0; i < 4; ++i) ss += v[j][i].x * v[j][i].x + v[j][i].y * v[j][i].y + v[j][i].z * v[j][i].z + v[j][i].w * v[j][i].w;
#pragma unroll
      for (int o = 32; o > 0; o >>= 1) ss += __shfl_xor(ss, o);
      rstd[j] = rsqrtf(ss * (1.f / 1024.f) + 1e-6f);
    }
#pragma unroll
    for (int i = 0; i < 4; ++i) {
      int c = (i * 64 + lane) * 4;
      float4 gv = *(const float4*)(g + c);
#pragma unroll
      for (int j = 0; j < 4; ++j) {
        float4 o; o.x = v[j][i].x * rstd[j] * gv.x; o.y = v[j][i].y * rstd[j] * gv.y; o.z = v[j][i].z * rstd[j] * gv.z; o.w = v[j][i].w * rstd[j] * gv.w;
        *(float4*)(x + (size_t)j * 1024 + c) = o;
      }
    }
  }
}

__device__ __forceinline__ void phase_outproj(const Params& p, int layer, const u16* Y, int K, const u16* Wt, const float* xp, const float* xs, char* sm) {
  WAVE_IDS;
  float* X = p.out;
  for (int idx = blockIdx.x; idx < 512; idx += gridDim.x) {
    int mt = idx & 63, nt = idx >> 6;
    f32x4 acc[4][4];
#pragma unroll
    for (int m = 0; m < 4; ++m)
#pragma unroll
      for (int n = 0; n < 4; ++n) acc[m][n] = (f32x4){0.f, 0.f, 0.f, 0.f};
    gemm_core_glds(Y + (size_t)mt * 128 * 32, 262144, Wt + (size_t)nt * 128 * 32, 1024 * 32, K, acc, sm);
    int row0 = mt * 128, col0 = nt * 128;
    int cnd = row0 < 4096 ? 0 : 1 + ((row0 - 4096) >> 11);
    const float* gate = (const float*)(p.ws + WS_MOD) + ((size_t)layer * 3 + cnd) * 3072 + 2048;
    const float* xres = row0 < 4096 ? xp + (size_t)row0 * 1024 : xs + (size_t)(row0 - 4096) * 1024;
    const int c4 = (t & 31) * 4, rb = t >> 5;
    const float4 g4 = *(const float4*)(gate + col0 + c4);
    float4 xv[16];
#pragma unroll
    for (int i = 0; i < 16; ++i) xv[i] = *(const float4*)(xres + (size_t)(rb + 8 * i) * 1024 + col0 + c4);
    float* cs = (float*)sm;
#pragma unroll
    for (int m = 0; m < 4; ++m) {
#pragma unroll
      for (int n = 0; n < 4; ++n)
#pragma unroll
        for (int r = 0; r < 4; ++r) cs[AROW(m, r) * 132 + ACOL(n)] = acc[m][n][r];
      __builtin_amdgcn_sched_barrier(0);
    }
    __syncthreads();
#pragma unroll
    for (int i = 0; i < 16; ++i) {
      const float4 a = *(const float4*)(cs + (rb + 8 * i) * 132 + c4);
      float4 o; o.x = xv[i].x + g4.x * a.x; o.y = xv[i].y + g4.y * a.y; o.z = xv[i].z + g4.z * a.z; o.w = xv[i].w + g4.w * a.w;
      *(float4*)(X + (size_t)(row0 + rb + 8 * i) * 1024 + col0 + c4) = o;
    }
    __syncthreads();
  }
}

__device__ __forceinline__ void attn_inproj_epi(const Params& p, int j, int mt, int nt, f32x4 (&acc)[4][4], char* sm) {
  WAVE_IDS;
  u16* Q = (u16*)(p.ws + WS_RA);
  u16* Kb = (u16*)(p.ws + WS_RB);
  u16* VTp = (u16*)(p.ws + WS_RD);
  u16* VTs = VTp + (size_t)16 * 256 * 256;
  u16* SZ = (u16*)(p.ws + WS_RE);
  const float* rope = (const float*)(p.ws + WS_ROPE);
  const int row0 = mt * 128;
  const bool sample = row0 >= 4096;
  if (nt < 10 && sample) {
#pragma unroll
    for (int m = 0; m < 4; ++m) {
      __builtin_amdgcn_sched_barrier(0);
#pragma unroll
      for (int r = 0; r < 4; ++r) {
        int tk = (row0 + AROW(m, r) - 4096) & 2047;
        int rp = tk >> 6, cp = tk & 63;
        float2 a = *(const float2*)(rope + (rp * 16 + fr) * 2), b = *(const float2*)(rope + (cp * 16 + fr) * 2);
        float x1r = acc[m][0][r], x2r = acc[m][1][r], x1c = acc[m][2][r], x2c = acc[m][3][r];
        acc[m][0][r] = x1r * a.x - x2r * a.y; acc[m][1][r] = x2r * a.x + x1r * a.y;
        acc[m][2][r] = x1c * b.x - x2c * b.y; acc[m][3][r] = x2c * b.x + x1c * b.y;
      }
    }
  }
  if (nt < 8) {
    epi_store_bf16(acc, sm, Q + (size_t)row0 * 1024 + nt * 128, 1024, IdF());
  } else if (nt < 10) {
    int c0 = (nt - 8) * 128;
    if (!sample) {
      int b = row0 >> 8, t0 = row0 & 255;
      float* dk = p.out + O_NK + ((size_t)(b * 2 + j) * 256 + t0) * 256 + c0;
#pragma unroll
      for (int m = 0; m < 4; ++m) {
        float* pm = opaque(dk + (size_t)AROW(m, 0) * 256 + ACOL(0));
#pragma unroll
        for (int n = 0; n < 4; ++n)
#pragma unroll
          for (int r = 0; r < 4; ++r) pm[r * 256 + n * 16] = acc[m][n][r];
        __builtin_amdgcn_sched_barrier(0);
      }
    }
    epi_store_bf16(acc, sm, Kb + (size_t)row0 * 256 + c0, 256, IdF());
  } else if (nt < 12) {
    int c0 = (nt - 10) * 128;
    if (!sample) {
      int b = row0 >> 8, t0 = row0 & 255;
      float* dv = p.out + O_NV + ((size_t)(b * 2 + j) * 256 + t0) * 256 + c0;
#pragma unroll
      for (int m = 0; m < 4; ++m) {
        float* pm = opaque(dv + (size_t)AROW(m, 0) * 256 + ACOL(0));
#pragma unroll
        for (int n = 0; n < 4; ++n)
#pragma unroll
          for (int r = 0; r < 4; ++r) pm[r * 256 + n * 16] = acc[m][n][r];
        __builtin_amdgcn_sched_barrier(0);
      }
      epi_store_bf16_T(acc, VTp + ((size_t)b * 256 + c0) * 256 + t0, 256, IdF());
    } else {
      int s = (row0 - 4096) >> 11, t0 = (row0 - 4096) & 2047;
      epi_store_bf16_T(acc, VTs + ((size_t)s * 256 + c0) * 2048 + t0, 2048, IdF());
    }
  } else {
    epi_store_bf16(acc, sm, SZ + (size_t)row0 * 1024 + (nt - 12) * 128, 1024, SiluF());
  }
}

__device__ __forceinline__ void phase_attn_inproj(const Params& p, int j, char* sm) {
  const u16* H = (const u16*)(p.ws + WS_RF);
  const u16* W = (const u16*)(p.ws + WS_WAI) + (size_t)j * 2560 * 1024;
  for (int idx = blockIdx.x; idx < 768; idx += gridDim.x) {
    if (idx < 512) {
      const int mt = idx & 63, nt2 = idx >> 6;
      f32x4 accL[4][4], accR[4][4];
#pragma unroll
      for (int m = 0; m < 4; ++m)
#pragma unroll
        for (int n = 0; n < 4; ++n) { accL[m][n] = (f32x4){0.f, 0.f, 0.f, 0.f}; accR[m][n] = (f32x4){0.f, 0.f, 0.f, 0.f}; }
      gemm_core_glds2(H + (size_t)mt * 128 * 32, 262144, W + (size_t)nt2 * 256 * 32, 2560 * 32, 1024, accL, accR, sm);
      attn_inproj_epi(p, j, mt, nt2 * 2, accL, sm);
      attn_inproj_epi(p, j, mt, nt2 * 2 + 1, accR, sm);
    } else {
      const int j2 = idx - 512, mt = j2 & 63, nt = 16 + (j2 >> 6);
      f32x4 acc[4][4];
#pragma unroll
      for (int m = 0; m < 4; ++m)
#pragma unroll
        for (int n = 0; n < 4; ++n) acc[m][n] = (f32x4){0.f, 0.f, 0.f, 0.f};
      gemm_core_glds(H + (size_t)mt * 128 * 32, 262144, W + (size_t)nt * 128 * 32, 2560 * 32, 1024, acc, sm);
      attn_inproj_epi(p, j, mt, nt, acc, sm);
    }
  }
}

__device__ __forceinline__ void attn_comp64_lds(const char* sk, const char* sv, const bf16x8 (&qf)[2][2], f32x4 (&oacc)[4][2],
                                                float (&mrun)[2], float (&lrun)[2], bool masked, int key0, int qbase, float sc2, int fr, int fq) {
  f32x4 s[4][2];
#pragma unroll
  for (int m = 0; m < 4; ++m) {
    const int krow = 32 * (m >> 1) + 8 * (fr >> 2) + 4 * (m & 1) + (fr & 3);
    bf16x8 k0 = *(const bf16x8*)(sk + lds_off(krow, fq * 8));
    bf16x8 k1 = *(const bf16x8*)(sk + lds_off(krow, 32 + fq * 8));
#pragma unroll
    for (int n = 0; n < 2; ++n) {
      s[m][n] = mfma16(k0, qf[n][0], (f32x4){0.f, 0.f, 0.f, 0.f});
      s[m][n] = mfma16(k1, qf[n][1], s[m][n]);
    }
  }
  if (masked) {
#pragma unroll
    for (int n = 0; n < 2; ++n)
#pragma unroll
      for (int m = 0; m < 4; ++m)
#pragma unroll
        for (int r = 0; r < 4; ++r) {
          int kpos = key0 + 32 * (m >> 1) + 8 * fq + 4 * (m & 1) + r, qpos = qbase + 16 * n + fr;
          int dd = qpos - kpos; dd = dd < 0 ? -dd : dd;
          s[m][n][r] = dd <= 128 ? s[m][n][r] : -1.0e30f;
        }
  }
#pragma unroll
  for (int n = 0; n < 2; ++n) {
    float mx = -3.0e38f;
#pragma unroll
    for (int m = 0; m < 4; ++m)
#pragma unroll
      for (int r = 0; r < 4; ++r) { float v = s[m][n][r] * sc2; s[m][n][r] = v; mx = fmaxf(mx, v); }
    mx = fmaxf(mx, __shfl_xor(mx, 16));
    mx = fmaxf(mx, __shfl_xor(mx, 32));
    float mnew = fmaxf(mrun[n], mx);
    float alpha = fexp2(mrun[n] - mnew);
    mrun[n] = mnew;
    float ls = 0.f;
#pragma unroll
    for (int m = 0; m < 4; ++m)
#pragma unroll
      for (int r = 0; r < 4; ++r) { float pv = fexp2(s[m][n][r] - mnew); s[m][n][r] = pv; ls += pv; }
    lrun[n] = lrun[n] * alpha + ls;
#pragma unroll
    for (int dt = 0; dt < 4; ++dt) oacc[dt][n] *= alpha;
  }
#pragma unroll
  for (int s2 = 0; s2 < 2; ++s2) {
    bf16x8 vf[4];
#pragma unroll
    for (int dt = 0; dt < 4; ++dt) vf[dt] = *(const bf16x8*)(sv + lds_off(dt * 16 + fr, s2 * 32 + fq * 8));
#pragma unroll
    for (int n = 0; n < 2; ++n) {
      union { bf16x8 v; unsigned u[4]; } pf;
      pf.u[0] = pk_bf16(s[2 * s2][n][0], s[2 * s2][n][1]); pf.u[1] = pk_bf16(s[2 * s2][n][2], s[2 * s2][n][3]);
      pf.u[2] = pk_bf16(s[2 * s2 + 1][n][0], s[2 * s2 + 1][n][1]); pf.u[3] = pk_bf16(s[2 * s2 + 1][n][2], s[2 * s2 + 1][n][3]);
#pragma unroll
      for (int dt = 0; dt < 4; ++dt) oacc[dt][n] = mfma16(vf[dt], pf.v, oacc[dt][n]);
    }
  }
}

__device__ __forceinline__ void phase_attn(const Params& p, int j, char* sm) {
  const int t = tid_now(), lane = t & 63, w = t >> 6, fr = lane & 15, fq = lane >> 4;
  const u16* Q = (const u16*)(p.ws + WS_RA);
  const u16* Kb = (const u16*)(p.ws + WS_RB);
  const u16* VTp = (const u16*)(p.ws + WS_RD);
  const u16* VTs = VTp + (size_t)16 * 256 * 256;
  const u16* SZ = (const u16*)(p.ws + WS_RE);
  const u16* cK = (const u16*)(p.ws + WS_CK);
  const u16* cVT = (const u16*)(p.ws + WS_CVT);
  u16* Y = (u16*)(p.ws + WS_RC);
  const float sc2 = 0.125f * LOG2E;
  const int lrow = t >> 3, lcol = (t & 7) * 8;
  for (int idx = blockIdx.x; idx < 1024; idx += gridDim.x) {
    const bool sample = idx < 512;
    int hq, qb, rowbase, sb;
    if (sample) { sb = idx >> 8; hq = (idx >> 4) & 15; qb = idx & 15; rowbase = 4096 + sb * 2048; }
    else { int ii = idx - 512; sb = ii >> 5; hq = (ii >> 1) & 15; qb = ii & 1; rowbase = sb * 256; }
    const int kvh = hq >> 2;
    const int Q0 = qb * 128, q0 = Q0 + w * 32;
    bf16x8 qf[2][2];
#pragma unroll
    for (int n = 0; n < 2; ++n)
#pragma unroll
      for (int ks = 0; ks < 2; ++ks) qf[n][ks] = *(const bf16x8*)(Q + (size_t)(rowbase + q0 + 16 * n + fr) * 1024 + hq * 64 + ks * 32 + fq * 8);
    f32x4 oacc[4][2];
#pragma unroll
    for (int dt = 0; dt < 4; ++dt)
#pragma unroll
      for (int n = 0; n < 2; ++n) oacc[dt][n] = (f32x4){0.f, 0.f, 0.f, 0.f};
    const float sink2 = p.in[13][j * 16 + hq] * LOG2E;
    float mrun[2] = {sink2, sink2}, lrun[2] = {0.f, 0.f};
    const u16 *K1, *V1, *K2, *V2;
    size_t ldv1, ldv2 = 2048;
    int n1, n2 = 0, lo = 0;
    if (sample) {
      K1 = cK + ((size_t)(sb * 2 + j) * 512) * 256 + kvh * 64;
      V1 = cVT + ((size_t)(sb * 2 + j) * 256 + kvh * 64) * 512; ldv1 = 512; n1 = 8;
      K2 = Kb + (size_t)rowbase * 256 + kvh * 64;
      V2 = VTs + ((size_t)sb * 256 + kvh * 64) * 2048;
      lo = Q0 - 128; lo = lo < 0 ? 0 : lo;
      int hi = Q0 + 256; hi = hi > 2048 ? 2048 : hi;
      n2 = (hi - lo) >> 6;
    } else {
      K1 = Kb + (size_t)rowbase * 256 + kvh * 64;
      V1 = VTp + ((size_t)sb * 256 + kvh * 64) * 256; ldv1 = 256; n1 = 4;
      K2 = K1; V2 = V1;
    }
    const int total = n1 + n2;
    u32x4 rk[2], rv[2];
#define AT_GLOAD(i) do { const u16* _kp; const u16* _vp; size_t _ldv; \
      if ((i) < n1) { _kp = K1 + (size_t)(i) * 64 * 256; _vp = V1 + (i) * 64; _ldv = ldv1; } \
      else { int _k0 = lo + ((i) - n1) * 64; _kp = K2 + (size_t)_k0 * 256; _vp = V2 + _k0; _ldv = ldv2; } \
      _Pragma("unroll") for (int _i = 0; _i < 2; ++_i) { \
        rk[_i] = *(const u32x4*)(_kp + (size_t)(lrow + 32 * _i) * 256 + lcol); \
        rv[_i] = *(const u32x4*)(_vp + (size_t)(lrow + 32 * _i) * _ldv + lcol); } } while (0)
#define AT_LSTORE(buf) do { _Pragma("unroll") for (int _i = 0; _i < 2; ++_i) { \
        *(u32x4*)(sm + (buf) * 16384 + lds_off(lrow + 32 * _i, lcol)) = rk[_i]; \
        *(u32x4*)(sm + (buf) * 16384 + 8192 + lds_off(lrow + 32 * _i, lcol)) = rv[_i]; } } while (0)
    AT_GLOAD(0);
    AT_LSTORE(0);
    __syncthreads();
    for (int i = 0; i < total; ++i) {
      const int cur = i & 1;
      if (i + 1 < total) AT_GLOAD(i + 1);
      const bool masked = i >= n1;
      const int key0 = lo + (i - n1) * 64;
      const bool skip = masked && (key0 + 63 < q0 - 128 || key0 > q0 + 31 + 128);
      if (!skip) attn_comp64_lds(sm + cur * 16384, sm + cur * 16384 + 8192, qf, oacc, mrun, lrun, masked, key0, q0, sc2, fr, fq);
      if (i + 1 < total) AT_LSTORE(cur ^ 1);
      __syncthreads();
    }
#undef AT_GLOAD
#undef AT_LSTORE
#pragma unroll
    for (int n = 0; n < 2; ++n) {
      float lt = lrun[n];
      lt += __shfl_xor(lt, 16);
      lt += __shfl_xor(lt, 32);
      float inv = 1.f / (lt + fexp2(sink2 - mrun[n]));
      size_t row = (size_t)(rowbase + q0 + 16 * n + fr);
#pragma unroll
      for (int dt = 0; dt < 4; ++dt) {
        int d0 = hq * 64 + dt * 16 + 4 * fq;
        uint2 zz = *(const uint2*)(SZ + row * 1024 + d0);
        uint2 o;
        o.x = pk_bf16(oacc[dt][n][0] * inv * bflo(zz.x), oacc[dt][n][1] * inv * bfhi(zz.x));
        o.y = pk_bf16(oacc[dt][n][2] * inv * bflo(zz.y), oacc[dt][n][3] * inv * bfhi(zz.y));
        *(uint2*)(Y + (size_t)(d0 >> 5) * 262144 + row * 32 + (d0 & 31)) = o;
      }
    }
  }
}

__device__ __forceinline__ void phase_pool_inproj(const Params& p, char* sm) {
  const u16* H = (const u16*)(p.ws + WS_RF);
  const u16* W = (const u16*)(p.ws + WS_WPI);
  u16* U = (u16*)(p.ws + WS_RD);
  u16* SZ = (u16*)(p.ws + WS_RE);
  for (int idx = blockIdx.x; idx < 64 * 8; idx += gridDim.x) {
    int mt = idx & 63, nt2 = idx >> 6;
    f32x4 accL[4][4], accR[4][4];
#pragma unroll
    for (int m = 0; m < 4; ++m)
#pragma unroll
      for (int n = 0; n < 4; ++n) { accL[m][n] = (f32x4){0.f, 0.f, 0.f, 0.f}; accR[m][n] = (f32x4){0.f, 0.f, 0.f, 0.f}; }
    gemm_core_glds2(H + (size_t)mt * 128 * 32, 262144, W + (size_t)nt2 * 256 * 32, 2048 * 32, 1024, accL, accR, sm);
    if (nt2 < 4) {
      epi_store_bf16(accL, sm, U + (size_t)mt * 128 * 1024 + nt2 * 256, 1024, IdF());
      epi_store_bf16(accR, sm, U + (size_t)mt * 128 * 1024 + nt2 * 256 + 128, 1024, IdF());
    } else {
      epi_store_bf16(accL, sm, SZ + (size_t)mt * 128 * 1024 + (nt2 - 4) * 256, 1024, SiluF());
      epi_store_bf16(accR, sm, SZ + (size_t)mt * 128 * 1024 + (nt2 - 4) * 256 + 128, 1024, SiluF());
    }
  }
}

struct PoolEpiF {
  const float* scale;
  __device__ __forceinline__ float operator()(int r, int c, float v) const { return v * scale[c]; }
};
template <int W>
__device__ __forceinline__ void pool_d_strip(const u16* __restrict__ uc, u16* __restrict__ dc, int t0, int L) {
  constexpr int LEFT = W / 2, RIGHT = W - 1 - LEFT;
  float pre[49];
  pre[0] = 0.f;
  float ctr[32];
#pragma unroll
  for (int k = 0; k < 48; ++k) {
    int pos = t0 - 8 + k;
    float v = 0.f;
    if (k >= 8 - LEFT && k < 40 + RIGHT) {
      int pc = pos < 0 ? 0 : (pos >= L ? L - 1 : pos);
      float lv = bf2f(uc[(ptrdiff_t)(pc - t0) * 1024]);
      v = (pos >= 0 && pos < L) ? lv : 0.f;
    }
    pre[k + 1] = pre[k] + v;
    if (k >= 8 && k < 40) ctr[k - 8] = v;
  }
#pragma unroll
  for (int i = 0; i < 32; ++i) {
    int pos = t0 + i;
    int lo = pos - LEFT; lo = lo < 0 ? 0 : lo;
    int hi = pos + RIGHT + 1; hi = hi > L ? L : hi;
    float sum = pre[i + 8 + RIGHT + 1] - pre[i + 8 - LEFT];
    dc[(size_t)i * 32] = f2bf(sum / (float)(hi - lo) - ctr[i]);
  }
}
__device__ __forceinline__ void phase_pool_d(const Params& p) {
  const int t = tid_now();
  const u16* U = (const u16*)(p.ws + WS_RD);
  u16* Dm = (u16*)(p.ws + WS_RD + 16 * MiB);
  for (int idx = blockIdx.x; idx < 1024; idx += gridDim.x) {
    const int g = idx & 3, strip = idx >> 2;
    const int row0 = strip * 32;
    int L, t0;
    if (row0 < 4096) { L = 256; t0 = row0 & 255; } else { L = 2048; t0 = (row0 - 4096) & 2047; }
    const u16* uc = U + (size_t)row0 * 1024 + g * 256 + t;
    const int dcol = g * 256 + t;
    u16* dc = Dm + (size_t)(dcol >> 5) * 262144 + (size_t)row0 * 32 + (dcol & 31);
    if (g == 0) pool_d_strip<2>(uc, dc, t0, L);
    else if (g == 1) pool_d_strip<4>(uc, dc, t0, L);
    else if (g == 2) pool_d_strip<8>(uc, dc, t0, L);
    else pool_d_strip<16>(uc, dc, t0, L);
  }
}
__device__ __forceinline__ void phase_pool_gemm(const Params& p, char* sm) {
  const u16* Dm = (const u16*)(p.ws + WS_RD + 16 * MiB);
  const u16* SZ = (const u16*)(p.ws + WS_RE);
  u16* Y = (u16*)(p.ws + WS_RC);
  const u16* Wg = (const u16*)(p.ws + WS_WPG);
  for (int idx = blockIdx.x; idx < 512; idx += gridDim.x) {
    const int mt = idx & 63, gn = idx >> 6, g = gn >> 1, n2 = gn & 1;
    const int row0 = mt * 128;
    f32x4 acc[4][4];
#pragma unroll
    for (int m = 0; m < 4; ++m)
#pragma unroll
      for (int n = 0; n < 4; ++n) acc[m][n] = (f32x4){0.f, 0.f, 0.f, 0.f};
    gemm_core_glds(Dm + (size_t)(g * 8) * 262144 + (size_t)row0 * 32, 262144, Wg + (size_t)g * 65536 + (size_t)n2 * 128 * 32, 256 * 32, 256, acc, sm);
    int c0 = g * 256 + n2 * 128;
    PoolEpiF f{p.in[16] + c0};
    epi_store_bf16_img(acc, sm, Y, row0, c0, f, SZ + (size_t)row0 * 1024 + c0, 1024);
  }
}

__device__ __forceinline__ void phase_ret_inproj(const Params& p, char* sm) {
  const u16* H = (const u16*)(p.ws + WS_RF);
  const u16* W = (const u16*)(p.ws + WS_WRI);
  u16* Q = (u16*)(p.ws + WS_RA);
  u16* Kb = (u16*)(p.ws + WS_RB);
  u16* KTp = (u16*)(p.ws + WS_RC);
  u16* KTs = KTp + (size_t)16 * 1024 * 256;
  u16* VTp = (u16*)(p.ws + WS_RD);
  u16* VTs = VTp + (size_t)16 * 2048 * 256;
  u16* SZ = (u16*)(p.ws + WS_RE);
  for (int idx = blockIdx.x; idx < 64 * 24; idx += gridDim.x) {
    int mt = idx & 63, nt2 = idx >> 6;
    f32x4 accL[4][4], accR[4][4];
#pragma unroll
    for (int m = 0; m < 4; ++m)
#pragma unroll
      for (int n = 0; n < 4; ++n) { accL[m][n] = (f32x4){0.f, 0.f, 0.f, 0.f}; accR[m][n] = (f32x4){0.f, 0.f, 0.f, 0.f}; }
    gemm_core_glds2(H + (size_t)mt * 128 * 32, 262144, W + (size_t)nt2 * 256 * 32, 6144 * 32, 1024, accL, accR, sm);
    const int row0 = mt * 128;
    const bool sample = row0 >= 4096;
    int sb, t0;
    if (!sample) { sb = row0 >> 8; t0 = row0 & 255; } else { sb = (row0 - 4096) >> 11; t0 = (row0 - 4096) & 2047; }
#pragma unroll
    for (int half = 0; half < 2; ++half) {
    f32x4 (&acc)[4][4] = half ? accR : accL;
    const int nt = nt2 * 2 + half;
    if (nt < 8) {
      epi_store_bf16_img(acc, sm, Q, row0, nt * 128, IdF());
    } else if (nt < 16) {
      int c0 = (nt - 8) * 128;
      ScaleF f{0.0625f};
      if (!sample) epi_store_bf16_T(acc, KTp + ((size_t)sb * 1024 + c0) * 256 + t0, 256, f);
      else epi_store_bf16_T(acc, KTs + ((size_t)sb * 1024 + c0) * 2048 + t0, 2048, f);
      epi_store_bf16_img(acc, sm, Kb, row0, c0, f);
    } else if (nt < 32) {
      int c0 = (nt - 16) * 128;
      if (!sample) epi_store_bf16_T(acc, VTp + ((size_t)sb * 2048 + c0) * 256 + t0, 256, IdF());
      else epi_store_bf16_T(acc, VTs + ((size_t)sb * 2048 + c0) * 2048 + t0, 2048, IdF());
    } else {
      epi_store_bf16_img(acc, sm, SZ, row0, (nt - 32) * 128, SiluF());
    }
    }
  }
}

__device__ __forceinline__ void scan_sample64(const Params& p, int ii, char* sm) {
  const int t = tid_now(), lane = t & 63, w = t >> 6, wm = w >> 1, wn = w & 1, fr = lane & 15, fq = lane >> 4;
  const int xl = ii & 7, rest = ii >> 3;
  const int h = xl & 3, sb = xl >> 2, et8 = rest & 7, dt4 = (rest >> 3) & 3, dir = rest >> 5;
  const u16* KTs = (const u16*)(p.ws + WS_RC) + (size_t)16 * 1024 * 256;
  const u16* VTs = (const u16*)(p.ws + WS_RD) + (size_t)16 * 2048 * 256;
  u16* SNAP = (u16*)(p.ws + WS_RF);
  const float lg2 = logsig2((dir ? p.in[20] : p.in[19])[h]);
  const float cdec = fexp2(128.f * lg2);
  const int lrow = t >> 4, kc = t & 15;
  const u16* Ap = KTs + ((size_t)sb * 1024 + h * 256 + dt4 * 64 + lrow) * 2048 + kc * 8;
  const u16* Bp = VTs + ((size_t)sb * 2048 + h * 512 + et8 * 64 + lrow) * 2048 + kc * 8;
  const int ldst = (kc >> 3) * 8192 + lds_off(lrow, (kc & 7) * 8);
  float fs[8];
#pragma unroll
  for (int e = 0; e < 8; ++e) { int jj = kc * 8 + e; fs[e] = fexp2((float)(dir ? jj : 127 - jj) * lg2); }
  f32x4 acc[2][2];
  {
    const float* st = (dir ? p.in[5] : p.in[4]) + ((size_t)(sb * 4 + h) * 256 + dt4 * 64 + wm * 32) * 512 + et8 * 64 + wn * 32;
#pragma unroll
    for (int m = 0; m < 2; ++m)
#pragma unroll
      for (int n = 0; n < 2; ++n)
#pragma unroll
        for (int r = 0; r < 4; ++r) acc[m][n][r] = st[(size_t)(m * 16 + fq * 4 + r) * 512 + n * 16 + fr];
  }
  u32x4 raA[4], rbA[4], raB[4], rbB[4];
#define S6_GLOAD(cc, RA, RB) do { const size_t _o = (size_t)((dir ? 15 - (cc) : (cc)) * 128); _Pragma("unroll") for (int i = 0; i < 4; ++i) { \
    RA[i] = *(const u32x4*)(Ap + (size_t)(16 * i) * 2048 + _o); RB[i] = *(const u32x4*)(Bp + (size_t)(16 * i) * 2048 + _o); } } while (0)
#define S6_LSTORE(buf, RA, RB) do { _Pragma("unroll") for (int i = 0; i < 4; ++i) { u32x4 _v = RA[i], _o; \
    _o[0] = pk_bf16(bflo(_v[0]) * fs[0], bfhi(_v[0]) * fs[1]); _o[1] = pk_bf16(bflo(_v[1]) * fs[2], bfhi(_v[1]) * fs[3]); \
    _o[2] = pk_bf16(bflo(_v[2]) * fs[4], bfhi(_v[2]) * fs[5]); _o[3] = pk_bf16(bflo(_v[3]) * fs[6], bfhi(_v[3]) * fs[7]); \
    *(u32x4*)(sm + (buf) * 32768 + ldst + i * 2048) = _o; *(u32x4*)(sm + (buf) * 32768 + 16384 + ldst + i * 2048) = RB[i]; } } while (0)
#define S6_STEP(cc, RA, RB) do { \
    const int cur = (cc) & 1; \
    { const int c = dir ? 15 - (cc) : (cc); \
      u16* sp = SNAP + (size_t)(((sb * 16 + c) * 4 + h) * 2 + dir) * 131072 + (size_t)(dt4 * 2 + wm) * 16384 + (size_t)(et8 * 64 + wn * 32 + fr) * 32 + fq * 4; \
      _Pragma("unroll") for (int m = 0; m < 2; ++m) _Pragma("unroll") for (int n = 0; n < 2; ++n) { \
          uint2 pk; pk.x = pk_bf16(acc[m][n][0], acc[m][n][1]); pk.y = pk_bf16(acc[m][n][2], acc[m][n][3]); \
          *(uint2*)(sp + (size_t)(n * 16) * 32 + m * 16) = pk; acc[m][n] *= cdec; } } \
    const char* sa = sm + cur * 32768; const char* sb2 = sa + 16384; \
    _Pragma("unroll") for (int kh = 0; kh < 2; ++kh) _Pragma("unroll") for (int ks = 0; ks < 2; ++ks) { \
        bf16x8 a[2], b[2]; \
        _Pragma("unroll") for (int m = 0; m < 2; ++m) a[m] = *(const bf16x8*)(sa + kh * 8192 + lds_off(wm * 32 + m * 16 + fr, ks * 32 + fq * 8)); \
        _Pragma("unroll") for (int n = 0; n < 2; ++n) b[n] = *(const bf16x8*)(sb2 + kh * 8192 + lds_off(wn * 32 + n * 16 + fr, ks * 32 + fq * 8)); \
        _Pragma("unroll") for (int m = 0; m < 2; ++m) _Pragma("unroll") for (int n = 0; n < 2; ++n) acc[m][n] = mfma16(a[m], b[n], acc[m][n]); } \
    if ((cc) + 1 < 15) { S6_LSTORE(cur ^ 1, RA, RB); if ((cc) + 3 < 15) S6_GLOAD((cc) + 3, RA, RB); } \
    __syncthreads(); } while (0)
  S6_GLOAD(0, raA, rbA);
  S6_LSTORE(0, raA, rbA);
  __syncthreads();
  S6_GLOAD(1, raA, rbA);
  S6_GLOAD(2, raB, rbB);
  for (int cc = 0; cc < 15; cc += 2) {
    S6_STEP(cc, raA, rbA);
    if (cc + 1 < 15) S6_STEP(cc + 1, raB, rbB);
  }
#undef S6_STEP
#undef S6_GLOAD
#undef S6_LSTORE
  {
    const int c = dir ? 0 : 15;
    u16* sp = SNAP + (size_t)(((sb * 16 + c) * 4 + h) * 2 + dir) * 131072 + (size_t)(dt4 * 2 + wm) * 16384 + (size_t)(et8 * 64 + wn * 32 + fr) * 32 + fq * 4;
#pragma unroll
    for (int m = 0; m < 2; ++m)
#pragma unroll
      for (int n = 0; n < 2; ++n) {
        uint2 pk; pk.x = pk_bf16(acc[m][n][0], acc[m][n][1]); pk.y = pk_bf16(acc[m][n][2], acc[m][n][3]);
        *(uint2*)(sp + (size_t)(n * 16) * 32 + m * 16) = pk;
      }
  }
}

__device__ __forceinline__ void phase_ret_scan(const Params& p, char* sm) {
  WAVE_IDS;
  const u16* KTp = (const u16*)(p.ws + WS_RC);
  const u16* KTs = KTp + (size_t)16 * 1024 * 256;
  const u16* VTp = (const u16*)(p.ws + WS_RD);
  const u16* VTs = VTp + (size_t)16 * 2048 * 256;
  u16* SNAP = (u16*)(p.ws + WS_RF);
  const int lr = t >> 3, lc = (t & 7) * 8;
  for (int idx = blockIdx.x; idx < 512; idx += gridDim.x) scan_sample64(p, idx, sm);
  for (int idx = 512 + (blockIdx.x + gridDim.x - (512 % gridDim.x)) % gridDim.x; idx < 512 + 1024; idx += gridDim.x) {
    const bool sample = false;
    int ii = idx - 512;
    const int xl = ii & 7, rest = ii >> 3;
    const int h = xl & 3, et = rest & 3, dt = (rest >> 2) & 1, dir = (rest >> 3) & 1, sb = (rest >> 4) * 2 + (xl >> 2);
    const float lg2 = logsig2((dir ? p.in[20] : p.in[19])[h]);
    const float cdec = fexp2(128.f * lg2);
    const int nch = sample ? 16 : 2;
    const int nacc = sample ? 15 : 2;
    const size_t ld = sample ? 2048 : 256;
    const u16* Ab = sample ? KTs + ((size_t)sb * 1024 + h * 256 + dt * 128) * 2048 : KTp + ((size_t)sb * 1024 + h * 256 + dt * 128) * 256;
    const u16* Bb = sample ? VTs + ((size_t)sb * 2048 + h * 512 + et * 128) * 2048 : VTp + ((size_t)sb * 2048 + h * 512 + et * 128) * 256;
    const u16* Ap = Ab + (size_t)lr * ld + lc;
    const u16* Bp = Bb + (size_t)lr * ld + lc;
    f32x4 acc[4][4];
#pragma unroll
    for (int m = 0; m < 4; ++m)
#pragma unroll
      for (int n = 0; n < 4; ++n) acc[m][n] = (f32x4){0.f, 0.f, 0.f, 0.f};
    if (sample) {
      const float* st = (dir ? p.in[5] : p.in[4]) + ((size_t)(sb * 4 + h) * 256 + dt * 128) * 512 + et * 128;
#pragma unroll
      for (int m = 0; m < 4; ++m) {
#pragma unroll
        for (int hh = 0; hh < 2; ++hh) {
          const float* pm = opaque(st + (size_t)AROW(m, 2 * hh) * 512 + ACOL(0));
#pragma unroll
          for (int n = 0; n < 4; ++n)
#pragma unroll
            for (int r = 0; r < 2; ++r) acc[m][n][2 * hh + r] = pm[r * 512 + n * 16];
        }
        __builtin_amdgcn_sched_barrier(0);
      }
    }
    float fs0[8];
#pragma unroll
    for (int e = 0; e < 8; ++e) {
      int j0 = lc + e;
      fs0[e] = fexp2((float)(dir ? j0 : 127 - j0) * lg2);
    }
    const float c64 = fexp2((dir ? 64.f : -64.f) * lg2);
    u32x4 ra[4], rb[4];
    const int nq = nacc * 2;
#define SC_TOK(q) ((size_t)((dir ? nch - 1 - ((q) >> 1) : ((q) >> 1)) * 128 + ((q) & 1) * 64))
#define SC_GLOAD(q) do { const size_t _o = SC_TOK(q); _Pragma("unroll") for (int i = 0; i < 4; ++i) { ra[i] = *(const u32x4*)(Ap + (size_t)(32 * i) * ld + _o); rb[i] = *(const u32x4*)(Bp + (size_t)(32 * i) * ld + _o); } } while (0)
#define SC_LSTORE(buf, q) do { \
    const float _cm = ((q) & 1) ? c64 : 1.f; \
    const float g0 = fs0[0] * _cm, g1 = fs0[1] * _cm, g2 = fs0[2] * _cm, g3 = fs0[3] * _cm; \
    const float g4 = fs0[4] * _cm, g5 = fs0[5] * _cm, g6 = fs0[6] * _cm, g7 = fs0[7] * _cm; \
    _Pragma("unroll") for (int i = 0; i < 4; ++i) { \
      u32x4 _v = ra[i]; u32x4 _o; \
      _o[0] = pk_bf16(bflo(_v[0]) * g0, bfhi(_v[0]) * g1); _o[1] = pk_bf16(bflo(_v[1]) * g2, bfhi(_v[1]) * g3); \
      _o[2] = pk_bf16(bflo(_v[2]) * g4, bfhi(_v[2]) * g5); _o[3] = pk_bf16(bflo(_v[3]) * g6, bfhi(_v[3]) * g7); ra[i] = _o; } \
    _Pragma("unroll") for (int i = 0; i < 4; ++i) { *(u32x4*)(sm + (buf) * 32768 + lds_off(lr + 32 * i, lc)) = ra[i]; *(u32x4*)(sm + (buf) * 32768 + 16384 + lds_off(lr + 32 * i, lc)) = rb[i]; } } while (0)
    SC_GLOAD(0);
    SC_LSTORE(0, 0);
    __syncthreads();
    for (int q = 0; q < nq; ++q) {
      const int cur = q & 1;
      if (q + 1 < nq) SC_GLOAD(q + 1);
      if ((q & 1) == 0) {
        const int cc = q >> 1, c = dir ? nch - 1 - cc : cc;
        if (sample || cc == 1) {
          int slot = sample ? ((sb * 16 + c) * 4 + h) * 2 + dir : 256 + (sb * 4 + h) * 2 + dir;
          u16* sp = SNAP + (size_t)slot * 131072;
#pragma unroll
          for (int m = 0; m < 4; ++m)
#pragma unroll
            for (int n = 0; n < 4; ++n) {
              const int dd = dt * 128 + AROW(m, 0), ee = et * 128 + ACOL(n);
              uint2 pk; pk.x = pk_bf16(acc[m][n][0], acc[m][n][1]); pk.y = pk_bf16(acc[m][n][2], acc[m][n][3]);
              *(uint2*)(sp + (size_t)(dd >> 5) * 16384 + (size_t)ee * 32 + (dd & 31)) = pk;
            }
        }
#pragma unroll
        for (int m = 0; m < 4; ++m)
#pragma unroll
          for (int n = 0; n < 4; ++n) acc[m][n] *= cdec;
      }
      const char* sa = sm + cur * 32768;
      const char* sb2 = sa + 16384;
#pragma unroll
      for (int ks = 0; ks < 2; ++ks) {
        bf16x8 a[4], b[4];
#pragma unroll
        for (int m = 0; m < 4; ++m) a[m] = *(const bf16x8*)(sa + lds_off(wm * 64 + m * 16 + fr, ks * 32 + fq * 8));
#pragma unroll
        for (int n = 0; n < 4; ++n) b[n] = *(const bf16x8*)(sb2 + lds_off(wn * 64 + n * 16 + fr, ks * 32 + fq * 8));
#pragma unroll
        for (int m = 0; m < 4; ++m)
#pragma unroll
          for (int n = 0; n < 4; ++n) acc[m][n] = mfma16(a[m], b[n], acc[m][n]);
      }
      if (q + 1 < nq) SC_LSTORE(cur ^ 1, q + 1);
      __syncthreads();
    }
#undef SC_TOK
#undef SC_GLOAD
#undef SC_LSTORE
    if (sample) {
      const int c = dir ? 0 : 15;
      u16* sp = SNAP + (size_t)(((sb * 16 + c) * 4 + h) * 2 + dir) * 131072 + (size_t)(et * 128) * 256 + dt * 128;
      epi_store_bf16_T(acc, sp, 256, IdF());
    } else {
      float* so = p.out + (dir ? O_SB : O_SF) + ((size_t)(sb * 4 + h) * 256 + dt * 128) * 512 + et * 128;
#pragma unroll
      for (int m = 0; m < 4; ++m) {
#pragma unroll
        for (int hh = 0; hh < 2; ++hh) {
          float* pm = opaque(so + (size_t)AROW(m, 2 * hh) * 512 + ACOL(0));
#pragma unroll
          for (int n = 0; n < 4; ++n)
#pragma unroll
            for (int r = 0; r < 2; ++r) pm[r * 512 + n * 16] = acc[m][n][2 * hh + r];
        }
        __builtin_amdgcn_sched_barrier(0);
      }
    }
  }
}

template <int J>
__device__ __forceinline__ void ret_ring_step(int ks, const u16* Ap, const u16* Bp, char* sm, unsigned aA, unsigned aB, int t, f32x4 (&a2)[4][8]) {
  asm volatile("s_waitcnt vmcnt(0)" ::: "memory");
  __builtin_amdgcn_s_barrier();
  if (ks + 1 < 8) {
    char* d = sm + (J ^ 1) * 36864 + t * 16;
    const int ko = (ks + 1) * 32;
    __builtin_amdgcn_global_load_lds((const unsigned*)(Ap + (size_t)(ks + 1) * 262144), (unsigned*)d, 16, 0, 0);
    const u16* bp = opaque(Bp + (size_t)(ks + 1) * 16384);
#pragma unroll
    for (int i = 0; i < 8; ++i) {
      __builtin_amdgcn_global_load_lds((const unsigned*)bp, (unsigned*)(d + 4096 + i * 4096), 16, 0, 0);
      bp = opaque(bp + 64 * 32);
    }
  }
  bf16x8 a0, a1, a2f, a3, b0, b1, b2, b3, b4, b5, b6, b7;
  asm volatile(
      "ds_read_b128 %0, %12 offset:%14\n\t"
      "ds_read_b128 %4, %13 offset:%18\n\t"
      "ds_read_b128 %5, %13 offset:%19\n\t"
      "ds_read_b128 %1, %12 offset:%15\n\t"
      "ds_read_b128 %6, %13 offset:%20\n\t"
      "ds_read_b128 %7, %13 offset:%21\n\t"
      "ds_read_b128 %2, %12 offset:%16\n\t"
      "ds_read_b128 %8, %13 offset:%22\n\t"
      "ds_read_b128 %9, %13 offset:%23\n\t"
      "ds_read_b128 %3, %12 offset:%17\n\t"
      "ds_read_b128 %10, %13 offset:%24\n\t"
      "ds_read_b128 %11, %13 offset:%25\n\t"
      "s_waitcnt lgkmcnt(0)"
      : "=&v"(a0), "=&v"(a1), "=&v"(a2f), "=&v"(a3), "=&v"(b0), "=&v"(b1), "=&v"(b2), "=&v"(b3), "=&v"(b4), "=&v"(b5), "=&v"(b6), "=&v"(b7)
      : "v"(aA), "v"(aB), "n"(J * 36864), "n"(J * 36864 + 1024), "n"(J * 36864 + 2048), "n"(J * 36864 + 3072),
        "n"(J * 36864), "n"(J * 36864 + 1024), "n"(J * 36864 + 2048), "n"(J * 36864 + 3072),
        "n"(J * 36864 + 4096), "n"(J * 36864 + 5120), "n"(J * 36864 + 6144), "n"(J * 36864 + 7168)
      : "memory");
#define RR_ROW(m, am) a2[m][0] = mfma16(am, b0, a2[m][0]); a2[m][1] = mfma16(am, b1, a2[m][1]); a2[m][2] = mfma16(am, b2, a2[m][2]); a2[m][3] = mfma16(am, b3, a2[m][3]); \
                      a2[m][4] = mfma16(am, b4, a2[m][4]); a2[m][5] = mfma16(am, b5, a2[m][5]); a2[m][6] = mfma16(am, b6, a2[m][6]); a2[m][7] = mfma16(am, b7, a2[m][7]);
  RR_ROW(0, a0) RR_ROW(1, a1) RR_ROW(2, a2f) RR_ROW(3, a3)
#undef RR_ROW
  __builtin_amdgcn_sched_barrier(0);
}
__device__ __forceinline__ void ret_ring_gemm(const u16* __restrict__ qbase, const u16* __restrict__ sbase, f32x4 (&a2)[4][8], char* sm) {
  const int t = tid_now(), lane = t & 63, w = t >> 6, fr = lane & 15, fq = lane >> 4;
  const int sb = lane * 16, swz = sb ^ (((sb >> 9) & 1) << 5);
  const int r0 = w * 16 + (swz >> 6), c0 = (swz & 63) >> 1;
  const u16* Ap = qbase + (size_t)r0 * 32 + c0;
  const u16* Bp = sbase + (size_t)r0 * 32 + c0;
  const unsigned smb = (unsigned)(uintptr_t)(LAS3 char*)sm;
  const unsigned aA = smb + lds_off32(fr, fq * 8);
  const unsigned aB = smb + 4096 + w * 8192 + lds_off32(fr, fq * 8);
  {
    char* d = sm + t * 16;
    __builtin_amdgcn_global_load_lds((const unsigned*)Ap, (unsigned*)d, 16, 0, 0);
#pragma unroll
    for (int i = 0; i < 8; ++i)
      __builtin_amdgcn_global_load_lds((const unsigned*)(Bp + (size_t)(64 * i) * 32), (unsigned*)(d + 4096 + i * 4096), 16, 0, 0);
  }
#pragma unroll 1
  for (int ks = 0; ks < 8; ks += 2) {
    ret_ring_step<0>(ks, Ap, Bp, sm, aA, aB, t, a2);
    ret_ring_step<1>(ks + 1, Ap, Bp, sm, aA, aB, t, a2);
  }
  __builtin_amdgcn_s_barrier();
}

__device__ __forceinline__ void phase_ret_out(const Params& p, char* sm) {
  for (int idx = blockIdx.x; idx < 512; idx += gridDim.x) {
    int t = tid_now();
    asm volatile("" : "+v"(t));
    const int lane = t & 63, w = t >> 6, fr = lane & 15, fq = lane >> 4;
    unsigned char* wsb = p.ws;
    asm volatile("" : "+s"(wsb));
    const u16* Q = (const u16*)(wsb + WS_RA);
    const u16* Kb = (const u16*)(wsb + WS_RB);
    const u16* VTp = (const u16*)(wsb + WS_RD);
    const u16* VTs = VTp + (size_t)16 * 2048 * 256;
    u16* SZ = (u16*)(wsb + WS_RE);
    const u16* SNAP = (const u16*)(wsb + WS_RF);
    const float* gn = p.in[21];
    int ii = idx, gbase = 32;
    if (ii >= 256) { ii -= 256; gbase = 0; }
    const int xl = ii & 7, yy = ii >> 3;
    const int rh = yy & 1, h = xl & 3;
    const int gc = gbase + (yy >> 1) * 2 + (xl >> 2);
    const bool sample = gc >= 32;
    int sb, c;
    if (sample) { sb = (gc - 32) >> 4; c = (gc - 32) & 15; } else { sb = gc >> 1; c = gc & 1; }
    const size_t R0 = (size_t)gc * 128 + rh * 64;
    const float lgf2 = logsig2(p.in[19][h]), lgb2 = logsig2(p.in[20][h]);
    {
      f32x4 a1[4][2];
#pragma unroll
      for (int m = 0; m < 4; ++m)
#pragma unroll
        for (int n = 0; n < 2; ++n) a1[m][n] = (f32x4){0.f, 0.f, 0.f, 0.f};
      const u16* qp = Q + (size_t)(h * 8) * 262144 + (R0 + fr) * 32 + fq * 8;
      const u16* kp = Kb + (size_t)(h * 8) * 262144 + ((size_t)gc * 128 + w * 32 + fr) * 32 + fq * 8;
#pragma unroll 1
      for (int kb = 0; kb < 8; kb += 4) {
        bf16x8 af[4][4], bfr[4][2];
#pragma unroll
        for (int k2 = 0; k2 < 4; ++k2) {
#pragma unroll
          for (int m = 0; m < 4; ++m) af[k2][m] = *(const bf16x8*)(qp + (size_t)(kb + k2) * 262144 + (16 * m) * 32);
#pragma unroll
          for (int n = 0; n < 2; ++n) bfr[k2][n] = *(const bf16x8*)(kp + (size_t)(kb + k2) * 262144 + (16 * n) * 32);
        }
#pragma unroll
        for (int k2 = 0; k2 < 4; ++k2)
#pragma unroll
          for (int m = 0; m < 4; ++m)
#pragma unroll
            for (int n = 0; n < 2; ++n) a1[m][n] = mfma16(af[k2][m], bfr[k2][n], a1[m][n]);
      }
#pragma unroll
      for (int m = 0; m < 4; ++m)
#pragma unroll
        for (int n = 0; n < 2; ++n)
#pragma unroll
          for (int r = 0; r < 4; ++r) {
            int il = 16 * m + 4 * fq + r, i = rh * 64 + il, jj = w * 32 + 16 * n + fr;
            int dd = i - jj;
            float f = dd > 0 ? fexp2((float)dd * lgf2) : (dd < 0 ? fexp2((float)(-dd) * lgb2) : 2.0f);
            *(u16*)(sm + (jj >> 6) * 8192 + lds_off(il, jj & 63)) = f2bf(a1[m][n][r] * f);
          }
    }
    __syncthreads();
    f32x4 a2[4][8];
#pragma unroll
    for (int m = 0; m < 4; ++m)
#pragma unroll
      for (int n = 0; n < 8; ++n) a2[m][n] = (f32x4){0.f, 0.f, 0.f, 0.f};
    {
      const u16* vt; size_t ldv;
      if (sample) { ldv = 2048; vt = VTs + ((size_t)sb * 2048 + h * 512 + w * 128 + fr) * 2048 + c * 128 + fq * 8; }
      else { ldv = 256; vt = VTp + ((size_t)sb * 2048 + h * 512 + w * 128 + fr) * 256 + c * 128 + fq * 8; }
#pragma unroll 1
      for (int kb = 0; kb < 4; kb += 2) {
        bf16x8 bv[2][8];
#pragma unroll
        for (int k2 = 0; k2 < 2; ++k2)
#pragma unroll
          for (int n = 0; n < 8; ++n) bv[k2][n] = *(const bf16x8*)(vt + (size_t)(16 * n) * ldv + (kb + k2) * 32);
#pragma unroll
        for (int k2 = 0; k2 < 2; ++k2) {
          const int ks = kb + k2;
          bf16x8 af[4];
#pragma unroll
          for (int m = 0; m < 4; ++m) af[m] = *(const bf16x8*)(sm + (ks >> 1) * 8192 + lds_off(16 * m + fr, (ks & 1) * 32 + fq * 8));
#pragma unroll
          for (int n = 0; n < 8; ++n)
#pragma unroll
            for (int m = 0; m < 4; ++m) a2[m][n] = mfma16(af[m], bv[k2][n], a2[m][n]);
        }
        __builtin_amdgcn_sched_barrier(0);
      }
    }
    __syncthreads();
    {
      int tb = tid_now();
      asm volatile("" : "+v"(tb));
      const int fq = (tb & 63) >> 4;
      bool hasF = sample || c == 1, hasB = sample || c == 0;
      int mode = 0;
#pragma unroll 1
      for (int dir = 0; dir < 2; ++dir) {
        bool has = dir == 0 ? hasF : hasB;
        if (!has) continue;
#pragma unroll
        for (int m = 0; m < 4; ++m)
#pragma unroll
          for (int r = 0; r < 4; ++r) {
            float fi = (float)(rh * 64 + 16 * m + 4 * fq + r);
            float ecur = mode == 0 ? 0.f : (fi + 1.f) * lgf2;
            float enew = dir == 0 ? (fi + 1.f) * lgf2 : (128.f - fi) * lgb2;
            float f = fexp2(ecur - enew);
#pragma unroll
            for (int n = 0; n < 8; ++n) a2[m][n][r] *= f;
          }
        mode = dir + 1;
        int slot = sample ? ((sb * 16 + c) * 4 + h) * 2 + dir : 256 + (sb * 4 + h) * 2 + dir;
        ret_ring_gemm(Q + (size_t)(h * 8) * 262144 + R0 * 32, SNAP + (size_t)slot * 131072, a2, sm);
      }
      if (mode != 0) {
#pragma unroll
        for (int m = 0; m < 4; ++m)
#pragma unroll
          for (int r = 0; r < 4; ++r) {
            float fi = (float)(rh * 64 + 16 * m + 4 * fq + r);
            float f = fexp2(mode == 1 ? (fi + 1.f) * lgf2 : (128.f - fi) * lgb2);
#pragma unroll
            for (int n = 0; n < 8; ++n) a2[m][n][r] *= f;
          }
      }
    }
    int t3 = tid_now();
    asm volatile("" : "+v"(t3));
    {
    const int lane = t3 & 63, w = t3 >> 6, fr = lane & 15, fq = lane >> 4;
    float* red = (float*)(sm + 69632);
#pragma unroll
    for (int m = 0; m < 4; ++m)
#pragma unroll
      for (int r = 0; r < 4; ++r) {
        float s1 = 0.f, s2 = 0.f;
#pragma unroll
        for (int n = 0; n < 8; ++n) { float v = a2[m][n][r]; s1 += v; s2 += v * v; }
#pragma unroll
        for (int o = 1; o < 16; o <<= 1) { s1 += __shfl_xor(s1, o); s2 += __shfl_xor(s2, o); }
        if (fr == 0) { int row = 16 * m + 4 * fq + r; red[(w * 64 + row) * 2] = s1; red[(w * 64 + row) * 2 + 1] = s2; }
      }
    __syncthreads();
    u16* stg = (u16*)(sm + w * 17408);
    float gv[8];
#pragma unroll
    for (int n = 0; n < 8; ++n) gv[n] = gn[h * 512 + w * 128 + 16 * n + fr];
#pragma unroll
    for (int m = 0; m < 4; ++m)
#pragma unroll
      for (int r = 0; r < 4; ++r) {
        int row = 16 * m + 4 * fq + r;
        float s1 = 0.f, s2 = 0.f;
#pragma unroll
        for (int ww = 0; ww < 4; ++ww) { s1 += red[(ww * 64 + row) * 2]; s2 += red[(ww * 64 + row) * 2 + 1]; }
        float mean = s1 * (1.f / 512.f);
        float var = s2 * (1.f / 512.f) - mean * mean;
        var = var < 0.f ? 0.f : var;
        float rstd = rsqrtf(var + 1e-6f);
#pragma unroll
        for (int n = 0; n < 8; ++n) stg[row * 136 + 16 * n + fr] = f2bf((a2[m][n][r] - mean) * rstd * gv[n]);
      }
#pragma unroll 8
    for (int i = 0; i < 16; ++i) {
      int row = (lane >> 4) + 4 * i, ch = lane & 15;
      uint4 yv = *(const uint4*)(stg + row * 136 + ch * 8);
      const int zc = h * 512 + w * 128 + ch * 8;
      u16* zp = SZ + (size_t)(zc >> 5) * 262144 + (R0 + row) * 32 + (zc & 31);
      uint4 zv = *(const uint4*)zp;
      uint4 o;
      o.x = pk_bf16(bflo(yv.x) * bflo(zv.x), bfhi(yv.x) * bfhi(zv.x));
      o.y = pk_bf16(bflo(yv.y) * bflo(zv.y), bfhi(yv.y) * bfhi(zv.y));
      o.z = pk_bf16(bflo(yv.z) * bflo(zv.z), bfhi(yv.z) * bfhi(zv.z));
      o.w = pk_bf16(bflo(yv.w) * bflo(zv.w), bfhi(yv.w) * bfhi(zv.w));
      *(uint4*)zp = o;
    }
    }
    __syncthreads();
  }
}

#define XB_TMO      128
#define XB_XCNT(j)  (256  + 64 * (j))
#define XB_XSUB(j)  (1280 + 64 * (j))
#define XB_XGEN(j)  (2304 + 64 * (j))
#define XB_TOP      3328
#define XB_TOPGEN   3392
#define XCD_BAR_WORDS 3456
#define XB_SPIN_CAP (1u << 18)
#define LAS __attribute__((address_space(3)))
__device__ __forceinline__ unsigned xb_ld(unsigned* p)              { return __hip_atomic_load(p, __ATOMIC_RELAXED, __HIP_MEMORY_SCOPE_AGENT); }
__device__ __forceinline__ unsigned xb_add(unsigned* p, unsigned v) { return __hip_atomic_fetch_add(p, v, __ATOMIC_RELAXED, __HIP_MEMORY_SCOPE_AGENT); }
__device__ __forceinline__ unsigned xb_xcc_id() { return (unsigned)__builtin_amdgcn_s_getreg((3 << 11) | 20) & 0xFu; }
#define XB_SPIN(cond, bar) do { unsigned _sp = 0; while (cond) { __builtin_amdgcn_s_sleep(1); \
    if ((++_sp & 255u) == 0u) { if (xb_ld(&(bar)[XB_TMO])) break; if (_sp > XB_SPIN_CAP) { atomicAdd(&(bar)[XB_TMO], 1u); break; } } } } while (0)
struct XcdBarrier { unsigned* bar; unsigned x; volatile LAS unsigned* st; };
__device__ __forceinline__ XcdBarrier xcd_barrier_post(unsigned* bar, volatile LAS unsigned* st) {
    XcdBarrier b; b.bar = bar; b.x = xb_xcc_id(); b.st = st;
    if (tid_now() == 0) (void)xb_add(&bar[XB_XCNT(b.x)], 1u);
    return b;
}
__device__ __forceinline__ void xcd_barrier_complete(unsigned* bar, unsigned x, unsigned& nloc, unsigned& nx) {
    const unsigned G = gridDim.x * gridDim.y * gridDim.z;
    unsigned sum, cnt, mine, sp = 0u;
    for (;;) {
        sum = 0u; cnt = 0u; mine = 0u;
#pragma unroll
        for (unsigned j = 0; j < 16; ++j) { const unsigned c = xb_ld(&bar[XB_XCNT(j)]); sum += c; cnt += (c > 0u) ? 1u : 0u; mine = (j == x) ? c : mine; }
        if (sum == G) break;
        __builtin_amdgcn_s_sleep(1);
        if ((++sp & 255u) == 0u) { if (xb_ld(&bar[XB_TMO])) break; if (sp > XB_SPIN_CAP) { atomicAdd(&bar[XB_TMO], 1u); break; } }
    }
    nloc = mine > 0u ? mine : 1u; nx = cnt > 0u ? cnt : 1u;
}
__device__ __forceinline__ void xcd_barrier(const XcdBarrier& b) {
    asm volatile("s_waitcnt vmcnt(0)" ::: "memory");
    __syncthreads();
    if (tid_now() == 0) {
        unsigned* bar = b.bar;
        __builtin_amdgcn_s_waitcnt(0);
        unsigned nloc = b.st[0], nx = b.st[1];
        if (nloc == 0u) { xcd_barrier_complete(bar, b.x, nloc, nx); b.st[0] = nloc; b.st[1] = nx; }
        const unsigned old = xb_add(&bar[XB_XSUB(b.x)], 1u);
        const unsigned gen = old / nloc;
        if (old + 1u == (gen + 1u) * nloc) {
            __builtin_amdgcn_fence(__ATOMIC_RELEASE, "agent");
            asm volatile("s_waitcnt vmcnt(0)" ::: "memory");
            const unsigned og = xb_add(&bar[XB_TOP], 1u);
            const unsigned tg = og / nx;
            if (og + 1u == (tg + 1u) * nx) xb_add(&bar[XB_TOPGEN], 1u);
            else XB_SPIN(xb_ld(&bar[XB_TOPGEN]) == tg, bar);
            __builtin_amdgcn_fence(__ATOMIC_ACQUIRE, "agent");
            xb_add(&bar[XB_XGEN(b.x)], 1u);
            asm volatile("s_waitcnt vmcnt(0)" ::: "memory");
        } else {
            XB_SPIN(xb_ld(&bar[XB_XGEN(b.x)]) == gen, bar);
            __builtin_amdgcn_fence(__ATOMIC_ACQUIRE, "agent");
            asm volatile("s_waitcnt vmcnt(0)" ::: "memory");
        }
    }
    __syncthreads();
}

__global__ void __launch_bounds__(NTHREADS, 2) mega(Params p, int ph_lo, int ph_hi) {
  __shared__ __attribute__((aligned(16))) char sm[SMEM_BYTES];
  cg::grid_group grid = cg::this_grid();
  __shared__ uint4 xb_words;
  if ((threadIdx.x & 63) == 0) g_wave_tab[hw_slot()] = (int)(threadIdx.x >> 6);
  if (threadIdx.x == 0) xb_words = make_uint4(0u, 0u, 0u, 0u);
  __syncthreads();
  (void)xcd_barrier_post((unsigned*)(p.ws + WS_BAR), (volatile LAS unsigned*)&xb_words);
  if (ph_lo < 0) grid.sync();
  const float* xp0 = p.in[0];
  const float* xs0 = p.in[1];
  const float* xp1 = p.out;
  const float* xs1 = p.out + (size_t)4096 * 1024;
#ifndef PH_ONLY
#define PH_ONLY -1
#endif
#define PHON(x) (PH_ONLY < 0 || PH_ONLY == (x))
#define RUN(k, call) do { if (ph_lo <= (k) && (k) < ph_hi) { if (PHON(k)) { call; } if ((k) + 1 < ph_hi) { XcdBarrier xb; xb.bar = (unsigned*)(p.ws + WS_BAR); xb.x = xb_xcc_id(); xb.st = (volatile LAS unsigned*)&xb_words; xcd_barrier(xb); } } } while (0)
  RUN(0, phase_prep(p, sm));
  RUN(1, phase_norm(p, 0, xp0, xs0));
  RUN(2, phase_attn_inproj(p, 0, sm));
  RUN(3, phase_attn(p, 0, sm));
  RUN(4, phase_outproj(p, 0, (const u16*)(p.ws + WS_RC), 1024, (const u16*)(p.ws + WS_WAO), xp0, xs0, sm));
  RUN(5, phase_norm(p, 1, xp1, xs1));
  RUN(6, phase_pool_inproj(p, sm));
  RUN(7, phase_pool_d(p));
  RUN(8, phase_pool_gemm(p, sm));
  RUN(9, phase_outproj(p, 1, (const u16*)(p.ws + WS_RC), 1024, (const u16*)(p.ws + WS_WPO), xp1, xs1, sm));
  RUN(10, phase_norm(p, 2, xp1, xs1));
  RUN(11, phase_ret_inproj(p, sm));
  RUN(12, phase_ret_scan(p, sm));
  RUN(13, phase_ret_out(p, sm));
  RUN(14, phase_outproj(p, 2, (const u16*)(p.ws + WS_RE), 2048, (const u16*)(p.ws + WS_WRO), xp1, xs1, sm));
  RUN(15, phase_norm(p, 3, xp1, xs1));
  RUN(16, phase_attn_inproj(p, 1, sm));
  RUN(17, phase_attn(p, 1, sm));
  RUN(18, phase_outproj(p, 3, (const u16*)(p.ws + WS_RC), 1024, (const u16*)(p.ws + WS_WAO) + (size_t)1024 * 1024, xp1, xs1, sm));
  RUN(19, phase_final_norm(p));
}

extern "C" void kernel_launch(void* const* d_in, const int* in_sizes, int n_in, void* d_out, int out_size, void* d_ws, size_t ws_size,
                              hipStream_t stream) {
  static int grid_blocks = 0;
  if (!grid_blocks) {
    int dev = 0, cus = 0, per_cu = 0;
    hipGetDevice(&dev);
    hipDeviceGetAttribute(&cus, hipDeviceAttributeMultiprocessorCount, dev);
    hipOccupancyMaxActiveBlocksPerMultiprocessor(&per_cu, mega, NTHREADS, 0);
    if (per_cu < 1) per_cu = 1;
    if (per_cu > 2) per_cu = 2;
    grid_blocks = cus * per_cu;
    if (ws_size < WS_END) fprintf(stderr, "kernel_launch: workspace too small: %zu < %zu\n", ws_size, (size_t)WS_END);
  }
  Params p{};
  for (int i = 0; i < 24; ++i) p.in[i] = (const float*)d_in[i];
  p.out = (float*)d_out;
  p.ws = (unsigned char*)d_ws;
#ifndef N_SPLIT
#define N_SPLIT 1
#endif
#ifndef PH_END
#define PH_END 20
#endif
  if (PH_END < 20) (void)hipMemsetAsync(d_out, 0, (size_t)out_size * 4, stream);
  (void)hipMemsetAsync((char*)d_ws + WS_BAR, 0, XCD_BAR_WORDS * 4, stream);
#ifndef PROBE_DUP
#define PROBE_DUP -1
#endif
  {
    int seg[4][2]; int nseg = 0;
    if (PROBE_DUP < 0) { seg[0][0] = 0; seg[0][1] = PH_END; nseg = 1; }
#ifndef PROBE_LO
#define PROBE_LO PROBE_DUP
#endif
    else { seg[0][0] = 0; seg[0][1] = PROBE_DUP + 1; seg[1][0] = PROBE_LO; seg[1][1] = PROBE_DUP + 1; nseg = 2; if (PROBE_DUP + 1 < 20) { seg[2][0] = PROBE_DUP + 1; seg[2][1] = 20; nseg = 3; } }
    for (int li = 0; li < nseg; ++li) {
      int lo = seg[li][0], hi = seg[li][1];
      if (li > 0) (void)hipMemsetAsync((char*)d_ws + WS_BAR, 0, XCD_BAR_WORDS * 4, stream);
      void* args[] = {&p, &lo, &hi};
      hipError_t e = hipLaunchCooperativeKernel((void*)mega, dim3(grid_blocks), dim3(NTHREADS), args, 0, stream);
      if (e != hipSuccess) fprintf(stderr, "cooperative launch failed: %s (grid %d)\n", hipGetErrorString(e), grid_blocks);
    }
  }
}
```

```cpp
#include <hip/hip_runtime.h>
#include <hip/hip_cooperative_groups.h>
#include <cstdio>
#include <cstdint>
namespace cg = cooperative_groups;

typedef unsigned short u16;
typedef short bf16x8 __attribute__((ext_vector_type(8)));
typedef float f32x4 __attribute__((ext_vector_type(4)));
typedef unsigned u32x4 __attribute__((ext_vector_type(4)));
typedef float f32x4v __attribute__((ext_vector_type(4)));

#define NTHREADS 256
#define SMEM_BYTES 73728
constexpr float LOG2E = 1.4426950408889634f;

constexpr size_t MiB = 1048576;
constexpr size_t WS_MOD  = 0;
constexpr size_t WS_ROPE = 147456;
constexpr size_t WS_BAR  = 155648;
constexpr size_t WS_WAI  = 262144;
constexpr size_t WS_WAO  = WS_WAI + 2 * 2560 * 1024 * 2;
constexpr size_t WS_WPI  = WS_WAO + 2 * 1024 * 1024 * 2;
constexpr size_t WS_WPG  = WS_WPI + 2048 * 1024 * 2;
constexpr size_t WS_WPO  = WS_WPG + 4 * 256 * 256 * 2;
constexpr size_t WS_WRI  = WS_WPO + 1024 * 1024 * 2;
constexpr size_t WS_WRO  = WS_WRI + 6144 * 1024 * 2;
constexpr size_t WS_CK   = WS_WRO + 1024 * 2048 * 2;
constexpr size_t WS_CVT  = WS_CK + 2 * 2 * 512 * 256 * 2;
constexpr size_t WS_RA   = WS_CVT + 2 * 2 * 512 * 256 * 2;
constexpr size_t WS_RB   = WS_RA + 16 * MiB;
constexpr size_t WS_RC   = WS_RB + 16 * MiB;
constexpr size_t WS_RD   = WS_RC + 16 * MiB;
constexpr size_t WS_RE   = WS_RD + 32 * MiB;
constexpr size_t WS_RF   = WS_RE + 32 * MiB;
constexpr size_t WS_END  = WS_RF + 96 * MiB;

constexpr size_t O_NK = 8388608, O_NV = 10485760, O_SF = 12582912, O_SB = 20971520;

struct Params {
  const float* in[24];
  float* out;
  unsigned char* ws;
};

typedef __bf16 bf16x2_t __attribute__((ext_vector_type(2)));
__device__ __forceinline__ unsigned pk_bf16(float lo, float hi) { bf16x2_t v; v.x = (__bf16)lo; v.y = (__bf16)hi; return __builtin_bit_cast(unsigned, v); }
__device__ __forceinline__ u16 f2bf(float f) { return __builtin_bit_cast(u16, (__bf16)f); }
__device__ __forceinline__ float bf2f(u16 h) { return __uint_as_float(((unsigned)h) << 16); }
__device__ __forceinline__ float bflo(unsigned u) { return __uint_as_float(u << 16); }
__device__ __forceinline__ float bfhi(unsigned u) { return __uint_as_float(u & 0xffff0000u); }
__device__ __forceinline__ float fexp2(float x) { return __builtin_amdgcn_exp2f(x); }
__shared__ int g_wave_tab[64];
__device__ __forceinline__ int hw_slot() { return (int)(__builtin_amdgcn_s_getreg(((6 - 1) << 11) | 4) & 63u); }
__device__ __forceinline__ int lane_now() { return (int)__builtin_amdgcn_mbcnt_hi(~0u, __builtin_amdgcn_mbcnt_lo(~0u, 0u)); }
__device__ __forceinline__ int tid_now() { return __builtin_amdgcn_readfirstlane(g_wave_tab[hw_slot()]) * 64 + lane_now(); }
__device__ __forceinline__ float silu(float x) { return x / (1.f + __expf(-x)); }
__device__ __forceinline__ float logsig2(float x) { return -log1pf(expf(-x)) * LOG2E; }
__device__ __forceinline__ f32x4 mfma16(bf16x8 a, bf16x8 b, f32x4 c) { return __builtin_amdgcn_mfma_f32_16x16x32_bf16(a, b, c, 0, 0, 0); }

template <typename T> __device__ __forceinline__ T* opaque(T* p) { asm volatile("" : "+v"(p)); return p; }

__device__ __forceinline__ int lds_off(int r, int c) {
  int st = (r >> 4) * 2 + (c >> 5), ob = (r & 15) * 64 + (c & 31) * 2;
  return st * 1024 + (ob ^ (((ob >> 9) & 1) << 5));
}

__device__ __forceinline__ bf16x8 scale_frag(bf16x8 v, float s) {
  union { bf16x8 v; unsigned u[4]; } x; x.v = v;
#pragma unroll
  for (int i = 0; i < 4; ++i) x.u[i] = pk_bf16(bflo(x.u[i]) * s, bfhi(x.u[i]) * s);
  return x.v;
}

template <bool SCALE>
__device__ __forceinline__ void gemm_core(const u16* __restrict__ A, size_t lda, const u16* __restrict__ B, size_t ldb, int K,
                                          f32x4 (&acc)[4][4], char* sm, float lg2 = 0.f, int dir = 0) {
  const int t = tid_now(), lane = t & 63, w = t >> 6, wm = w >> 1, wn = w & 1, fr = lane & 15, fq = lane >> 4;
  const int lr = t >> 3, lc = (t & 7) * 8;
  uint4 ra[4], rb[4];
  const int nk = K >> 6;
  const u16* Ap = A + (size_t)lr * lda + lc;
  const u16* Bp = B + (size_t)lr * ldb + lc;
#define GLOAD(kt) do { _Pragma("unroll") for (int i = 0; i < 4; ++i) { ra[i] = *(const uint4*)(Ap + (size_t)(32 * i) * lda + (kt) * 64); rb[i] = *(const uint4*)(Bp + (size_t)(32 * i) * ldb + (kt) * 64); } } while (0)
#define LSTORE(buf, kt) do { \
    if (SCALE) { float fs[8]; _Pragma("unroll") for (int e = 0; e < 8; ++e) { int j = (kt) * 64 + lc + e; fs[e] = fexp2((float)(dir ? j : 127 - j) * lg2); } \
      _Pragma("unroll") for (int i = 0; i < 4; ++i) { unsigned* u = (unsigned*)&ra[i]; _Pragma("unroll") for (int e = 0; e < 4; ++e) u[e] = pk_bf16(bflo(u[e]) * fs[2 * e], bfhi(u[e]) * fs[2 * e + 1]); } } \
    _Pragma("unroll") for (int i = 0; i < 4; ++i) { *(uint4*)(sm + (buf) * 32768 + lds_off(lr + 32 * i, lc)) = ra[i]; *(uint4*)(sm + (buf) * 32768 + 16384 + lds_off(lr + 32 * i, lc)) = rb[i]; } } while (0)
  GLOAD(0);
  LSTORE(0, 0);
  __syncthreads();
  for (int kt = 0; kt < nk; ++kt) {
    const int cur = kt & 1;
    if (kt + 1 < nk) GLOAD(kt + 1);
    const char* sa = sm + cur * 32768;
    const char* sb = sa + 16384;
#pragma unroll
    for (int ks = 0; ks < 2; ++ks) {
      bf16x8 a[4], b[4];
#pragma unroll
      for (int m = 0; m < 4; ++m) a[m] = *(const bf16x8*)(sa + lds_off(wm * 64 + m * 16 + fr, ks * 32 + fq * 8));
#pragma unroll
      for (int n = 0; n < 4; ++n) b[n] = *(const bf16x8*)(sb + lds_off(wn * 64 + n * 16 + fr, ks * 32 + fq * 8));
#pragma unroll
      for (int m = 0; m < 4; ++m)
#pragma unroll
        for (int n = 0; n < 4; ++n) acc[m][n] = mfma16(a[m], b[n], acc[m][n]);
    }
    if (kt + 1 < nk) LSTORE(cur ^ 1, kt + 1);
    __syncthreads();
  }
#undef GLOAD
#undef LSTORE
}

__device__ __forceinline__ int lds_off32(int r, int c) {
  int ob = (r & 15) * 64 + c * 2;
  return (r >> 4) * 1024 + (ob ^ (((ob >> 9) & 1) << 5));
}
#define LAS3 __attribute__((address_space(3)))
template <int J>
__device__ __forceinline__ void glds_step(int kt, int nk, const u16* Ap, size_t lda, const u16* Bp, size_t ldb, char* sm, unsigned aA, unsigned aB,
                                          f32x4 (&acc)[4][4]) {
  const int t = tid_now();
  if (kt + 2 < nk) asm volatile("s_waitcnt vmcnt(8)" ::: "memory");
  else if (kt + 1 < nk) asm volatile("s_waitcnt vmcnt(4)" ::: "memory");
  else asm volatile("s_waitcnt vmcnt(0)" ::: "memory");
  __builtin_amdgcn_s_barrier();
  bf16x8 a0, a1, a2, a3, b0, b1, b2, b3;
  asm volatile(
      "ds_read_b128 %0, %8 offset:%10\n\t"
      "ds_read_b128 %4, %9 offset:%10\n\t"
      "ds_read_b128 %5, %9 offset:%11\n\t"
      "ds_read_b128 %1, %8 offset:%11\n\t"
      "ds_read_b128 %6, %9 offset:%12\n\t"
      "ds_read_b128 %7, %9 offset:%13\n\t"
      "ds_read_b128 %2, %8 offset:%12\n\t"
      "ds_read_b128 %3, %8 offset:%13\n\t"
      "s_waitcnt lgkmcnt(0)"
      : "=&v"(a0), "=&v"(a1), "=&v"(a2), "=&v"(a3), "=&v"(b0), "=&v"(b1), "=&v"(b2), "=&v"(b3)
      : "v"(aA), "v"(aB), "n"(J * 16384), "n"(J * 16384 + 1024), "n"(J * 16384 + 2048), "n"(J * 16384 + 3072)
      : "memory");
  if (kt + 3 < nk) {
    char* d = sm + ((J + 3) & 3) * 16384 + t * 16;
    const size_t ko = (size_t)(kt + 3) * 32;
#pragma unroll
    for (int i = 0; i < 2; ++i) {
      __builtin_amdgcn_global_load_lds((const unsigned*)(Ap + (size_t)(64 * i) * 32 + (size_t)(kt + 3) * lda), (unsigned*)(d + i * 4096), 16, 0, 0);
      __builtin_amdgcn_global_load_lds((const unsigned*)(Bp + (size_t)(64 * i) * 32 + (size_t)(kt + 3) * ldb), (unsigned*)(d + 8192 + i * 4096), 16, 0, 0);
    }
  }
  acc[0][0] = mfma16(a0, b0, acc[0][0]); acc[0][1] = mfma16(a0, b1, acc[0][1]); acc[0][2] = mfma16(a0, b2, acc[0][2]); acc[0][3] = mfma16(a0, b3, acc[0][3]);
  acc[1][0] = mfma16(a1, b0, acc[1][0]); acc[1][1] = mfma16(a1, b1, acc[1][1]); acc[1][2] = mfma16(a1, b2, acc[1][2]); acc[1][3] = mfma16(a1, b3, acc[1][3]);
  acc[2][0] = mfma16(a2, b0, acc[2][0]); acc[2][1] = mfma16(a2, b1, acc[2][1]); acc[2][2] = mfma16(a2, b2, acc[2][2]); acc[2][3] = mfma16(a2, b3, acc[2][3]);
  acc[3][0] = mfma16(a3, b0, acc[3][0]); acc[3][1] = mfma16(a3, b1, acc[3][1]); acc[3][2] = mfma16(a3, b2, acc[3][2]); acc[3][3] = mfma16(a3, b3, acc[3][3]);
}
__device__ __forceinline__ void gemm_core_glds(const u16* __restrict__ A, size_t lda, const u16* __restrict__ B, size_t ldb, int K,
                                               f32x4 (&acc)[4][4], char* sm) {
  const int t = tid_now(), lane = t & 63, w = t >> 6, wm = w >> 1, wn = w & 1, fr = lane & 15, fq = lane >> 4;
  const int sb = lane * 16, swz = sb ^ (((sb >> 9) & 1) << 5);
  const int r0 = w * 16 + (swz >> 6), c0 = (swz & 63) >> 1;
  const u16* Ap = A + (size_t)r0 * 32 + c0;
  const u16* Bp = B + (size_t)r0 * 32 + c0;
  const int nk = K >> 5;
  const unsigned smb = (unsigned)(uintptr_t)(LAS3 char*)sm;
  const unsigned aA = smb + lds_off32(wm * 64 + fr, fq * 8);
  const unsigned aB = smb + 8192 + lds_off32(wn * 64 + fr, fq * 8);
#pragma unroll
  for (int j = 0; j < 3; ++j) {
    char* d = sm + j * 16384 + t * 16;
#pragma unroll
    for (int i = 0; i < 2; ++i) {
      __builtin_amdgcn_global_load_lds((const unsigned*)(Ap + (size_t)(64 * i) * 32 + (size_t)j * lda), (unsigned*)(d + i * 4096), 16, 0, 0);
      __builtin_amdgcn_global_load_lds((const unsigned*)(Bp + (size_t)(64 * i) * 32 + (size_t)j * ldb), (unsigned*)(d + 8192 + i * 4096), 16, 0, 0);
    }
  }
  for (int kt0 = 0; kt0 < nk; kt0 += 4) {
    glds_step<0>(kt0, nk, Ap, lda, Bp, ldb, sm, aA, aB, acc);
    glds_step<1>(kt0 + 1, nk, Ap, lda, Bp, ldb, sm, aA, aB, acc);
    glds_step<2>(kt0 + 2, nk, Ap, lda, Bp, ldb, sm, aA, aB, acc);
    glds_step<3>(kt0 + 3, nk, Ap, lda, Bp, ldb, sm, aA, aB, acc);
  }
  __syncthreads();
}

template <int J>
__device__ __forceinline__ void glds2_step(int kt, int nk, const u16* Ap, size_t lda, const u16* Bp, size_t ldb, char* sm, unsigned aA, unsigned aB, int t,
                                           f32x4 (&accL)[4][4], f32x4 (&accR)[4][4]) {
  if (kt + 1 < nk) asm volatile("s_waitcnt vmcnt(6)" ::: "memory");
  else asm volatile("s_waitcnt vmcnt(0)" ::: "memory");
  __builtin_amdgcn_s_barrier();
  bf16x8 a0, a1, a2, a3, b0, b1, b2, b3, b4, b5, b6, b7;
  asm volatile(
      "ds_read_b128 %0, %12 offset:%14\n\t"
      "ds_read_b128 %4, %13 offset:%14\n\t"
      "ds_read_b128 %5, %13 offset:%15\n\t"
      "ds_read_b128 %1, %12 offset:%15\n\t"
      "ds_read_b128 %6, %13 offset:%16\n\t"
      "ds_read_b128 %7, %13 offset:%17\n\t"
      "ds_read_b128 %2, %12 offset:%16\n\t"
      "ds_read_b128 %8, %13 offset:%18\n\t"
      "ds_read_b128 %9, %13 offset:%19\n\t"
      "ds_read_b128 %3, %12 offset:%17\n\t"
      "ds_read_b128 %10, %13 offset:%20\n\t"
      "ds_read_b128 %11, %13 offset:%21\n\t"
      "s_waitcnt lgkmcnt(0)"
      : "=&v"(a0), "=&v"(a1), "=&v"(a2), "=&v"(a3), "=&v"(b0), "=&v"(b1), "=&v"(b2), "=&v"(b3), "=&v"(b4), "=&v"(b5), "=&v"(b6), "=&v"(b7)
      : "v"(aA), "v"(aB), "n"(J * 24576), "n"(J * 24576 + 1024), "n"(J * 24576 + 2048), "n"(J * 24576 + 3072),
        "n"(J * 24576 + 8192), "n"(J * 24576 + 9216), "n"(J * 24576 + 10240), "n"(J * 24576 + 11264)
      : "memory");
  if (kt + 2 < nk) {
    char* d = sm + ((J + 2) % 3) * 24576 + t * 16;
    const size_t ko = (size_t)(kt + 2) * 32;
#pragma unroll
    for (int i = 0; i < 2; ++i) __builtin_amdgcn_global_load_lds((const unsigned*)(Ap + (size_t)(64 * i) * 32 + (size_t)(kt + 2) * lda), (unsigned*)(d + i * 4096), 16, 0, 0);
#pragma unroll
    for (int i = 0; i < 4; ++i) __builtin_amdgcn_global_load_lds((const unsigned*)(Bp + (size_t)(64 * i) * 32 + (size_t)(kt + 2) * ldb), (unsigned*)(d + 8192 + i * 4096), 16, 0, 0);
  }
#define G2_ROW(m, am) accL[m][0] = mfma16(am, b0, accL[m][0]); accL[m][1] = mfma16(am, b1, accL[m][1]); accL[m][2] = mfma16(am, b2, accL[m][2]); accL[m][3] = mfma16(am, b3, accL[m][3]); \
                      accR[m][0] = mfma16(am, b4, accR[m][0]); accR[m][1] = mfma16(am, b5, accR[m][1]); accR[m][2] = mfma16(am, b6, accR[m][2]); accR[m][3] = mfma16(am, b7, accR[m][3]);
  G2_ROW(0, a0) G2_ROW(1, a1) G2_ROW(2, a2) G2_ROW(3, a3)
#undef G2_ROW
  __builtin_amdgcn_sched_barrier(0);
}
__device__ __forceinline__ void gemm_core_glds2(const u16* __restrict__ A, size_t lda, const u16* __restrict__ B, size_t ldb, int K,
                                                f32x4 (&accL)[4][4], f32x4 (&accR)[4][4], char* sm) {
  const int t = tid_now(), lane = t & 63, w = t >> 6, wm = w >> 1, wn = w & 1, fr = lane & 15, fq = lane >> 4;
  const int sb = lane * 16, swz = sb ^ (((sb >> 9) & 1) << 5);
  const int r0 = w * 16 + (swz >> 6), c0 = (swz & 63) >> 1;
  const u16* Ap = A + (size_t)r0 * 32 + c0;
  const u16* Bp = B + (size_t)r0 * 32 + c0;
  const int nk = K >> 5;
  const unsigned smb = (unsigned)(uintptr_t)(LAS3 char*)sm;
  const unsigned aA = smb + lds_off32(wm * 64 + fr, fq * 8);
  const unsigned aB = smb + 8192 + lds_off32(wn * 64 + fr, fq * 8);
#pragma unroll
  for (int j = 0; j < 2; ++j) {
    char* d = sm + j * 24576 + t * 16;
#pragma unroll
    for (int i = 0; i < 2; ++i) __builtin_amdgcn_global_load_lds((const unsigned*)(Ap + (size_t)(64 * i) * 32 + (size_t)j * lda), (unsigned*)(d + i * 4096), 16, 0, 0);
#pragma unroll
    for (int i = 0; i < 4; ++i) __builtin_amdgcn_global_load_lds((const unsigned*)(Bp + (size_t)(64 * i) * 32 + (size_t)j * ldb), (unsigned*)(d + 8192 + i * 4096), 16, 0, 0);
  }
  for (int kt0 = 0; kt0 < nk; kt0 += 3) {
    glds2_step<0>(kt0, nk, Ap, lda, Bp, ldb, sm, aA, aB, t, accL, accR);
    if (kt0 + 1 < nk) glds2_step<1>(kt0 + 1, nk, Ap, lda, Bp, ldb, sm, aA, aB, t, accL, accR);
    if (kt0 + 2 < nk) glds2_step<2>(kt0 + 2, nk, Ap, lda, Bp, ldb, sm, aA, aB, t, accL, accR);
  }
  __syncthreads();
}

#define WAVE_IDS const int t = tid_now(), lane = t & 63, w = t >> 6, wm = w >> 1, wn = w & 1, fr = lane & 15, fq = lane >> 4; (void)wm; (void)wn; (void)fr; (void)fq; (void)lane; (void)w; (void)t
#define AROW(m, r) (wm * 64 + (m) * 16 + fq * 4 + (r))
#define ACOL(n) (wn * 64 + (n) * 16 + fr)

template <class F>
__device__ __forceinline__ void epi_store_bf16(const f32x4 (&acc)[4][4], char* sm, u16* dst, size_t ldd, F f, const u16* mulp = nullptr, size_t ldm = 0) {
  WAVE_IDS;
  u16* cs = (u16*)sm;
#pragma unroll
  for (int m = 0; m < 4; ++m) {
#pragma unroll
    for (int n = 0; n < 4; ++n)
#pragma unroll
      for (int r = 0; r < 4; ++r) cs[AROW(m, r) * 136 + ACOL(n)] = f2bf(f(AROW(m, r), ACOL(n), acc[m][n][r]));
    __builtin_amdgcn_sched_barrier(0);
  }
  __syncthreads();
#pragma unroll
  for (int i = 0; i < 8; ++i) {
    int row = (t >> 4) + 16 * i, ch = t & 15;
    uint4 v = *(const uint4*)(cs + row * 136 + ch * 8);
    if (mulp) {
      uint4 z = *(const uint4*)(mulp + (size_t)row * ldm + ch * 8);
      v.x = pk_bf16(bflo(v.x) * bflo(z.x), bfhi(v.x) * bfhi(z.x));
      v.y = pk_bf16(bflo(v.y) * bflo(z.y), bfhi(v.y) * bfhi(z.y));
      v.z = pk_bf16(bflo(v.z) * bflo(z.z), bfhi(v.z) * bfhi(z.z));
      v.w = pk_bf16(bflo(v.w) * bflo(z.w), bfhi(v.w) * bfhi(z.w));
    }
    *(uint4*)(dst + (size_t)row * ldd + ch * 8) = v;
  }
  __syncthreads();
}

template <class F>
__device__ __forceinline__ void epi_store_bf16_T(const f32x4 (&acc)[4][4], u16* dstT, size_t ldt, F f) {
  WAVE_IDS;
#pragma unroll
  for (int m = 0; m < 4; ++m)
#pragma unroll
    for (int n = 0; n < 4; ++n) {
      float v0 = f(AROW(m, 0), ACOL(n), acc[m][n][0]), v1 = f(AROW(m, 1), ACOL(n), acc[m][n][1]);
      float v2 = f(AROW(m, 2), ACOL(n), acc[m][n][2]), v3 = f(AROW(m, 3), ACOL(n), acc[m][n][3]);
      uint2 pk; pk.x = pk_bf16(v0, v1); pk.y = pk_bf16(v2, v3);
      *(uint2*)(dstT + (size_t)ACOL(n) * ldt + AROW(m, 0)) = pk;
    }
}

template <class F>
__device__ __forceinline__ void epi_store_bf16_img(const f32x4 (&acc)[4][4], char* sm, u16* img, int row0, int col0, F f, const u16* mulp = nullptr, size_t ldm = 0) {
  WAVE_IDS;
  u16* cs = (u16*)sm;
#pragma unroll
  for (int m = 0; m < 4; ++m) {
#pragma unroll
    for (int n = 0; n < 4; ++n)
#pragma unroll
      for (int r = 0; r < 4; ++r) cs[AROW(m, r) * 136 + ACOL(n)] = f2bf(f(AROW(m, r), ACOL(n), acc[m][n][r]));
    __builtin_amdgcn_sched_barrier(0);
  }
  __syncthreads();
#pragma unroll
  for (int i = 0; i < 8; ++i) {
    int ch = (t & 3) + 4 * ((t >> 6) & 3), row = ((t >> 2) & 15) + 16 * i;
    uint4 v = *(const uint4*)(cs + row * 136 + ch * 8);
    if (mulp) {
      uint4 z = *(const uint4*)(mulp + (size_t)row * ldm + ch * 8);
      v.x = pk_bf16(bflo(v.x) * bflo(z.x), bfhi(v.x) * bfhi(z.x));
      v.y = pk_bf16(bflo(v.y) * bflo(z.y), bfhi(v.y) * bfhi(z.y));
      v.z = pk_bf16(bflo(v.z) * bflo(z.z), bfhi(v.z) * bfhi(z.z));
      v.w = pk_bf16(bflo(v.w) * bflo(z.w), bfhi(v.w) * bfhi(z.w));
    }
    const int col = col0 + ch * 8;
    *(uint4*)(img + (size_t)(col >> 5) * 262144 + (size_t)(row0 + row) * 32 + (col & 31)) = v;
  }
  __syncthreads();
}

struct IdF { __device__ __forceinline__ float operator()(int, int, float v) const { return v; } };
struct SiluF { __device__ __forceinline__ float operator()(int, int, float v) const { return silu(v); } };
struct ScaleF { float s; __device__ __forceinline__ float operator()(int, int, float v) const { return v * s; } };

__device__ __forceinline__ void transpose_tile(const float* __restrict__ src, size_t ldn, u16* __restrict__ dst, size_t ldk, int k0, int n0, char* smc, size_t bstep) {
  float* sm = (float*)smc;
  const int t = tid_now(), l = t & 63, w = t >> 6;
  float4 v[16];
#pragma unroll
  for (int i = 0; i < 16; ++i) { f32x4v nv = __builtin_nontemporal_load((const f32x4v*)(src + (size_t)(k0 + w + 4 * i) * ldn + n0 + l * 4)); v[i] = make_float4(nv[0], nv[1], nv[2], nv[3]); }
#pragma unroll
  for (int i = 0; i < 16; ++i) {
    float* d = sm + (w + 4 * i) * 257 + l * 4;
    d[0] = v[i].x; d[1] = v[i].y; d[2] = v[i].z; d[3] = v[i].w;
  }
  __syncthreads();
  const int kq = t & 7;
#pragma unroll
  for (int j = 0; j < 8; ++j) {
    int n = (t >> 3) + 32 * j;
    const float* r = sm + (kq * 8) * 257 + n;
    uint4 o;
    o.x = pk_bf16(r[0], r[257]); o.y = pk_bf16(r[2 * 257], r[3 * 257]); o.z = pk_bf16(r[4 * 257], r[5 * 257]); o.w = pk_bf16(r[6 * 257], r[7 * 257]);
    const int kk = k0 + kq * 8;
    if (bstep) *(uint4*)(dst + (size_t)(kk >> 5) * bstep + (size_t)(n0 + n) * 32 + (kk & 31)) = o;
    else *(uint4*)(dst + (size_t)(n0 + n) * ldk + kk) = o;
  }
  __syncthreads();
}

__device__ __forceinline__ void phase_prep(const Params& p, char* sm) {
  const int t = tid_now();
  unsigned char* ws = p.ws;
  float* mod = (float*)(ws + WS_MOD);
  const int N_ADA = 384, N_TR = 1200, N_CK = 256;
  for (int idx = blockIdx.x; idx < N_ADA + N_TR + N_CK + 1; idx += gridDim.x) {
    if (idx < N_ADA) {
      int i = idx / 96, nb = idx % 96, n0 = nb * 32;
      float* sv = (float*)sm;
      float* red = (float*)(sm + 12288);
      for (int e = t; e < 3072; e += NTHREADS) {
        int k = e / 3, cd = e % 3;
        float cv = (cd == 0) ? p.in[7][k] : p.in[6][(cd - 1) * 1024 + k];
        sv[e] = silu(cv);
      }
      __syncthreads();
      const int kg = t >> 3, c4 = (t & 7) * 4;
      float a0[4] = {0, 0, 0, 0}, a1[4] = {0, 0, 0, 0}, a2[4] = {0, 0, 0, 0};
      const float* wp = p.in[9] + ((size_t)i * 1024 + kg * 32) * 3072 + n0 + c4;
#pragma unroll 16
      for (int kk = 0; kk < 32; ++kk) {
        const f32x4v nv = __builtin_nontemporal_load((const f32x4v*)(wp + (size_t)kk * 3072));
        float4 wv = make_float4(nv[0], nv[1], nv[2], nv[3]);
        const float* svp = sv + (kg * 32 + kk) * 3;
        float s0 = svp[0], s1 = svp[1], s2 = svp[2];
        a0[0] += s0 * wv.x; a0[1] += s0 * wv.y; a0[2] += s0 * wv.z; a0[3] += s0 * wv.w;
        a1[0] += s1 * wv.x; a1[1] += s1 * wv.y; a1[2] += s1 * wv.z; a1[3] += s1 * wv.w;
        a2[0] += s2 * wv.x; a2[1] += s2 * wv.y; a2[2] += s2 * wv.z; a2[3] += s2 * wv.w;
      }
#pragma unroll
      for (int e = 0; e < 4; ++e) { red[(kg * 3 + 0) * 32 + c4 + e] = a0[e]; red[(kg * 3 + 1) * 32 + c4 + e] = a1[e]; red[(kg * 3 + 2) * 32 + c4 + e] = a2[e]; }
      __syncthreads();
      if (t < 96) {
        int cd = t >> 5, col = t & 31;
        float sacc = p.in[10][(size_t)i * 3072 + n0 + col];
        for (int g = 0; g < 32; ++g) sacc += red[(g * 3 + cd) * 32 + col];
        mod[((size_t)i * 3 + cd) * 3072 + n0 + col] = sacc;
      }
      __syncthreads();
    } else if (idx < N_ADA + N_TR) {
      int q = idx - N_ADA;
      const float* src; u16* dst; size_t ldn, ldk; int tk, tn;
      bool q_is_cache = false;
      if (q < 320) { int j = q / 160, r = q % 160; src = p.in[11] + (size_t)j * 1024 * 2560; dst = (u16*)(ws + WS_WAI) + (size_t)j * 2560 * 1024; ldn = 2560; ldk = 1024; tk = r / 10; tn = r % 10; }
      else if (q < 448) { q -= 320; int j = q / 64, r = q % 64; src = p.in[12] + (size_t)j * 1024 * 1024; dst = (u16*)(ws + WS_WAO) + (size_t)j * 1024 * 1024; ldn = 1024; ldk = 1024; tk = r / 4; tn = r % 4; }
      else if (q < 576) { q -= 448; src = p.in[14]; dst = (u16*)(ws + WS_WPI); ldn = 2048; ldk = 1024; tk = q / 8; tn = q % 8; }
      else if (q < 592) { q -= 576; int g = q / 4, r = q % 4; src = p.in[15] + (size_t)g * 65536; dst = (u16*)(ws + WS_WPG) + (size_t)g * 65536; ldn = 256; ldk = 256; tk = r; tn = 0; }
      else if (q < 656) { q -= 592; src = p.in[17]; dst = (u16*)(ws + WS_WPO); ldn = 1024; ldk = 1024; tk = q / 4; tn = q % 4; }
      else if (q < 1040) { q -= 656; src = p.in[18]; dst = (u16*)(ws + WS_WRI); ldn = 6144; ldk = 1024; tk = q / 24; tn = q % 24; }
      else if (q < 1168) { q -= 1040; src = p.in[22]; dst = (u16*)(ws + WS_WRO); ldn = 1024; ldk = 2048; tk = q / 4; tn = q % 4; }
      else { q_is_cache = true; q -= 1168; int bj = q / 8, r = q % 8; src = p.in[3] + (size_t)bj * 512 * 256; dst = (u16*)(ws + WS_CVT) + (size_t)bj * 256 * 512; ldn = 256; ldk = 512; tk = r; tn = 0; }
      transpose_tile(src, ldn, dst, ldk, tk * 64, tn * 256, sm, q_is_cache ? 0 : ldn * 32);
    } else if (idx < N_ADA + N_TR + N_CK) {
      int q = idx - N_ADA - N_TR;
      size_t off = (size_t)q * 2048 + t * 8;
      float4 v0 = *(const float4*)(p.in[2] + off), v1 = *(const float4*)(p.in[2] + off + 4);
      *(uint4*)((u16*)(ws + WS_CK) + off) = make_uint4(pk_bf16(v0.x, v0.y), pk_bf16(v0.z, v0.w), pk_bf16(v1.x, v1.y), pk_bf16(v1.z, v1.w));
    } else {
      if (t < 16) {
        double r = 0.5623413251903491, th = 1.0;
        for (int i = 0; i < t; ++i) th *= r;
        double x2 = th * th, cs = 1.0, sn = th, tc = 1.0, ts = th;
        for (int i = 1; i < 14; ++i) { tc *= -x2 / ((2.0 * i - 1.0) * (2.0 * i)); ts *= -x2 / ((2.0 * i) * (2.0 * i + 1.0)); cs += tc; sn += ts; }
        double c = 1.0, s = 0.0;
        float* tab = (float*)(ws + WS_ROPE);
        for (int pos = 0; pos < 64; ++pos) {
          tab[(pos * 16 + t) * 2] = (float)c; tab[(pos * 16 + t) * 2 + 1] = (float)s;
          double c2 = c * cs - s * sn, s2 = s * cs + c * sn; c = c2; s = s2;
        }
      }
    }
  }
}

__device__ __forceinline__ void phase_norm(const Params& p, int layer, const float* xp, const float* xs) {
  const int t = tid_now(), lane = t & 63, w = t >> 6;
  u16* H = (u16*)(p.ws + WS_RF);
  const float* g = p.in[8] + (size_t)layer * 1024;
  for (int base = (blockIdx.x * 4 + w) * 4; base < 8192; base += gridDim.x * 16) {
    const float* x = base < 4096 ? xp + (size_t)base * 1024 : xs + (size_t)(base - 4096) * 1024;
    int cnd = base < 4096 ? 0 : 1 + ((base - 4096) >> 11);
    const float* md = (const float*)(p.ws + WS_MOD) + ((size_t)layer * 3 + cnd) * 3072;
    float4 v[4][4];
#pragma unroll
    for (int j = 0; j < 4; ++j)
#pragma unroll
      for (int i = 0; i < 4; ++i) v[j][i] = *(const float4*)(x + (size_t)j * 1024 + (i * 64 + lane) * 4);
    float rstd[4];
#pragma unroll
    for (int j = 0; j < 4; ++j) {
      float ss = 0.f;
#pragma unroll
      for (int i = 0; i < 4; ++i) ss += v[j][i].x * v[j][i].x + v[j][i].y * v[j][i].y + v[j][i].z * v[j][i].z + v[j][i].w * v[j][i].w;
#pragma unroll
      for (int o = 32; o > 0; o >>= 1) ss += __shfl_xor(ss, o);
      rstd[j] = rsqrtf(ss * (1.f / 1024.f) + 1e-6f);
    }
#pragma unroll
    for (int i = 0; i < 4; ++i) {
      int c = (i * 64 + lane) * 4;
      float4 gv = *(const float4*)(g + c), sh = *(const float4*)(md + c), sc = *(const float4*)(md + 1024 + c);
      float m0 = gv.x * (1.f + sc.x), m1 = gv.y * (1.f + sc.y), m2 = gv.z * (1.f + sc.z), m3 = gv.w * (1.f + sc.w);
#pragma unroll
      for (int j = 0; j < 4; ++j) {
        float h0 = v[j][i].x * rstd[j] * m0 + sh.x, h1 = v[j][i].y * rstd[j] * m1 + sh.y;
        float h2 = v[j][i].z * rstd[j] * m2 + sh.z, h3 = v[j][i].w * rstd[j] * m3 + sh.w;
        uint2 pk; pk.x = pk_bf16(h0, h1); pk.y = pk_bf16(h2, h3);
        *(uint2*)(H + (size_t)(c >> 5) * 262144 + (size_t)(base + j) * 32 + (c & 31)) = pk;
      }
    }
  }
}

__device__ __forceinline__ void phase_final_norm(const Params& p) {
  const int t = tid_now(), lane = t & 63, w = t >> 6;
  const float* g = p.in[23];
  for (int base = (blockIdx.x * 4 + w) * 4; base < 8192; base += gridDim.x * 16) {
    float* x = p.out + (size_t)base * 1024;
    float4 v[4][4];
#pragma unroll
    for (int j = 0; j < 4; ++j)
#pragma unroll
      for (int i = 0; i < 4; ++i) v[j][i] = *(const float4*)(x + (size_t)j * 1024 + (i * 64 + lane) * 4);
    float rstd[4];
#pragma unroll
    for (int j = 0; j < 4; ++j) {
      float ss = 0.f;
#pragma unroll
      for (int i = 0; i < 4; ++i) ss += v[j][i].x * v[j][i].x + v[j][i].y * v[j][i].y + v[j][i].z * v[j][i].z + v[j][i].w * v[j][i].w;
#pragma unroll
      for (int o = 32; o > 0; o >>= 1) ss += __shfl_xor(ss, o);
      rstd[j] = rsqrtf(ss * (1.f / 1024.f) + 1e-6f);
    }
#pragma unroll
    for (int i = 0; i < 4; ++i) {
      int c = (i * 64 + lane) * 4;
      float4 gv = *(const float4*)(g + c);
#pragma unroll
      for (int j = 0; j < 4; ++j) {
        float4 o; o.x = v[j][i].x * rstd[j] * gv.x; o.y = v[j][i].y * rstd[j] * gv.y; o.z = v[j][i].z * rstd[j] * gv.z; o.w = v[j][i].w * rstd[j] * gv.w;
        { f32x4v ov = {o.x, o.y, o.z, o.w}; __builtin_nontemporal_store(ov, (f32x4v*)(x + (size_t)j * 1024 + c)); }
      }
    }
  }
}

__device__ __forceinline__ void phase_outproj(const Params& p, int layer, const u16* Y, int K, const u16* Wt, const float* xp, const float* xs, char* sm) {
  WAVE_IDS;
  float* X = p.out;
  for (int idx = blockIdx.x; idx < 512; idx += gridDim.x) {
    int mt = idx & 63, nt = idx >> 6;
    f32x4 acc[4][4];
#pragma unroll
    for (int m = 0; m < 4; ++m)
#pragma unroll
      for (int n = 0; n < 4; ++n) acc[m][n] = (f32x4){0.f, 0.f, 0.f, 0.f};
    gemm_core_glds(Y + (size_t)mt * 128 * 32, 262144, Wt + (size_t)nt * 128 * 32, 1024 * 32, K, acc, sm);
    int row0 = mt * 128, col0 = nt * 128;
    int cnd = row0 < 4096 ? 0 : 1 + ((row0 - 4096) >> 11);
    const float* gate = (const float*)(p.ws + WS_MOD) + ((size_t)layer * 3 + cnd) * 3072 + 2048;
    const float* xres = row0 < 4096 ? xp + (size_t)row0 * 1024 : xs + (size_t)(row0 - 4096) * 1024;
    const int c4 = (t & 31) * 4, rb = t >> 5;
    const float4 g4 = *(const float4*)(gate + col0 + c4);
    float4 xv[16];
#pragma unroll
    for (int i = 0; i < 16; ++i) xv[i] = *(const float4*)(xres + (size_t)(rb + 8 * i) * 1024 + col0 + c4);
    float* cs = (float*)sm;
#pragma unroll
    for (int m = 0; m < 4; ++m) {
#pragma unroll
      for (int n = 0; n < 4; ++n)
#pragma unroll
        for (int r = 0; r < 4; ++r) cs[AROW(m, r) * 132 + ACOL(n)] = acc[m][n][r];
      __builtin_amdgcn_sched_barrier(0);
    }
    __syncthreads();
#pragma unroll
    for (int i = 0; i < 16; ++i) {
      const float4 a = *(const float4*)(cs + (rb + 8 * i) * 132 + c4);
      float4 o; o.x = xv[i].x + g4.x * a.x; o.y = xv[i].y + g4.y * a.y; o.z = xv[i].z + g4.z * a.z; o.w = xv[i].w + g4.w * a.w;
      *(float4*)(X + (size_t)(row0 + rb + 8 * i) * 1024 + col0 + c4) = o;
    }
    __syncthreads();
  }
}

__device__ __forceinline__ void attn_inproj_epi(const Params& p, int j, int mt, int nt, f32x4 (&acc)[4][4], char* sm) {
  WAVE_IDS;
  u16* Q = (u16*)(p.ws + WS_RA);
  u16* Kb = (u16*)(p.ws + WS_RB);
  u16* VTp = (u16*)(p.ws + WS_RD);
  u16* VTs = VTp + (size_t)16 * 256 * 256;
  u16* SZ = (u16*)(p.ws + WS_RE);
  const float* rope = (const float*)(p.ws + WS_ROPE);
  const int row0 = mt * 128;
  const bool sample = row0 >= 4096;
  if (nt < 10 && sample) {
#pragma unroll
    for (int m = 0; m < 4; ++m) {
      __builtin_amdgcn_sched_barrier(0);
#pragma unroll
      for (int r = 0; r < 4; ++r) {
        int tk = (row0 + AROW(m, r) - 4096) & 2047;
        int rp = tk >> 6, cp = tk & 63;
        float2 a = *(const float2*)(rope + (rp * 16 + fr) * 2), b = *(const float2*)(rope + (cp * 16 + fr) * 2);
        float x1r = acc[m][0][r], x2r = acc[m][1][r], x1c = acc[m][2][r], x2c = acc[m][3][r];
        acc[m][0][r] = x1r * a.x - x2r * a.y; acc[m][1][r] = x2r * a.x + x1r * a.y;
        acc[m][2][r] = x1c * b.x - x2c * b.y; acc[m][3][r] = x2c * b.x + x1c * b.y;
      }
    }
  }
  if (nt < 8) {
    epi_store_bf16(acc, sm, Q + (size_t)row0 * 1024 + nt * 128, 1024, IdF());
  } else if (nt < 10) {
    int c0 = (nt - 8) * 128;
    if (!sample) {
      int b = row0 >> 8, t0 = row0 & 255;
      float* dk = p.out + O_NK + ((size_t)(b * 2 + j) * 256 + t0) * 256 + c0;
#pragma unroll
      for (int m = 0; m < 4; ++m) {
        float* pm = opaque(dk + (size_t)AROW(m, 0) * 256 + ACOL(0));
#pragma unroll
        for (int n = 0; n < 4; ++n)
#pragma unroll
          for (int r = 0; r < 4; ++r) __builtin_nontemporal_store(acc[m][n][r], pm + r * 256 + n * 16);
        __builtin_amdgcn_sched_barrier(0);
      }
    }
    epi_store_bf16(acc, sm, Kb + (size_t)row0 * 256 + c0, 256, IdF());
  } else if (nt < 12) {
    int c0 = (nt - 10) * 128;
    if (!sample) {
      int b = row0 >> 8, t0 = row0 & 255;
      float* dv = p.out + O_NV + ((size_t)(b * 2 + j) * 256 + t0) * 256 + c0;
#pragma unroll
      for (int m = 0; m < 4; ++m) {
        float* pm = opaque(dv + (size_t)AROW(m, 0) * 256 + ACOL(0));
#pragma unroll
        for (int n = 0; n < 4; ++n)
#pragma unroll
          for (int r = 0; r < 4; ++r) __builtin_nontemporal_store(acc[m][n][r], pm + r * 256 + n * 16);
        __builtin_amdgcn_sched_barrier(0);
      }
      epi_store_bf16_T(acc, VTp + ((size_t)b * 256 + c0) * 256 + t0, 256, IdF());
    } else {
      int s = (row0 - 4096) >> 11, t0 = (row0 - 4096) & 2047;
      epi_store_bf16_T(acc, VTs + ((size_t)s * 256 + c0) * 2048 + t0, 2048, IdF());
    }
  } else {
    epi_store_bf16(acc, sm, SZ + (size_t)row0 * 1024 + (nt - 12) * 128, 1024, SiluF());
  }
}

__device__ __forceinline__ void phase_attn_inproj(const Params& p, int j, char* sm) {
  const u16* H = (const u16*)(p.ws + WS_RF);
  const u16* W = (const u16*)(p.ws + WS_WAI) + (size_t)j * 2560 * 1024;
  for (int idx = blockIdx.x; idx < 768; idx += gridDim.x) {
    if (idx < 512) {
      const int mt = idx & 63, nt2 = idx >> 6;
      f32x4 accL[4][4], accR[4][4];
#pragma unroll
      for (int m = 0; m < 4; ++m)
#pragma unroll
        for (int n = 0; n < 4; ++n) { accL[m][n] = (f32x4){0.f, 0.f, 0.f, 0.f}; accR[m][n] = (f32x4){0.f, 0.f, 0.f, 0.f}; }
      gemm_core_glds2(H + (size_t)mt * 128 * 32, 262144, W + (size_t)nt2 * 256 * 32, 2560 * 32, 1024, accL, accR, sm);
      attn_inproj_epi(p, j, mt, nt2 * 2, accL, sm);
      attn_inproj_epi(p, j, mt, nt2 * 2 + 1, accR, sm);
    } else {
      const int j2 = idx - 512, mt = j2 & 63, nt = 16 + (j2 >> 6);
      f32x4 acc[4][4];
#pragma unroll
      for (int m = 0; m < 4; ++m)
#pragma unroll
        for (int n = 0; n < 4; ++n) acc[m][n] = (f32x4){0.f, 0.f, 0.f, 0.f};
      gemm_core_glds(H + (size_t)mt * 128 * 32, 262144, W + (size_t)nt * 128 * 32, 2560 * 32, 1024, acc, sm);
      attn_inproj_epi(p, j, mt, nt, acc, sm);
    }
  }
}

__device__ __forceinline__ void attn_comp64_lds(const char* sk, const char* sv, const bf16x8 (&qf)[2][2], f32x4 (&oacc)[4][2],
                                                float (&mrun)[2], float (&lrun)[2], bool masked, int key0, int qbase, float sc2, int fr, int fq) {
  f32x4 s[4][2];
#pragma unroll
  for (int m = 0; m < 4; ++m) {
    const int krow = 32 * (m >> 1) + 8 * (fr >> 2) + 4 * (m & 1) + (fr & 3);
    bf16x8 k0 = *(const bf16x8*)(sk + lds_off(krow, fq * 8));
    bf16x8 k1 = *(const bf16x8*)(sk + lds_off(krow, 32 + fq * 8));
#pragma unroll
    for (int n = 0; n < 2; ++n) {
      s[m][n] = mfma16(k0, qf[n][0], (f32x4){0.f, 0.f, 0.f, 0.f});
      s[m][n] = mfma16(k1, qf[n][1], s[m][n]);
    }
  }
  if (masked) {
#pragma unroll
    for (int n = 0; n < 2; ++n)
#pragma unroll
      for (int m = 0; m < 4; ++m)
#pragma unroll
        for (int r = 0; r < 4; ++r) {
          int kpos = key0 + 32 * (m >> 1) + 8 * fq + 4 * (m & 1) + r, qpos = qbase + 16 * n + fr;
          int dd = qpos - kpos; dd = dd < 0 ? -dd : dd;
          s[m][n][r] = dd <= 128 ? s[m][n][r] : -1.0e30f;
        }
  }
#pragma unroll
  for (int n = 0; n < 2; ++n) {
    float mx = -3.0e38f;
#pragma unroll
    for (int m = 0; m < 4; ++m)
#pragma unroll
      for (int r = 0; r < 4; ++r) { float v = s[m][n][r] * sc2; s[m][n][r] = v; mx = fmaxf(mx, v); }
    mx = fmaxf(mx, __shfl_xor(mx, 16));
    mx = fmaxf(mx, __shfl_xor(mx, 32));
    float mnew = fmaxf(mrun[n], mx);
    float alpha = fexp2(mrun[n] - mnew);
    mrun[n] = mnew;
    float ls = 0.f;
#pragma unroll
    for (int m = 0; m < 4; ++m)
#pragma unroll
      for (int r = 0; r < 4; ++r) { float pv = fexp2(s[m][n][r] - mnew); s[m][n][r] = pv; ls += pv; }
    lrun[n] = lrun[n] * alpha + ls;
#pragma unroll
    for (int dt = 0; dt < 4; ++dt) oacc[dt][n] *= alpha;
  }
#pragma unroll
  for (int s2 = 0; s2 < 2; ++s2) {
    bf16x8 vf[4];
#pragma unroll
    for (int dt = 0; dt < 4; ++dt) vf[dt] = *(const bf16x8*)(sv + lds_off(dt * 16 + fr, s2 * 32 + fq * 8));
#pragma unroll
    for (int n = 0; n < 2; ++n) {
      union { bf16x8 v; unsigned u[4]; } pf;
      pf.u[0] = pk_bf16(s[2 * s2][n][0], s[2 * s2][n][1]); pf.u[1] = pk_bf16(s[2 * s2][n][2], s[2 * s2][n][3]);
      pf.u[2] = pk_bf16(s[2 * s2 + 1][n][0], s[2 * s2 + 1][n][1]); pf.u[3] = pk_bf16(s[2 * s2 + 1][n][2], s[2 * s2 + 1][n][3]);
#pragma unroll
      for (int dt = 0; dt < 4; ++dt) oacc[dt][n] = mfma16(vf[dt], pf.v, oacc[dt][n]);
    }
  }
}

__device__ __forceinline__ void phase_attn(const Params& p, int j, char* sm) {
  const int t = tid_now(), lane = t & 63, w = t >> 6, fr = lane & 15, fq = lane >> 4;
  const u16* Q = (const u16*)(p.ws + WS_RA);
  const u16* Kb = (const u16*)(p.ws + WS_RB);
  const u16* VTp = (const u16*)(p.ws + WS_RD);
  const u16* VTs = VTp + (size_t)16 * 256 * 256;
  const u16* SZ = (const u16*)(p.ws + WS_RE);
  const u16* cK = (const u16*)(p.ws + WS_CK);
  const u16* cVT = (const u16*)(p.ws + WS_CVT);
  u16* Y = (u16*)(p.ws + WS_RC);
  const float sc2 = 0.125f * LOG2E;
  const int lrow = t >> 3, lcol = (t & 7) * 8;
  for (int idx = blockIdx.x; idx < 1024; idx += gridDim.x) {
    const bool sample = idx < 512;
    int hq, qb, rowbase, sb;
    if (sample) { sb = idx >> 8; hq = (idx >> 4) & 15; qb = idx & 15; rowbase = 4096 + sb * 2048; }
    else { int ii = idx - 512; sb = ii >> 5; hq = (ii >> 1) & 15; qb = ii & 1; rowbase = sb * 256; }
    const int kvh = hq >> 2;
    const int Q0 = qb * 128, q0 = Q0 + w * 32;
    bf16x8 qf[2][2];
#pragma unroll
    for (int n = 0; n < 2; ++n)
#pragma unroll
      for (int ks = 0; ks < 2; ++ks) qf[n][ks] = *(const bf16x8*)(Q + (size_t)(rowbase + q0 + 16 * n + fr) * 1024 + hq * 64 + ks * 32 + fq * 8);
    f32x4 oacc[4][2];
#pragma unroll
    for (int dt = 0; dt < 4; ++dt)
#pragma unroll
      for (int n = 0; n < 2; ++n) oacc[dt][n] = (f32x4){0.f, 0.f, 0.f, 0.f};
    const float sink2 = p.in[13][j * 16 + hq] * LOG2E;
    float mrun[2] = {sink2, sink2}, lrun[2] = {0.f, 0.f};
    const u16 *K1, *V1, *K2, *V2;
    size_t ldv1, ldv2 = 2048;
    int n1, n2 = 0, lo = 0;
    if (sample) {
      K1 = cK + ((size_t)(sb * 2 + j) * 512) * 256 + kvh * 64;
      V1 = cVT + ((size_t)(sb * 2 + j) * 256 + kvh * 64) * 512; ldv1 = 512; n1 = 8;
      K2 = Kb + (size_t)rowbase * 256 + kvh * 64;
      V2 = VTs + ((size_t)sb * 256 + kvh * 64) * 2048;
      lo = Q0 - 128; lo = lo < 0 ? 0 : lo;
      int hi = Q0 + 256; hi = hi > 2048 ? 2048 : hi;
      n2 = (hi - lo) >> 6;
    } else {
      K1 = Kb + (size_t)rowbase * 256 + kvh * 64;
      V1 = VTp + ((size_t)sb * 256 + kvh * 64) * 256; ldv1 = 256; n1 = 4;
      K2 = K1; V2 = V1;
    }
    const int total = n1 + n2;
    u32x4 rk[2], rv[2];
#define AT_GLOAD(i) do { const u16* _kp; const u16* _vp; size_t _ldv; \
      if ((i) < n1) { _kp = K1 + (size_t)(i) * 64 * 256; _vp = V1 + (i) * 64; _ldv = ldv1; } \
      else { int _k0 = lo + ((i) - n1) * 64; _kp = K2 + (size_t)_k0 * 256; _vp = V2 + _k0; _ldv = ldv2; } \
      _Pragma("unroll") for (int _i = 0; _i < 2; ++_i) { \
        rk[_i] = *(const u32x4*)(_kp + (size_t)(lrow + 32 * _i) * 256 + lcol); \
        rv[_i] = *(const u32x4*)(_vp + (size_t)(lrow + 32 * _i) * _ldv + lcol); } } while (0)
#define AT_LSTORE(buf) do { _Pragma("unroll") for (int _i = 0; _i < 2; ++_i) { \
        *(u32x4*)(sm + (buf) * 16384 + lds_off(lrow + 32 * _i, lcol)) = rk[_i]; \
        *(u32x4*)(sm + (buf) * 16384 + 8192 + lds_off(lrow + 32 * _i, lcol)) = rv[_i]; } } while (0)
    AT_GLOAD(0);
    AT_LSTORE(0);
    __syncthreads();
    for (int i = 0; i < total; ++i) {
      const int cur = i & 1;
      if (i + 1 < total) AT_GLOAD(i + 1);
      const bool masked = i >= n1;
      const int key0 = lo + (i - n1) * 64;
      const bool skip = masked && (key0 + 63 < q0 - 128 || key0 > q0 + 31 + 128);
      if (!skip) attn_comp64_lds(sm + cur * 16384, sm + cur * 16384 + 8192, qf, oacc, mrun, lrun, masked, key0, q0, sc2, fr, fq);
      if (i + 1 < total) AT_LSTORE(cur ^ 1);
      __syncthreads();
    }
#undef AT_GLOAD
#undef AT_LSTORE
#pragma unroll
    for (int n = 0; n < 2; ++n) {
      float lt = lrun[n];
      lt += __shfl_xor(lt, 16);
      lt += __shfl_xor(lt, 32);
      float inv = 1.f / (lt + fexp2(sink2 - mrun[n]));
      size_t row = (size_t)(rowbase + q0 + 16 * n + fr);
#pragma unroll
      for (int dt = 0; dt < 4; ++dt) {
        int d0 = hq * 64 + dt * 16 + 4 * fq;
        uint2 zz = *(const uint2*)(SZ + row * 1024 + d0);
        uint2 o;
        o.x = pk_bf16(oacc[dt][n][0] * inv * bflo(zz.x), oacc[dt][n][1] * inv * bfhi(zz.x));
        o.y = pk_bf16(oacc[dt][n][2] * inv * bflo(zz.y), oacc[dt][n][3] * inv * bfhi(zz.y));
        *(uint2*)(Y + (size_t)(d0 >> 5) * 262144 + row * 32 + (d0 & 31)) = o;
      }
    }
  }
}

__device__ __forceinline__ void phase_pool_inproj(const Params& p, char* sm) {
  const u16* H = (const u16*)(p.ws + WS_RF);
  const u16* W = (const u16*)(p.ws + WS_WPI);
  u16* U = (u16*)(p.ws + WS_RD);
  u16* SZ = (u16*)(p.ws + WS_RE);
  for (int idx = blockIdx.x; idx < 64 * 8; idx += gridDim.x) {
    int mt = idx & 63, nt2 = idx >> 6;
    f32x4 accL[4][4], accR[4][4];
#pragma unroll
    for (int m = 0; m < 4; ++m)
#pragma unroll
      for (int n = 0; n < 4; ++n) { accL[m][n] = (f32x4){0.f, 0.f, 0.f, 0.f}; accR[m][n] = (f32x4){0.f, 0.f, 0.f, 0.f}; }
    gemm_core_glds2(H + (size_t)mt * 128 * 32, 262144, W + (size_t)nt2 * 256 * 32, 2048 * 32, 1024, accL, accR, sm);
    if (nt2 < 4) {
      epi_store_bf16(accL, sm, U + (size_t)mt * 128 * 1024 + nt2 * 256, 1024, IdF());
      epi_store_bf16(accR, sm, U + (size_t)mt * 128 * 1024 + nt2 * 256 + 128, 1024, IdF());
    } else {
      epi_store_bf16(accL, sm, SZ + (size_t)mt * 128 * 1024 + (nt2 - 4) * 256, 1024, SiluF());
      epi_store_bf16(accR, sm, SZ + (size_t)mt * 128 * 1024 + (nt2 - 4) * 256 + 128, 1024, SiluF());
    }
  }
}

struct PoolEpiF {
  const float* scale;
  __device__ __forceinline__ float operator()(int r, int c, float v) const { return v * scale[c]; }
};
template <int W>
__device__ __forceinline__ void pool_d_strip(const u16* __restrict__ uc, u16* __restrict__ dc, int t0, int L) {
  constexpr int LEFT = W / 2, RIGHT = W - 1 - LEFT;
  float pre[49];
  pre[0] = 0.f;
  float ctr[32];
#pragma unroll
  for (int k = 0; k < 48; ++k) {
    int pos = t0 - 8 + k;
    float v = 0.f;
    if (k >= 8 - LEFT && k < 40 + RIGHT) {
      int pc = pos < 0 ? 0 : (pos >= L ? L - 1 : pos);
      float lv = bf2f(uc[(ptrdiff_t)(pc - t0) * 1024]);
      v = (pos >= 0 && pos < L) ? lv : 0.f;
    }
    pre[k + 1] = pre[k] + v;
    if (k >= 8 && k < 40) ctr[k - 8] = v;
  }
#pragma unroll
  for (int i = 0; i < 32; ++i) {
    int pos = t0 + i;
    int lo = pos - LEFT; lo = lo < 0 ? 0 : lo;
    int hi = pos + RIGHT + 1; hi = hi > L ? L : hi;
    float sum = pre[i + 8 + RIGHT + 1] - pre[i + 8 - LEFT];
    dc[(size_t)i * 32] = f2bf(sum / (float)(hi - lo) - ctr[i]);
  }
}
__device__ __forceinline__ void phase_pool_d(const Params& p) {
  const int t = tid_now();
  const u16* U = (const u16*)(p.ws + WS_RD);
  u16* Dm = (u16*)(p.ws + WS_RD + 16 * MiB);
  for (int idx = blockIdx.x; idx < 1024; idx += gridDim.x) {
    const int g = idx & 3, strip = idx >> 2;
    const int row0 = strip * 32;
    int L, t0;
    if (row0 < 4096) { L = 256; t0 = row0 & 255; } else { L = 2048; t0 = (row0 - 4096) & 2047; }
    const u16* uc = U + (size_t)row0 * 1024 + g * 256 + t;
    const int dcol = g * 256 + t;
    u16* dc = Dm + (size_t)(dcol >> 5) * 262144 + (size_t)row0 * 32 + (dcol & 31);
    if (g == 0) pool_d_strip<2>(uc, dc, t0, L);
    else if (g == 1) pool_d_strip<4>(uc, dc, t0, L);
    else if (g == 2) pool_d_strip<8>(uc, dc, t0, L);
    else pool_d_strip<16>(uc, dc, t0, L);
  }
}
__device__ __forceinline__ void phase_pool_gemm(const Params& p, char* sm) {
  const u16* Dm = (const u16*)(p.ws + WS_RD + 16 * MiB);
  const u16* SZ = (const u16*)(p.ws + WS_RE);
  u16* Y = (u16*)(p.ws + WS_RC);
  const u16* Wg = (const u16*)(p.ws + WS_WPG);
  for (int idx = blockIdx.x; idx < 512; idx += gridDim.x) {
    const int mt = idx & 63, gn = idx >> 6, g = gn >> 1, n2 = gn & 1;
    const int row0 = mt * 128;
    f32x4 acc[4][4];
#pragma unroll
    for (int m = 0; m < 4; ++m)
#pragma unroll
      for (int n = 0; n < 4; ++n) acc[m][n] = (f32x4){0.f, 0.f, 0.f, 0.f};
    gemm_core_glds(Dm + (size_t)(g * 8) * 262144 + (size_t)row0 * 32, 262144, Wg + (size_t)g * 65536 + (size_t)n2 * 128 * 32, 256 * 32, 256, acc, sm);
    int c0 = g * 256 + n2 * 128;
    PoolEpiF f{p.in[16] + c0};
    epi_store_bf16_img(acc, sm, Y, row0, c0, f, SZ + (size_t)row0 * 1024 + c0, 1024);
  }
}

__device__ __forceinline__ void phase_ret_inproj(const Params& p, char* sm) {
  const u16* H = (const u16*)(p.ws + WS_RF);
  const u16* W = (const u16*)(p.ws + WS_WRI);
  u16* Q = (u16*)(p.ws + WS_RA);
  u16* Kb = (u16*)(p.ws + WS_RB);
  u16* KTp = (u16*)(p.ws + WS_RC);
  u16* KTs = KTp + (size_t)16 * 1024 * 256;
  u16* VTp = (u16*)(p.ws + WS_RD);
  u16* VTs = VTp + (size_t)16 * 2048 * 256;
  u16* SZ = (u16*)(p.ws + WS_RE);
  for (int idx = blockIdx.x; idx < 64 * 24; idx += gridDim.x) {
    int mt = idx & 63, nt2 = idx >> 6;
    f32x4 accL[4][4], accR[4][4];
#pragma unroll
    for (int m = 0; m < 4; ++m)
#pragma unroll
      for (int n = 0; n < 4; ++n) { accL[m][n] = (f32x4){0.f, 0.f, 0.f, 0.f}; accR[m][n] = (f32x4){0.f, 0.f, 0.f, 0.f}; }
    gemm_core_glds2(H + (size_t)mt * 128 * 32, 262144, W + (size_t)nt2 * 256 * 32, 6144 * 32, 1024, accL, accR, sm);
    const int row0 = mt * 128;
    const bool sample = row0 >= 4096;
    int sb, t0;
    if (!sample) { sb = row0 >> 8; t0 = row0 & 255; } else { sb = (row0 - 4096) >> 11; t0 = (row0 - 4096) & 2047; }
#pragma unroll
    for (int half = 0; half < 2; ++half) {
    f32x4 (&acc)[4][4] = half ? accR : accL;
    const int nt = nt2 * 2 + half;
    if (nt < 8) {
      epi_store_bf16_img(acc, sm, Q, row0, nt * 128, IdF());
    } else if (nt < 16) {
      int c0 = (nt - 8) * 128;
      ScaleF f{0.0625f};
      if (!sample) epi_store_bf16_T(acc, KTp + ((size_t)sb * 1024 + c0) * 256 + t0, 256, f);
      else epi_store_bf16_T(acc, KTs + ((size_t)sb * 1024 + c0) * 2048 + t0, 2048, f);
      epi_store_bf16_img(acc, sm, Kb, row0, c0, f);
    } else if (nt < 32) {
      int c0 = (nt - 16) * 128;
      if (!sample) epi_store_bf16_T(acc, VTp + ((size_t)sb * 2048 + c0) * 256 + t0, 256, IdF());
      else epi_store_bf16_T(acc, VTs + ((size_t)sb * 2048 + c0) * 2048 + t0, 2048, IdF());
    } else {
      epi_store_bf16_img(acc, sm, SZ, row0, (nt - 32) * 128, SiluF());
    }
    }
  }
}

__device__ __forceinline__ void scan_sample64(const Params& p, int ii, char* sm) {
  const int t = tid_now(), lane = t & 63, w = t >> 6, wm = w >> 1, wn = w & 1, fr = lane & 15, fq = lane >> 4;
  const int xl = ii & 7, rest = ii >> 3;
  const int h = xl & 3, sb = xl >> 2, et8 = rest & 7, dt4 = (rest >> 3) & 3, dir = rest >> 5;
  const u16* KTs = (const u16*)(p.ws + WS_RC) + (size_t)16 * 1024 * 256;
  const u16* VTs = (const u16*)(p.ws + WS_RD) + (size_t)16 * 2048 * 256;
  u16* SNAP = (u16*)(p.ws + WS_RF);
  const float lg2 = logsig2((dir ? p.in[20] : p.in[19])[h]);
  const float cdec = fexp2(128.f * lg2);
  const int lrow = t >> 4, kc = t & 15;
  const u16* Ap = KTs + ((size_t)sb * 1024 + h * 256 + dt4 * 64 + lrow) * 2048 + kc * 8;
  const u16* Bp = VTs + ((size_t)sb * 2048 + h * 512 + et8 * 64 + lrow) * 2048 + kc * 8;
  const int ldst = (kc >> 3) * 8192 + lds_off(lrow, (kc & 7) * 8);
  float fs[8];
#pragma unroll
  for (int e = 0; e < 8; ++e) { int jj = kc * 8 + e; fs[e] = fexp2((float)(dir ? jj : 127 - jj) * lg2); }
  f32x4 acc[2][2];
  {
    const float* st = (dir ? p.in[5] : p.in[4]) + ((size_t)(sb * 4 + h) * 256 + dt4 * 64 + wm * 32) * 512 + et8 * 64 + wn * 32;
#pragma unroll
    for (int m = 0; m < 2; ++m)
#pragma unroll
      for (int n = 0; n < 2; ++n)
#pragma unroll
        for (int r = 0; r < 4; ++r) acc[m][n][r] = __builtin_nontemporal_load(st + (size_t)(m * 16 + fq * 4 + r) * 512 + n * 16 + fr);
  }
  u32x4 raA[4], rbA[4], raB[4], rbB[4];
#define S6_GLOAD(cc, RA, RB) do { const size_t _o = (size_t)((dir ? 15 - (cc) : (cc)) * 128); _Pragma("unroll") for (int i = 0; i < 4; ++i) { \
    RA[i] = *(const u32x4*)(Ap + (size_t)(16 * i) * 2048 + _o); RB[i] = *(const u32x4*)(Bp + (size_t)(16 * i) * 2048 + _o); } } while (0)
#define S6_LSTORE(buf, RA, RB) do { _Pragma("unroll") for (int i = 0; i < 4; ++i) { u32x4 _v = RA[i], _o; \
    _o[0] = pk_bf16(bflo(_v[0]) * fs[0], bfhi(_v[0]) * fs[1]); _o[1] = pk_bf16(bflo(_v[1]) * fs[2], bfhi(_v[1]) * fs[3]); \
    _o[2] = pk_bf16(bflo(_v[2]) * fs[4], bfhi(_v[2]) * fs[5]); _o[3] = pk_bf16(bflo(_v[3]) * fs[6], bfhi(_v[3]) * fs[7]); \
    *(u32x4*)(sm + (buf) * 32768 + ldst + i * 2048) = _o; *(u32x4*)(sm + (buf) * 32768 + 16384 + ldst + i * 2048) = RB[i]; } } while (0)
#define S6_STEP(cc, RA, RB) do { \
    const int cur = (cc) & 1; \
    { const int c = dir ? 15 - (cc) : (cc); \
      u16* sp = SNAP + (size_t)(((sb * 16 + c) * 4 + h) * 2 + dir) * 131072 + (size_t)(dt4 * 2 + wm) * 16384 + (size_t)(et8 * 64 + wn * 32 + fr) * 32 + fq * 4; \
      _Pragma("unroll") for (int m = 0; m < 2; ++m) _Pragma("unroll") for (int n = 0; n < 2; ++n) { \
          uint2 pk; pk.x = pk_bf16(acc[m][n][0], acc[m][n][1]); pk.y = pk_bf16(acc[m][n][2], acc[m][n][3]); \
          *(uint2*)(sp + (size_t)(n * 16) * 32 + m * 16) = pk; acc[m][n] *= cdec; } } \
    const char* sa = sm + cur * 32768; const char* sb2 = sa + 16384; \
    _Pragma("unroll") for (int kh = 0; kh < 2; ++kh) _Pragma("unroll") for (int ks = 0; ks < 2; ++ks) { \
        bf16x8 a[2], b[2]; \
        _Pragma("unroll") for (int m = 0; m < 2; ++m) a[m] = *(const bf16x8*)(sa + kh * 8192 + lds_off(wm * 32 + m * 16 + fr, ks * 32 + fq * 8)); \
        _Pragma("unroll") for (int n = 0; n < 2; ++n) b[n] = *(const bf16x8*)(sb2 + kh * 8192 + lds_off(wn * 32 + n * 16 + fr, ks * 32 + fq * 8)); \
        _Pragma("unroll") for (int m = 0; m < 2; ++m) _Pragma("unroll") for (int n = 0; n < 2; ++n) acc[m][n] = mfma16(a[m], b[n], acc[m][n]); } \
    if ((cc) + 1 < 15) { S6_LSTORE(cur ^ 1, RA, RB); if ((cc) + 3 < 15) S6_GLOAD((cc) + 3, RA, RB); } \
    __syncthreads(); } while (0)
  S6_GLOAD(0, raA, rbA);
  S6_LSTORE(0, raA, rbA);
  __syncthreads();
  S6_GLOAD(1, raA, rbA);
  S6_GLOAD(2, raB, rbB);
  for (int cc = 0; cc < 15; cc += 2) {
    S6_STEP(cc, raA, rbA);
    if (cc + 1 < 15) S6_STEP(cc + 1, raB, rbB);
  }
#undef S6_STEP
#undef S6_GLOAD
#undef S6_LSTORE
  {
    const int c = dir ? 0 : 15;
    u16* sp = SNAP + (size_t)(((sb * 16 + c) * 4 + h) * 2 + dir) * 131072 + (size_t)(dt4 * 2 + wm) * 16384 + (size_t)(et8 * 64 + wn * 32 + fr) * 32 + fq * 4;
#pragma unroll
    for (int m = 0; m < 2; ++m)
#pragma unroll
      for (int n = 0; n < 2; ++n) {
        uint2 pk; pk.x = pk_bf16(acc[m][n][0], acc[m][n][1]); pk.y = pk_bf16(acc[m][n][2], acc[m][n][3]);
        *(uint2*)(sp + (size_t)(n * 16) * 32 + m * 16) = pk;
      }
  }
}

__device__ __forceinline__ void phase_ret_scan(const Params& p, char* sm) {
  WAVE_IDS;
  const u16* KTp = (const u16*)(p.ws + WS_RC);
  const u16* KTs = KTp + (size_t)16 * 1024 * 256;
  const u16* VTp = (const u16*)(p.ws + WS_RD);
  const u16* VTs = VTp + (size_t)16 * 2048 * 256;
  u16* SNAP = (u16*)(p.ws + WS_RF);
  const int lr = t >> 3, lc = (t & 7) * 8;
  for (int idx = blockIdx.x; idx < 512; idx += gridDim.x) scan_sample64(p, idx, sm);
  for (int idx = 512 + (blockIdx.x + gridDim.x - (512 % gridDim.x)) % gridDim.x; idx < 512 + 1024; idx += gridDim.x) {
    const bool sample = false;
    int ii = idx - 512;
    const int xl = ii & 7, rest = ii >> 3;
    const int h = xl & 3, et = rest & 3, dt = (rest >> 2) & 1, dir = (rest >> 3) & 1, sb = (rest >> 4) * 2 + (xl >> 2);
    const float lg2 = logsig2((dir ? p.in[20] : p.in[19])[h]);
    const float cdec = fexp2(128.f * lg2);
    const int nch = sample ? 16 : 2;
    const int nacc = sample ? 15 : 2;
    const size_t ld = sample ? 2048 : 256;
    const u16* Ab = sample ? KTs + ((size_t)sb * 1024 + h * 256 + dt * 128) * 2048 : KTp + ((size_t)sb * 1024 + h * 256 + dt * 128) * 256;
    const u16* Bb = sample ? VTs + ((size_t)sb * 2048 + h * 512 + et * 128) * 2048 : VTp + ((size_t)sb * 2048 + h * 512 + et * 128) * 256;
    const u16* Ap = Ab + (size_t)lr * ld + lc;
    const u16* Bp = Bb + (size_t)lr * ld + lc;
    f32x4 acc[4][4];
#pragma unroll
    for (int m = 0; m < 4; ++m)
#pragma unroll
      for (int n = 0; n < 4; ++n) acc[m][n] = (f32x4){0.f, 0.f, 0.f, 0.f};
    if (sample) {
      const float* st = (dir ? p.in[5] : p.in[4]) + ((size_t)(sb * 4 + h) * 256 + dt * 128) * 512 + et * 128;
#pragma unroll
      for (int m = 0; m < 4; ++m) {
#pragma unroll
        for (int hh = 0; hh < 2; ++hh) {
          const float* pm = opaque(st + (size_t)AROW(m, 2 * hh) * 512 + ACOL(0));
#pragma unroll
          for (int n = 0; n < 4; ++n)
#pragma unroll
            for (int r = 0; r < 2; ++r) acc[m][n][2 * hh + r] = pm[r * 512 + n * 16];
        }
        __builtin_amdgcn_sched_barrier(0);
      }
    }
    float fs0[8];
#pragma unroll
    for (int e = 0; e < 8; ++e) {
      int j0 = lc + e;
      fs0[e] = fexp2((float)(dir ? j0 : 127 - j0) * lg2);
    }
    const float c64 = fexp2((dir ? 64.f : -64.f) * lg2);
    u32x4 ra[4], rb[4];
    const int nq = nacc * 2;
#define SC_TOK(q) ((size_t)((dir ? nch - 1 - ((q) >> 1) : ((q) >> 1)) * 128 + ((q) & 1) * 64))
#define SC_GLOAD(q) do { const size_t _o = SC_TOK(q); _Pragma("unroll") for (int i = 0; i < 4; ++i) { ra[i] = *(const u32x4*)(Ap + (size_t)(32 * i) * ld + _o); rb[i] = *(const u32x4*)(Bp + (size_t)(32 * i) * ld + _o); } } while (0)
#define SC_LSTORE(buf, q) do { \
    const float _cm = ((q) & 1) ? c64 : 1.f; \
    const float g0 = fs0[0] * _cm, g1 = fs0[1] * _cm, g2 = fs0[2] * _cm, g3 = fs0[3] * _cm; \
    const float g4 = fs0[4] * _cm, g5 = fs0[5] * _cm, g6 = fs0[6] * _cm, g7 = fs0[7] * _cm; \
    _Pragma("unroll") for (int i = 0; i < 4; ++i) { \
      u32x4 _v = ra[i]; u32x4 _o; \
      _o[0] = pk_bf16(bflo(_v[0]) * g0, bfhi(_v[0]) * g1); _o[1] = pk_bf16(bflo(_v[1]) * g2, bfhi(_v[1]) * g3); \
      _o[2] = pk_bf16(bflo(_v[2]) * g4, bfhi(_v[2]) * g5); _o[3] = pk_bf16(bflo(_v[3]) * g6, bfhi(_v[3]) * g7); ra[i] = _o; } \
    _Pragma("unroll") for (int i = 0; i < 4; ++i) { *(u32x4*)(sm + (buf) * 32768 + lds_off(lr + 32 * i, lc)) = ra[i]; *(u32x4*)(sm + (buf) * 32768 + 16384 + lds_off(lr + 32 * i, lc)) = rb[i]; } } while (0)
    SC_GLOAD(0);
    SC_LSTORE(0, 0);
    __syncthreads();
    for (int q = 0; q < nq; ++q) {
      const int cur = q & 1;
      if (q + 1 < nq) SC_GLOAD(q + 1);
      if ((q & 1) == 0) {
        const int cc = q >> 1, c = dir ? nch - 1 - cc : cc;
        if (sample || cc == 1) {
          int slot = sample ? ((sb * 16 + c) * 4 + h) * 2 + dir : 256 + (sb * 4 + h) * 2 + dir;
          u16* sp = SNAP + (size_t)slot * 131072;
#pragma unroll
          for (int m = 0; m < 4; ++m)
#pragma unroll
            for (int n = 0; n < 4; ++n) {
              const int dd = dt * 128 + AROW(m, 0), ee = et * 128 + ACOL(n);
              uint2 pk; pk.x = pk_bf16(acc[m][n][0], acc[m][n][1]); pk.y = pk_bf16(acc[m][n][2], acc[m][n][3]);
              *(uint2*)(sp + (size_t)(dd >> 5) * 16384 + (size_t)ee * 32 + (dd & 31)) = pk;
            }
        }
#pragma unroll
        for (int m = 0; m < 4; ++m)
#pragma unroll
          for (int n = 0; n < 4; ++n) acc[m][n] *= cdec;
      }
      const char* sa = sm + cur * 32768;
      const char* sb2 = sa + 16384;
#pragma unroll
      for (int ks = 0; ks < 2; ++ks) {
        bf16x8 a[4], b[4];
#pragma unroll
        for (int m = 0; m < 4; ++m) a[m] = *(const bf16x8*)(sa + lds_off(wm * 64 + m * 16 + fr, ks * 32 + fq * 8));
#pragma unroll
        for (int n = 0; n < 4; ++n) b[n] = *(const bf16x8*)(sb2 + lds_off(wn * 64 + n * 16 + fr, ks * 32 + fq * 8));
#pragma unroll
        for (int m = 0; m < 4; ++m)
#pragma unroll
          for (int n = 0; n < 4; ++n) acc[m][n] = mfma16(a[m], b[n], acc[m][n]);
      }
      if (q + 1 < nq) SC_LSTORE(cur ^ 1, q + 1);
      __syncthreads();
    }
#undef SC_TOK
#undef SC_GLOAD
#undef SC_LSTORE
    if (sample) {
      const int c = dir ? 0 : 15;
      u16* sp = SNAP + (size_t)(((sb * 16 + c) * 4 + h) * 2 + dir) * 131072 + (size_t)(et * 128) * 256 + dt * 128;
      epi_store_bf16_T(acc, sp, 256, IdF());
    } else {
      float* so = p.out + (dir ? O_SB : O_SF) + ((size_t)(sb * 4 + h) * 256 + dt * 128) * 512 + et * 128;
#pragma unroll
      for (int m = 0; m < 4; ++m) {
#pragma unroll
        for (int hh = 0; hh < 2; ++hh) {
          float* pm = opaque(so + (size_t)AROW(m, 2 * hh) * 512 + ACOL(0));
#pragma unroll
          for (int n = 0; n < 4; ++n)
#pragma unroll
            for (int r = 0; r < 2; ++r) __builtin_nontemporal_store(acc[m][n][2 * hh + r], pm + r * 512 + n * 16);
        }
        __builtin_amdgcn_sched_barrier(0);
      }
    }
  }
}

template <int J>
__device__ __forceinline__ void ret_ring_step(int ks, const u16* Ap, const u16* Bp, char* sm, unsigned aA, unsigned aB, int t, f32x4 (&a2)[4][8]) {
  asm volatile("s_waitcnt vmcnt(0)" ::: "memory");
  __builtin_amdgcn_s_barrier();
  if (ks + 1 < 8) {
    char* d = sm + (J ^ 1) * 36864 + t * 16;
    const int ko = (ks + 1) * 32;
    __builtin_amdgcn_global_load_lds((const unsigned*)(Ap + (size_t)(ks + 1) * 262144), (unsigned*)d, 16, 0, 0);
    const u16* bp = opaque(Bp + (size_t)(ks + 1) * 16384);
#pragma unroll
    for (int i = 0; i < 8; ++i) {
      __builtin_amdgcn_global_load_lds((const unsigned*)bp, (unsigned*)(d + 4096 + i * 4096), 16, 0, 0);
      bp = opaque(bp + 64 * 32);
    }
  }
  bf16x8 a0, a1, a2f, a3, b0, b1, b2, b3, b4, b5, b6, b7;
  asm volatile(
      "ds_read_b128 %0, %12 offset:%14\n\t"
      "ds_read_b128 %4, %13 offset:%18\n\t"
      "ds_read_b128 %5, %13 offset:%19\n\t"
      "ds_read_b128 %1, %12 offset:%15\n\t"
      "ds_read_b128 %6, %13 offset:%20\n\t"
      "ds_read_b128 %7, %13 offset:%21\n\t"
      "ds_read_b128 %2, %12 offset:%16\n\t"
      "ds_read_b128 %8, %13 offset:%22\n\t"
      "ds_read_b128 %9, %13 offset:%23\n\t"
      "ds_read_b128 %3, %12 offset:%17\n\t"
      "ds_read_b128 %10, %13 offset:%24\n\t"
      "ds_read_b128 %11, %13 offset:%25\n\t"
      "s_waitcnt lgkmcnt(0)"
      : "=&v"(a0), "=&v"(a1), "=&v"(a2f), "=&v"(a3), "=&v"(b0), "=&v"(b1), "=&v"(b2), "=&v"(b3), "=&v"(b4), "=&v"(b5), "=&v"(b6), "=&v"(b7)
      : "v"(aA), "v"(aB), "n"(J * 36864), "n"(J * 36864 + 1024), "n"(J * 36864 + 2048), "n"(J * 36864 + 3072),
        "n"(J * 36864), "n"(J * 36864 + 1024), "n"(J * 36864 + 2048), "n"(J * 36864 + 3072),
        "n"(J * 36864 + 4096), "n"(J * 36864 + 5120), "n"(J * 36864 + 6144), "n"(J * 36864 + 7168)
      : "memory");
#define RR_ROW(m, am) a2[m][0] = mfma16(am, b0, a2[m][0]); a2[m][1] = mfma16(am, b1, a2[m][1]); a2[m][2] = mfma16(am, b2, a2[m][2]); a2[m][3] = mfma16(am, b3, a2[m][3]); \
                      a2[m][4] = mfma16(am, b4, a2[m][4]); a2[m][5] = mfma16(am, b5, a2[m][5]); a2[m][6] = mfma16(am, b6, a2[m][6]); a2[m][7] = mfma16(am, b7, a2[m][7]);
  RR_ROW(0, a0) RR_ROW(1, a1) RR_ROW(2, a2f) RR_ROW(3, a3)
#undef RR_ROW
  __builtin_amdgcn_sched_barrier(0);
}
__device__ __forceinline__ void ret_ring_gemm(const u16* __restrict__ qbase, const u16* __restrict__ sbase, f32x4 (&a2)[4][8], char* sm) {
  const int t = tid_now(), lane = t & 63, w = t >> 6, fr = lane & 15, fq = lane >> 4;
  const int sb = lane * 16, swz = sb ^ (((sb >> 9) & 1) << 5);
  const int r0 = w * 16 + (swz >> 6), c0 = (swz & 63) >> 1;
  const u16* Ap = qbase + (size_t)r0 * 32 + c0;
  const u16* Bp = sbase + (size_t)r0 * 32 + c0;
  const unsigned smb = (unsigned)(uintptr_t)(LAS3 char*)sm;
  const unsigned aA = smb + lds_off32(fr, fq * 8);
  const unsigned aB = smb + 4096 + w * 8192 + lds_off32(fr, fq * 8);
  {
    char* d = sm + t * 16;
    __builtin_amdgcn_global_load_lds((const unsigned*)Ap, (unsigned*)d, 16, 0, 0);
#pragma unroll
    for (int i = 0; i < 8; ++i)
      __builtin_amdgcn_global_load_lds((const unsigned*)(Bp + (size_t)(64 * i) * 32), (unsigned*)(d + 4096 + i * 4096), 16, 0, 0);
  }
#pragma unroll 1
  for (int ks = 0; ks < 8; ks += 2) {
    ret_ring_step<0>(ks, Ap, Bp, sm, aA, aB, t, a2);
    ret_ring_step<1>(ks + 1, Ap, Bp, sm, aA, aB, t, a2);
  }
  __builtin_amdgcn_s_barrier();
}

__device__ __forceinline__ void phase_ret_out(const Params& p, char* sm) {
  for (int idx = blockIdx.x; idx < 512; idx += gridDim.x) {
    int t = tid_now();
    asm volatile("" : "+v"(t));
    const int lane = t & 63, w = t >> 6, fr = lane & 15, fq = lane >> 4;
    unsigned char* wsb = p.ws;
    asm volatile("" : "+s"(wsb));
    const u16* Q = (const u16*)(wsb + WS_RA);
    const u16* Kb = (const u16*)(wsb + WS_RB);
    const u16* VTp = (const u16*)(wsb + WS_RD);
    const u16* VTs = VTp + (size_t)16 * 2048 * 256;
    u16* SZ = (u16*)(wsb + WS_RE);
    const u16* SNAP = (const u16*)(wsb + WS_RF);
    const float* gn = p.in[21];
    int ii = idx, gbase = 32;
    if (ii >= 256) { ii -= 256; gbase = 0; }
    const int xl = ii & 7, yy = ii >> 3;
    const int rh = yy & 1, h = xl & 3;
    const int gc = gbase + (yy >> 1) * 2 + (xl >> 2);
    const bool sample = gc >= 32;
    int sb, c;
    if (sample) { sb = (gc - 32) >> 4; c = (gc - 32) & 15; } else { sb = gc >> 1; c = gc & 1; }
    const size_t R0 = (size_t)gc * 128 + rh * 64;
    const float lgf2 = logsig2(p.in[19][h]), lgb2 = logsig2(p.in[20][h]);
    {
      f32x4 a1[4][2];
#pragma unroll
      for (int m = 0; m < 4; ++m)
#pragma unroll
        for (int n = 0; n < 2; ++n) a1[m][n] = (f32x4){0.f, 0.f, 0.f, 0.f};
      const u16* qp = Q + (size_t)(h * 8) * 262144 + (R0 + fr) * 32 + fq * 8;
      const u16* kp = Kb + (size_t)(h * 8) * 262144 + ((size_t)gc * 128 + w * 32 + fr) * 32 + fq * 8;
#pragma unroll 1
      for (int kb = 0; kb < 8; kb += 4) {
        bf16x8 af[4][4], bfr[4][2];
#pragma unroll
        for (int k2 = 0; k2 < 4; ++k2) {
#pragma unroll
          for (int m = 0; m < 4; ++m) af[k2][m] = *(const bf16x8*)(qp + (size_t)(kb + k2) * 262144 + (16 * m) * 32);
#pragma unroll
          for (int n = 0; n < 2; ++n) bfr[k2][n] = *(const bf16x8*)(kp + (size_t)(kb + k2) * 262144 + (16 * n) * 32);
        }
#pragma unroll
        for (int k2 = 0; k2 < 4; ++k2)
#pragma unroll
          for (int m = 0; m < 4; ++m)
#pragma unroll
            for (int n = 0; n < 2; ++n) a1[m][n] = mfma16(af[k2][m], bfr[k2][n], a1[m][n]);
      }
#pragma unroll
      for (int m = 0; m < 4; ++m)
#pragma unroll
        for (int n = 0; n < 2; ++n)
#pragma unroll
          for (int r = 0; r < 4; ++r) {
            int il = 16 * m + 4 * fq + r, i = rh * 64 + il, jj = w * 32 + 16 * n + fr;
            int dd = i - jj;
            float f = dd > 0 ? fexp2((float)dd * lgf2) : (dd < 0 ? fexp2((float)(-dd) * lgb2) : 2.0f);
            *(u16*)(sm + (jj >> 6) * 8192 + lds_off(il, jj & 63)) = f2bf(a1[m][n][r] * f);
          }
    }
    __syncthreads();
    f32x4 a2[4][8];
#pragma unroll
    for (int m = 0; m < 4; ++m)
#pragma unroll
      for (int n = 0; n < 8; ++n) a2[m][n] = (f32x4){0.f, 0.f, 0.f, 0.f};
    {
      const u16* vt; size_t ldv;
      if (sample) { ldv = 2048; vt = VTs + ((size_t)sb * 2048 + h * 512 + w * 128 + fr) * 2048 + c * 128 + fq * 8; }
      else { ldv = 256; vt = VTp + ((size_t)sb * 2048 + h * 512 + w * 128 + fr) * 256 + c * 128 + fq * 8; }
#pragma unroll 1
      for (int kb = 0; kb < 4; kb += 2) {
        bf16x8 bv[2][8];
#pragma unroll
        for (int k2 = 0; k2 < 2; ++k2)
#pragma unroll
          for (int n = 0; n < 8; ++n) bv[k2][n] = *(const bf16x8*)(vt + (size_t)(16 * n) * ldv + (kb + k2) * 32);
#pragma unroll
        for (int k2 = 0; k2 < 2; ++k2) {
          const int ks = kb + k2;
          bf16x8 af[4];
#pragma unroll
          for (int m = 0; m < 4; ++m) af[m] = *(const bf16x8*)(sm + (ks >> 1) * 8192 + lds_off(16 * m + fr, (ks & 1) * 32 + fq * 8));
#pragma unroll
          for (int n = 0; n < 8; ++n)
#pragma unroll
            for (int m = 0; m < 4; ++m) a2[m][n] = mfma16(af[m], bv[k2][n], a2[m][n]);
        }
        __builtin_amdgcn_sched_barrier(0);
      }
    }
    __syncthreads();
    {
      int tb = tid_now();
      asm volatile("" : "+v"(tb));
      const int fq = (tb & 63) >> 4;
      bool hasF = sample || c == 1, hasB = sample || c == 0;
      int mode = 0;
#pragma unroll 1
      for (int dir = 0; dir < 2; ++dir) {
        bool has = dir == 0 ? hasF : hasB;
        if (!has) continue;
#pragma unroll
        for (int m = 0; m < 4; ++m)
#pragma unroll
          for (int r = 0; r < 4; ++r) {
            float fi = (float)(rh * 64 + 16 * m + 4 * fq + r);
            float ecur = mode == 0 ? 0.f : (fi + 1.f) * lgf2;
            float enew = dir == 0 ? (fi + 1.f) * lgf2 : (128.f - fi) * lgb2;
            float f = fexp2(ecur - enew);
#pragma unroll
            for (int n = 0; n < 8; ++n) a2[m][n][r] *= f;
          }
        mode = dir + 1;
        int slot = sample ? ((sb * 16 + c) * 4 + h) * 2 + dir : 256 + (sb * 4 + h) * 2 + dir;
        ret_ring_gemm(Q + (size_t)(h * 8) * 262144 + R0 * 32, SNAP + (size_t)slot * 131072, a2, sm);
      }
      if (mode != 0) {
#pragma unroll
        for (int m = 0; m < 4; ++m)
#pragma unroll
          for (int r = 0; r < 4; ++r) {
            float fi = (float)(rh * 64 + 16 * m + 4 * fq + r);
            float f = fexp2(mode == 1 ? (fi + 1.f) * lgf2 : (128.f - fi) * lgb2);
#pragma unroll
            for (int n = 0; n < 8; ++n) a2[m][n][r] *= f;
          }
      }
    }
    int t3 = tid_now();
    asm volatile("" : "+v"(t3));
    {
    const int lane = t3 & 63, w = t3 >> 6, fr = lane & 15, fq = lane >> 4;
    float* red = (float*)(sm + 69632);
#pragma unroll
    for (int m = 0; m < 4; ++m)
#pragma unroll
      for (int r = 0; r < 4; ++r) {
        float s1 = 0.f, s2 = 0.f;
#pragma unroll
        for (int n = 0; n < 8; ++n) { float v = a2[m][n][r]; s1 += v; s2 += v * v; }
#pragma unroll
        for (int o = 1; o < 16; o <<= 1) { s1 += __shfl_xor(s1, o); s2 += __shfl_xor(s2, o); }
        if (fr == 0) { int row = 16 * m + 4 * fq + r; red[(w * 64 + row) * 2] = s1; red[(w * 64 + row) * 2 + 1] = s2; }
      }
    __syncthreads();
    u16* stg = (u16*)(sm + w * 17408);
    float gv[8];
#pragma unroll
    for (int n = 0; n < 8; ++n) gv[n] = gn[h * 512 + w * 128 + 16 * n + fr];
#pragma unroll
    for (int m = 0; m < 4; ++m)
#pragma unroll
      for (int r = 0; r < 4; ++r) {
        int row = 16 * m + 4 * fq + r;
        float s1 = 0.f, s2 = 0.f;
#pragma unroll
        for (int ww = 0; ww < 4; ++ww) { s1 += red[(ww * 64 + row) * 2]; s2 += red[(ww * 64 + row) * 2 + 1]; }
        float mean = s1 * (1.f / 512.f);
        float var = s2 * (1.f / 512.f) - mean * mean;
        var = var < 0.f ? 0.f : var;
        float rstd = rsqrtf(var + 1e-6f);
#pragma unroll
        for (int n = 0; n < 8; ++n) stg[row * 136 + 16 * n + fr] = f2bf((a2[m][n][r] - mean) * rstd * gv[n]);
      }
#pragma unroll 8
    for (int i = 0; i < 16; ++i) {
      int row = (lane >> 4) + 4 * i, ch = lane & 15;
      uint4 yv = *(const uint4*)(stg + row * 136 + ch * 8);
      const int zc = h * 512 + w * 128 + ch * 8;
      u16* zp = SZ + (size_t)(zc >> 5) * 262144 + (R0 + row) * 32 + (zc & 31);
      uint4 zv = *(const uint4*)zp;
      uint4 o;
      o.x = pk_bf16(bflo(yv.x) * bflo(zv.x), bfhi(yv.x) * bfhi(zv.x));
      o.y = pk_bf16(bflo(yv.y) * bflo(zv.y), bfhi(yv.y) * bfhi(zv.y));
      o.z = pk_bf16(bflo(yv.z) * bflo(zv.z), bfhi(yv.z) * bfhi(zv.z));
      o.w = pk_bf16(bflo(yv.w) * bflo(zv.w), bfhi(yv.w) * bfhi(zv.w));
      *(uint4*)zp = o;
    }
    }
    __syncthreads();
  }
}

#define XB_TMO      128
#define XB_XCNT(j)  (256  + 64 * (j))
#define XB_XSUB(j)  (1280 + 64 * (j))
#define XB_XGEN(j)  (2304 + 64 * (j))
#define XB_TOP      3328
#define XB_TOPGEN   3392
#define XCD_BAR_WORDS 3456
#define XB_SPIN_CAP (1u << 18)
#define LAS __attribute__((address_space(3)))
__device__ __forceinline__ unsigned xb_ld(unsigned* p)              { return __hip_atomic_load(p, __ATOMIC_RELAXED, __HIP_MEMORY_SCOPE_AGENT); }
__device__ __forceinline__ unsigned xb_add(unsigned* p, unsigned v) { return __hip_atomic_fetch_add(p, v, __ATOMIC_RELAXED, __HIP_MEMORY_SCOPE_AGENT); }
__device__ __forceinline__ unsigned xb_xcc_id() { return (unsigned)__builtin_amdgcn_s_getreg((3 << 11) | 20) & 0xFu; }
#define XB_SPIN(cond, bar) do { unsigned _sp = 0; while (cond) { __builtin_amdgcn_s_sleep(1); \
    if ((++_sp & 255u) == 0u) { if (xb_ld(&(bar)[XB_TMO])) break; if (_sp > XB_SPIN_CAP) { atomicAdd(&(bar)[XB_TMO], 1u); break; } } } } while (0)
struct XcdBarrier { unsigned* bar; unsigned x; volatile LAS unsigned* st; };
__device__ __forceinline__ XcdBarrier xcd_barrier_post(unsigned* bar, volatile LAS unsigned* st) {
    XcdBarrier b; b.bar = bar; b.x = xb_xcc_id(); b.st = st;
    if (tid_now() == 0) (void)xb_add(&bar[XB_XCNT(b.x)], 1u);
    return b;
}
__device__ __forceinline__ void xcd_barrier_complete(unsigned* bar, unsigned x, unsigned& nloc, unsigned& nx) {
    const unsigned G = gridDim.x * gridDim.y * gridDim.z;
    unsigned sum, cnt, mine, sp = 0u;
    for (;;) {
        sum = 0u; cnt = 0u; mine = 0u;
#pragma unroll
        for (unsigned j = 0; j < 16; ++j) { const unsigned c = xb_ld(&bar[XB_XCNT(j)]); sum += c; cnt += (c > 0u) ? 1u : 0u; mine = (j == x) ? c : mine; }
        if (sum == G) break;
        __builtin_amdgcn_s_sleep(1);
        if ((++sp & 255u) == 0u) { if (xb_ld(&bar[XB_TMO])) break; if (sp > XB_SPIN_CAP) { atomicAdd(&bar[XB_TMO], 1u); break; } }
    }
    nloc = mine > 0u ? mine : 1u; nx = cnt > 0u ? cnt : 1u;
}
__device__ __forceinline__ void xcd_barrier(const XcdBarrier& b) {
    asm volatile("s_waitcnt vmcnt(0)" ::: "memory");
    __syncthreads();
    if (tid_now() == 0) {
        unsigned* bar = b.bar;
        __builtin_amdgcn_s_waitcnt(0);
        unsigned nloc = b.st[0], nx = b.st[1];
        if (nloc == 0u) { xcd_barrier_complete(bar, b.x, nloc, nx); b.st[0] = nloc; b.st[1] = nx; }
        const unsigned old = xb_add(&bar[XB_XSUB(b.x)], 1u);
        const unsigned gen = old / nloc;
        if (old + 1u == (gen + 1u) * nloc) {
            __builtin_amdgcn_fence(__ATOMIC_RELEASE, "agent");
            asm volatile("s_waitcnt vmcnt(0)" ::: "memory");
            const unsigned og = xb_add(&bar[XB_TOP], 1u);
            const unsigned tg = og / nx;
            if (og + 1u == (tg + 1u) * nx) xb_add(&bar[XB_TOPGEN], 1u);
            else XB_SPIN(xb_ld(&bar[XB_TOPGEN]) == tg, bar);
            __builtin_amdgcn_fence(__ATOMIC_ACQUIRE, "agent");
            xb_add(&bar[XB_XGEN(b.x)], 1u);
            asm volatile("s_waitcnt vmcnt(0)" ::: "memory");
        } else {
            XB_SPIN(xb_ld(&bar[XB_XGEN(b.x)]) == gen, bar);
            __builtin_amdgcn_fence(__ATOMIC_ACQUIRE, "agent");
            asm volatile("s_waitcnt vmcnt(0)" ::: "memory");
        }
    }
    __syncthreads();
}

__global__ void __launch_bounds__(NTHREADS, 2) mega(Params p, int ph_lo, int ph_hi) {
  __shared__ __attribute__((aligned(16))) char sm[SMEM_BYTES];
  cg::grid_group grid = cg::this_grid();
  __shared__ uint4 xb_words;
  if ((threadIdx.x & 63) == 0) g_wave_tab[hw_slot()] = (int)(threadIdx.x >> 6);
  if (threadIdx.x == 0) xb_words = make_uint4(0u, 0u, 0u, 0u);
  __syncthreads();
  (void)xcd_barrier_post((unsigned*)(p.ws + WS_BAR), (volatile LAS unsigned*)&xb_words);
  if (ph_lo < 0) grid.sync();
  const float* xp0 = p.in[0];
  const float* xs0 = p.in[1];
  const float* xp1 = p.out;
  const float* xs1 = p.out + (size_t)4096 * 1024;
#ifndef PH_ONLY
#define PH_ONLY -1
#endif
#define PHON(x) (PH_ONLY < 0 || PH_ONLY == (x))
#define RUN(k, call) do { if (ph_lo <= (k) && (k) < ph_hi) { if (PHON(k)) { call; } if ((k) + 1 < ph_hi) { XcdBarrier xb; xb.bar = (unsigned*)(p.ws + WS_BAR); xb.x = xb_xcc_id(); xb.st = (volatile LAS unsigned*)&xb_words; xcd_barrier(xb); } } } while (0)
  RUN(0, phase_prep(p, sm));
  RUN(1, phase_norm(p, 0, xp0, xs0));
  RUN(2, phase_attn_inproj(p, 0, sm));
  RUN(3, phase_attn(p, 0, sm));
  RUN(4, phase_outproj(p, 0, (const u16*)(p.ws + WS_RC), 1024, (const u16*)(p.ws + WS_WAO), xp0, xs0, sm));
  RUN(5, phase_norm(p, 1, xp1, xs1));
  RUN(6, phase_pool_inproj(p, sm));
  RUN(7, phase_pool_d(p));
  RUN(8, phase_pool_gemm(p, sm));
  RUN(9, phase_outproj(p, 1, (const u16*)(p.ws + WS_RC), 1024, (const u16*)(p.ws + WS_WPO), xp1, xs1, sm));
  RUN(10, phase_norm(p, 2, xp1, xs1));
  RUN(11, phase_ret_inproj(p, sm));
  RUN(12, phase_ret_scan(p, sm));
  RUN(13, phase_ret_out(p, sm));
  RUN(14, phase_outproj(p, 2, (const u16*)(p.ws + WS_RE), 2048, (const u16*)(p.ws + WS_WRO), xp1, xs1, sm));
  RUN(15, phase_norm(p, 3, xp1, xs1));
  RUN(16, phase_attn_inproj(p, 1, sm));
  RUN(17, phase_attn(p, 1, sm));
  RUN(18, phase_outproj(p, 3, (const u16*)(p.ws + WS_RC), 1024, (const u16*)(p.ws + WS_WAO) + (size_t)1024 * 1024, xp1, xs1, sm));
  RUN(19, phase_final_norm(p));
}

extern "C" void kernel_launch(void* const* d_in, const int* in_sizes, int n_in, void* d_out, int out_size, void* d_ws, size_t ws_size,
                              hipStream_t stream) {
  static int grid_blocks = 0;
  if (!grid_blocks) {
    int dev = 0, cus = 0, per_cu = 0;
    hipGetDevice(&dev);
    hipDeviceGetAttribute(&cus, hipDeviceAttributeMultiprocessorCount, dev);
    hipOccupancyMaxActiveBlocksPerMultiprocessor(&per_cu, mega, NTHREADS, 0);
    if (per_cu < 1) per_cu = 1;
    if (per_cu > 2) per_cu = 2;
    grid_blocks = cus * per_cu;
    if (ws_size < WS_END) fprintf(stderr, "kernel_launch: workspace too small: %zu < %zu\n", ws_size, (size_t)WS_END);
  }
  Params p{};
  for (int i = 0; i < 24; ++i) p.in[i] = (const float*)d_in[i];
  p.out = (float*)d_out;
  p.ws = (unsigned char*)d_ws;
#ifndef N_SPLIT
#define N_SPLIT 1
#endif
#ifndef PH_END
#define PH_END 20
#endif
  if (PH_END < 20) (void)hipMemsetAsync(d_out, 0, (size_t)out_size * 4, stream);
  (void)hipMemsetAsync((char*)d_ws + WS_BAR, 0, XCD_BAR_WORDS * 4, stream);
#ifndef PROBE_DUP
#define PROBE_DUP -1
#endif
  {
    int seg[4][2]; int nseg = 0;
    if (PROBE_DUP < 0) { seg[0][0] = 0; seg[0][1] = PH_END; nseg = 1; }
#ifndef PROBE_LO
#define PROBE_LO PROBE_DUP
#endif
    else { seg[0][0] = 0; seg[0][1] = PROBE_DUP + 1; seg[1][0] = PROBE_LO; seg[1][1] = PROBE_DUP + 1; nseg = 2; if (PROBE_DUP + 1 < 20) { seg[2][0] = PROBE_DUP + 1; seg[2][1] = 20; nseg = 3; } }
    for (int li = 0; li < nseg; ++li) {
      int lo = seg[li][0], hi = seg[li][1];
      if (li > 0) (void)hipMemsetAsync((char*)d_ws + WS_BAR, 0, XCD_BAR_WORDS * 4, stream);
      void* args[] = {&p, &lo, &hi};
      hipError_t e = hipLaunchCooperativeKernel((void*)mega, dim3(grid_blocks), dim3(NTHREADS), args, 0, stream);
      if (e != hipSuccess) fprintf(stderr, "cooperative launch failed: %s (grid %d)\n", hipGetErrorString(e), grid_blocks);
    }
  }
}
```
